# Optimizing an MI355X kernel written in HIP

```python
import jax, jax.numpy as jnp
from jax import lax
import numpy as np

D_MODEL = 1024
BATCH = 16
SEQ = 2048
DEPTH = 1

D_MIX = D_MODEL
C_CONV = D_MIX // 2
V_HEAD = 64
N_HEADS = (D_MIX - C_CONV) // V_HEAD
QK_NOPE = 64
QK_ROPE = 32
QK_HEAD = QK_NOPE + QK_ROPE
Q_LORA = D_MODEL // 4
KV_LORA = D_MODEL // 8
CONV_K = 31
CONV_PAD = CONV_K // 2
D_FF = 256 * ((8 * D_MODEL // 3 + 255) // 256)
N_MOD = 9
W_IN_COLS = 2 * C_CONV + Q_LORA + KV_LORA + QK_ROPE
ROPE_THETA = 10000.0
Q_BLOCK = 128
EPS = 1e-6

kernel_name = "hybrid_conv_mla_macaron_adaln_encoder"


def _rms(x):
    xf = x.astype(jnp.float32)
    return (xf * lax.rsqrt(jnp.mean(xf * xf, axis=-1, keepdims=True) + EPS)).astype(x.dtype)


def _layernorm(x, g, b):
    xf = x.astype(jnp.float32)
    mu = jnp.mean(xf, axis=-1, keepdims=True)
    var = jnp.mean(jnp.square(xf - mu), axis=-1, keepdims=True)
    return ((xf - mu) * lax.rsqrt(var + 1e-5)).astype(x.dtype) * g + b


def _modulate(x, shift, scale):
    return _rms(x) * (1 + scale[:, None, :]) + shift[:, None, :]


def _swiglu(x, w_gate, w_up, w_down):
    return (jax.nn.silu(x @ w_gate) * (x @ w_up)) @ w_down


def _rope(x, cos, sin):
    half = x.shape[-1] // 2
    x1, x2 = x[..., :half], x[..., half:]
    return jnp.concatenate([x1 * cos - x2 * sin, x2 * cos + x1 * sin], axis=-1)


def _attention(q, k, v):
    B, S, H, Dq = q.shape
    nb = S // Q_BLOCK
    qb = q.reshape(B, nb, Q_BLOCK, H, Dq).transpose(1, 0, 2, 3, 4)
    scale = Dq ** -0.5

    def one_block(qblk):
        s = jnp.einsum('bqhd,bkhd->bhqk', qblk, k, preferred_element_type=jnp.float32) * scale
        p = jax.nn.softmax(s, axis=-1).astype(v.dtype)
        return jnp.einsum('bhqk,bkhd->bqhd', p, v)

    o = lax.map(one_block, qb)
    return o.transpose(1, 0, 2, 3, 4).reshape(B, S, H * v.shape[-1])


def setup_inputs(seed: int = 0) -> dict:
    key = jax.random.key(seed)
    ks = jax.random.split(key, 24)

    def w(k, shape, fan_in):
        return jax.random.normal(k, shape, jnp.float32) * (fan_in ** -0.5)

    def gain(k, shape):
        return 1.0 + 0.01 * jax.random.normal(k, shape, jnp.float32)

    def bias(k, shape):
        return 0.01 * jax.random.normal(k, shape, jnp.float32)

    L = DEPTH
    return {
        "x": jax.random.normal(ks[0], (BATCH, SEQ, D_MODEL), jnp.float32),
        "c": jax.random.normal(ks[1], (BATCH, D_MODEL), jnp.float32),
        "positions": jnp.broadcast_to(jnp.arange(SEQ, dtype=jnp.int32), (BATCH, SEQ)),
        "w_ada": w(ks[2], (L, D_MODEL, N_MOD * D_MODEL), D_MODEL),
        "b_ada": bias(ks[3], (L, N_MOD * D_MODEL)),
        "ffn1_wg": w(ks[4], (L, D_MODEL, D_FF), D_MODEL),
        "ffn1_wu": w(ks[5], (L, D_MODEL, D_FF), D_MODEL),
        "ffn1_wd": w(ks[6], (L, D_FF, D_MODEL), D_FF),
        "w_in": w(ks[7], (L, D_MODEL, W_IN_COLS), D_MODEL),
        "g_q_lat": gain(ks[8], (L, Q_LORA)),
        "g_kv_lat": gain(ks[9], (L, KV_LORA)),
        "w_q_up": w(ks[10], (L, Q_LORA, N_HEADS * QK_HEAD), Q_LORA),
        "w_kv_up": w(ks[11], (L, KV_LORA, N_HEADS * (QK_NOPE + V_HEAD)), KV_LORA),
        "g_q_head": gain(ks[12], (L, QK_HEAD)),
        "g_k_head": gain(ks[13], (L, QK_HEAD)),
        "conv_w": w(ks[14], (L, CONV_K, 1, C_CONV), CONV_K),
        "conv_b": bias(ks[15], (L, C_CONV)),
        "g_conv_ln": gain(ks[16], (L, C_CONV)),
        "b_conv_ln": bias(ks[17], (L, C_CONV)),
        "w_out": w(ks[18], (L, D_MIX, D_MODEL), D_MIX),
        "ffn2_wg": w(ks[19], (L, D_MODEL, D_FF), D_MODEL),
        "ffn2_wu": w(ks[20], (L, D_MODEL, D_FF), D_MODEL),
        "ffn2_wd": w(ks[21], (L, D_FF, D_MODEL), D_FF),
        "g_final": gain(ks[22], (L, D_MODEL)),
    }


def reference(x, c, positions, w_ada, b_ada, ffn1_wg, ffn1_wu, ffn1_wd, w_in,
              g_q_lat, g_kv_lat, w_q_up, w_kv_up, g_q_head, g_k_head,
              conv_w, conv_b, g_conv_ln, b_conv_ln, w_out,
              ffn2_wg, ffn2_wu, ffn2_wd, g_final):
    B, S, _ = x.shape
    inv_freq = 1.0 / (ROPE_THETA ** (jnp.arange(0, QK_ROPE, 2, dtype=jnp.float32) / QK_ROPE))
    ang = positions.astype(jnp.float32)[..., None] * inv_freq
    cos = jnp.cos(ang)[:, :, None, :].astype(x.dtype)
    sin = jnp.sin(ang)[:, :, None, :].astype(x.dtype)
    sc = jax.nn.silu(c)

    h = x
    for i in range(DEPTH):
        mod = sc @ w_ada[i] + b_ada[i]
        (sh1, s1, g1, shm, smx, gm, sh2, s2, g2) = jnp.split(mod, N_MOD, axis=-1)

        h = h + 0.5 * g1[:, None, :] * _swiglu(_modulate(h, sh1, s1), ffn1_wg[i], ffn1_wu[i], ffn1_wd[i])

        n = _modulate(h, shm, smx)
        z = n @ w_in[i]
        o1 = 2 * C_CONV
        o2 = o1 + Q_LORA
        o3 = o2 + KV_LORA
        u, cq, ckv, kr = z[..., :o1], z[..., o1:o2], z[..., o2:o3], z[..., o3:]

        a = u[..., :C_CONV] * jax.nn.sigmoid(u[..., C_CONV:])
        a = lax.conv_general_dilated(a, conv_w[i], window_strides=(1,),
                                     padding=[(CONV_PAD, CONV_PAD)],
                                     dimension_numbers=('NWC', 'WIO', 'NWC'),
                                     feature_group_count=C_CONV) + conv_b[i]
        a = jax.nn.silu(_layernorm(a, g_conv_ln[i], b_conv_ln[i]))

        q = ((_rms(cq) * g_q_lat[i]) @ w_q_up[i]).reshape(B, S, N_HEADS, QK_HEAD)
        kv = ((_rms(ckv) * g_kv_lat[i]) @ w_kv_up[i]).reshape(B, S, N_HEADS, QK_NOPE + V_HEAD)
        k_nope, v = kv[..., :QK_NOPE], kv[..., QK_NOPE:]
        k_rope = jnp.broadcast_to(kr[:, :, None, :], (B, S, N_HEADS, QK_ROPE))
        k = jnp.concatenate([k_nope, k_rope], axis=-1)
        q = _rms(q) * g_q_head[i]
        k = _rms(k) * g_k_head[i]
        q = jnp.concatenate([q[..., :QK_NOPE], _rope(q[..., QK_NOPE:], cos, sin)], axis=-1)
        k = jnp.concatenate([k[..., :QK_NOPE], _rope(k[..., QK_NOPE:], cos, sin)], axis=-1)
        att = _attention(q, k, v)

        mix = jnp.concatenate([a, att], axis=-1) @ w_out[i]
        h = h + gm[:, None, :] * mix

        h = h + 0.5 * g2[:, None, :] * _swiglu(_modulate(h, sh2, s2), ffn2_wg[i], ffn2_wu[i], ffn2_wd[i])

        h = _rms(h) * g_final[i]
    return h
```

```cpp
#include <hip/hip_runtime.h>
#include <hip/hip_bf16.h>
#include <cstdio>
#include <cstdint>
#include <cmath>
namespace pg8 {
#define PG8_LAS __attribute__((address_space(3)))
typedef unsigned short bf16_t;
typedef short bf16x8 __attribute__((ext_vector_type(8)));
typedef float f32x4 __attribute__((ext_vector_type(4)));
typedef unsigned u32x4 __attribute__((ext_vector_type(4)));
constexpr int BM = 256, BK = 64, HALF = 128, HTB = HALF * BK * 2  , STAGE_BYTES = 8 * HTB, NXCD = 8, WGM = 8;

__host__ __device__ __forceinline__ int lds_byte(int r, int c) { const int st = (r >> 4) * 2 + (c >> 5), rr = r & 15, cc = c & 31, ob = rr * 64 + cc * 2; return st * 1024 + (ob ^ (((ob >> 9) & 1) << 5)); }
__host__ __device__ __forceinline__ void stage_rc(int b, int& R, int& C) { const int st = b / 1024, sb = b % 1024, swz = sb ^ (((sb >> 9) & 1) << 5); R = (st >> 1) * 16 + swz / 64; C = (st & 1) * 32 + (swz % 64) / 2; }
__host__ __device__ __forceinline__ int perm32(int rho) { const int n = rho >> 4, i = rho & 15; return 8 * (i >> 2) + 4 * n + (i & 3); }

struct Unit { int pm, pn; };
struct Gemm { const bf16_t* A; const bf16_t* Bt; int M, N, K; };

struct StaticOrder {
    int nM, nN, nwg, G, c;
    __host__ __device__ void init(int M, int N, int G_, int c_) { nM = M / BM; nN = N / BM; nwg = nM * nN; G = G_; c = c_; }
    __host__ __device__ bool next(int i, Unit& u) const {
        const long L = (long)i * G + c; if (L >= nwg) return false;
        int wgid = (int)L; { const int q = nwg / NXCD, r = nwg % NXCD, xcd = wgid % NXCD, off = wgid / NXCD; wgid = (xcd < r ? xcd * (q + 1) : r * (q + 1) + (xcd - r) * q) + off; }
        const int nig = WGM * nN, gid = wgid / nig, fm = gid * WGM, gsz = (nM - fm) < WGM ? (nM - fm) : WGM;
        u.pm = fm + ((wgid % nig) % gsz); u.pn = (wgid % nig) / gsz; return true;
    }
    __device__ __forceinline__ void a_ready(const Unit&) const {}
    __device__ __forceinline__ void done(const Unit&) const {}
};

__device__ __forceinline__ unsigned cvt_pk_bf16(float lo, float hi) { unsigned r; asm volatile("v_cvt_pk_bf16_f32 %0, %1, %2" : "=v"(r) : "v"(lo), "v"(hi)); return r; }
__device__ __forceinline__ float sigm(float x) { return __builtin_amdgcn_rcpf(1.0f + __builtin_amdgcn_exp2f(-1.4426950408889634f * x)); }
struct EpiSwiglu {
    static constexpr bool PERM = true, AFTER_DRAIN = false;
    bf16_t* O; int ldc;
    __device__ __forceinline__ void operator()(const f32x4 (&acc)[2][2][4][2], const Unit& u, int wr, int wc, int fr, int fq) const {
        const int row0 = u.pm * BM + wr * 64 + fr, col0 = u.pn * HALF + wc * 32 + 8 * fq;
#pragma unroll
        for (int ai = 0; ai < 2; ++ai)
#pragma unroll
            for (int m = 0; m < 4; ++m) { bf16_t* rowp = O + (size_t)(row0 + ai * HALF + m * 16) * ldc + col0;
                float o[8];
#pragma unroll
                for (int n = 0; n < 2; ++n)
#pragma unroll
                    for (int e = 0; e < 4; ++e) { const float g = acc[ai][0][m][n][e], up = acc[ai][1][m][n][e]; o[4 * n + e] = g * sigm(g) * up; }
                u32x4 w; w.x = cvt_pk_bf16(o[0], o[1]); w.y = cvt_pk_bf16(o[2], o[3]); w.z = cvt_pk_bf16(o[4], o[5]); w.w = cvt_pk_bf16(o[6], o[7]);
                *(u32x4*)rowp = w; }
    }
};
struct EpiG3 {
    static constexpr bool PERM = true, AFTER_DRAIN = false;
    bf16_t* ZG; bf16_t* ZC;
    __device__ __forceinline__ void operator()(const f32x4 (&acc)[2][2][4][2], const Unit& u, int wr, int wc, int fr, int fq) const {
        const int row0 = u.pm * BM + wr * 64 + fr;
        if (u.pn < 4) {
            const int col0 = u.pn * HALF + wc * 32 + 8 * fq;
#pragma unroll
            for (int ai = 0; ai < 2; ++ai)
#pragma unroll
                for (int m = 0; m < 4; ++m) { bf16_t* rowp = ZG + (size_t)(row0 + ai * HALF + m * 16) * 512 + col0;
                    float o[8];
#pragma unroll
                    for (int n = 0; n < 2; ++n)
#pragma unroll
                        for (int e = 0; e < 4; ++e) o[4 * n + e] = acc[ai][0][m][n][e] * sigm(acc[ai][1][m][n][e]);
                    u32x4 w; w.x = cvt_pk_bf16(o[0], o[1]); w.y = cvt_pk_bf16(o[2], o[3]); w.z = cvt_pk_bf16(o[4], o[5]); w.w = cvt_pk_bf16(o[6], o[7]);
                    *(u32x4*)rowp = w; }
        } else {
            const int col0 = (u.pn - 4) * BM + wc * 32 + 8 * fq;
#pragma unroll
            for (int ai = 0; ai < 2; ++ai)
#pragma unroll
                for (int m = 0; m < 4; ++m) { bf16_t* rowp = ZC + (size_t)(row0 + ai * HALF + m * 16) * 512 + col0;
#pragma unroll
                    for (int bj = 0; bj < 2; ++bj) { const f32x4 v0 = acc[ai][bj][m][0], v1 = acc[ai][bj][m][1];
                        u32x4 w; w.x = cvt_pk_bf16(v0[0], v0[1]); w.y = cvt_pk_bf16(v0[2], v0[3]); w.z = cvt_pk_bf16(v1[0], v1[1]); w.w = cvt_pk_bf16(v1[2], v1[3]);
                        *(u32x4*)(rowp + bj * HALF) = w; } }
        }
    }
};
struct EpiResid {
    static constexpr bool PERM = false, AFTER_DRAIN = false;
    const float* res; float* out; const float* gate; float coef;
    __device__ __forceinline__ void operator()(const f32x4 (&acc)[2][2][4][2], const Unit& u, int wr, int wc, int fr, int fq) const {
        const int row0 = u.pm * BM + wr * 64 + fr, col0 = u.pn * BM + wc * 32 + 4 * fq;
        const float* gp = gate + (size_t)(u.pm >> 3) * 9216 + col0;
        f32x4 gv[2][2];
#pragma unroll
        for (int bj = 0; bj < 2; ++bj)
#pragma unroll
            for (int n = 0; n < 2; ++n) gv[bj][n] = *(const f32x4*)(gp + bj * HALF + n * 16) * coef;
#pragma unroll
        for (int ai = 0; ai < 2; ++ai)
#pragma unroll
            for (int m = 0; m < 4; ++m) { const size_t off = (size_t)(row0 + ai * HALF + m * 16) * 1024 + col0;
                f32x4 r[2][2];
#pragma unroll
                for (int bj = 0; bj < 2; ++bj)
#pragma unroll
                    for (int n = 0; n < 2; ++n) r[bj][n] = *(const f32x4*)(res + off + bj * HALF + n * 16);
#pragma unroll
                for (int bj = 0; bj < 2; ++bj)
#pragma unroll
                    for (int n = 0; n < 2; ++n) *(f32x4*)(out + off + bj * HALF + n * 16) = r[bj][n] + gv[bj][n] * acc[ai][bj][m][n];
                if (m & 1) asm volatile("" ::: "memory"); }
    }
};

template <class Epi, class Sched, bool ALIGN_EPI = false, bool SP2 = false>
__device__ __forceinline__ void gemm_phase(PG8_LAS unsigned char* lds, const Gemm g, const Sched& S, const Epi& E) {
    const int tid = threadIdx.x, wid = __builtin_amdgcn_readfirstlane(tid >> 6), lane = tid & 63, wr = wid >> 2, wc = wid & 3, fr = lane & 15, fq = lane >> 4;
    const int K = g.K, nt = K / BK;
    unsigned voffA[2], voffB[2];
#pragma unroll
    for (int i = 0; i < 2; ++i) { int R, C; stage_rc(tid * 16 + i * 8192, R, C); const int Rb = Epi::PERM ? ((R & ~31) + perm32(R & 31)) : R;
        voffA[i] = (unsigned)(R * K + C) * 2u; voffB[i] = (unsigned)(Rb * K + C) * 2u; }
    const size_t kstep = (size_t)(BK * 2);
    const size_t hstep = (size_t)HALF * K * 2;
    const size_t tstep = 2 * hstep;
    const unsigned ldsw = (unsigned)wid * 1024u;
    const int aoff = lds_byte(wr * 64 + fr, fq * 8), boff = lds_byte(wc * 32 + fr, fq * 8);
#define PG8_SA(b, h) (((b) * 2 + (h)) * HTB)
#define PG8_SB(b, h) ((4 + (b) * 2 + (h)) * HTB)
#define PG8_STAGE(bufoff, gbase, voff) do { _Pragma("unroll") for (int _i = 0; _i < 2; ++_i) \
        __builtin_amdgcn_global_load_lds((const unsigned*)((const char*)(gbase) + (voff)[_i]), (PG8_LAS unsigned*)(lds + (bufoff) + ldsw + _i * 8192), 16, 0, 0); } while (0)
#define PG8_LDA(dst, b, h) do { _Pragma("unroll") for (int m = 0; m < 4; ++m) _Pragma("unroll") for (int k = 0; k < 2; ++k) dst[m][k] = *(const PG8_LAS bf16x8*)(lds + PG8_SA(b, h) + aoff + m * 2048 + k * 1024); } while (0)
#define PG8_LDB(dst, b, h) do { _Pragma("unroll") for (int n = 0; n < 2; ++n) _Pragma("unroll") for (int k = 0; k < 2; ++k) dst[n][k] = *(const PG8_LAS bf16x8*)(lds + PG8_SB(b, h) + boff + n * 2048 + k * 1024); } while (0)
#define PG8_MMA(ai, bj, At, Bt) do { __builtin_amdgcn_s_setprio(1); _Pragma("unroll") for (int m = 0; m < 4; ++m) _Pragma("unroll") for (int n = 0; n < 2; ++n) _Pragma("unroll") for (int k = 0; k < 2; ++k) \
        acc[ai][bj][m][n] = __builtin_amdgcn_mfma_f32_16x16x32_bf16(Bt[n][k], At[m][k], acc[ai][bj][m][n], 0, 0, 0); __builtin_amdgcn_s_setprio(0); } while (0)
#define PG8_WAIT_V(n) asm volatile("s_waitcnt vmcnt(" #n ")" ::: "memory")
#define PG8_WAIT_L(n) asm volatile("s_waitcnt lgkmcnt(" #n ")" ::: "memory")
#define PG8_BAR __builtin_amdgcn_s_barrier()
#define PG8_SCHED __builtin_amdgcn_sched_barrier(0)
    Unit cur, nxt; int ui = 0;
    if (!S.next(0, cur)) return;
    f32x4 acc[2][2][4][2];
#pragma unroll
    for (int a = 0; a < 2; ++a)
#pragma unroll
        for (int b = 0; b < 2; ++b)
#pragma unroll
            for (int m = 0; m < 4; ++m)
#pragma unroll
                for (int n = 0; n < 2; ++n) acc[a][b][m][n] = (f32x4){0.f, 0.f, 0.f, 0.f};
    bf16x8 At[4][2], B0[2][2], B1[2][2];
    const char* cA = (const char*)g.A + (size_t)cur.pm * tstep; const char* cB = (const char*)g.Bt + (size_t)cur.pn * tstep;
    S.a_ready(cur);
    if constexpr (SP2) {
        PG8_STAGE(PG8_SB(0, 0), cB, voffB); PG8_STAGE(PG8_SB(0, 1), cB + hstep, voffB); PG8_STAGE(PG8_SA(0, 0), cA, voffA); PG8_STAGE(PG8_SA(0, 1), cA + hstep, voffA);
        if (wr == 1) PG8_BAR;
        PG8_WAIT_V(2); PG8_BAR;
        PG8_STAGE(PG8_SB(1, 0), cB + kstep, voffB); PG8_STAGE(PG8_SA(1, 0), cA + kstep, voffA); PG8_STAGE(PG8_SB(1, 1), cB + hstep + kstep, voffB);
        PG8_WAIT_V(6); PG8_BAR;
    } else {
        PG8_STAGE(PG8_SB(0, 0), cB, voffB); PG8_STAGE(PG8_SA(0, 0), cA, voffA); PG8_STAGE(PG8_SB(0, 1), cB + hstep, voffB); PG8_STAGE(PG8_SA(0, 1), cA + hstep, voffA);
        if (wr == 1) PG8_BAR;
        PG8_WAIT_V(4); PG8_BAR;
        PG8_STAGE(PG8_SB(1, 0), cB + kstep, voffB); PG8_STAGE(PG8_SA(1, 0), cA + kstep, voffA); PG8_STAGE(PG8_SB(1, 1), cB + hstep + kstep, voffB);
        PG8_WAIT_V(6); PG8_BAR;
    }
    for (;;) {
        const bool has_next = S.next(ui + 1, nxt);
        const char* nA = has_next ? (const char*)g.A + (size_t)nxt.pm * tstep : cA; const char* nB = has_next ? (const char*)g.Bt + (size_t)nxt.pn * tstep : cB;
        for (int t = 0; t < nt; t += 2) {
            const bool last = (t == nt - 2);
            const char* a1 = cA + (size_t)(t + 1) * kstep;
            const char* a2 = last ? nA : cA + (size_t)(t + 2) * kstep; const char* b2 = last ? nB : cB + (size_t)(t + 2) * kstep;
            const char* a3 = a2 + kstep; const char* b3 = b2 + kstep;
            if (last && has_next) S.a_ready(nxt);
            if constexpr (SP2) {
            PG8_LDB(B0, 0, 0); PG8_LDB(B1, 0, 1); PG8_SCHED; PG8_LDA(At, 0, 0); PG8_STAGE(PG8_SA(1, 1), a1 + hstep, voffA);
            PG8_WAIT_V(8); PG8_WAIT_L(0); PG8_BAR; PG8_MMA(0, 0, At, B0); PG8_MMA(0, 1, At, B1); PG8_BAR; PG8_SCHED;
            PG8_LDA(At, 0, 1); PG8_STAGE(PG8_SB(0, 0), b2, voffB); PG8_STAGE(PG8_SB(0, 1), b2 + hstep, voffB); PG8_STAGE(PG8_SA(0, 0), a2, voffA);
            PG8_WAIT_V(8); PG8_WAIT_L(0); PG8_BAR; PG8_MMA(1, 0, At, B0); PG8_MMA(1, 1, At, B1); PG8_BAR; PG8_SCHED;
            PG8_LDB(B0, 1, 0); PG8_LDB(B1, 1, 1); PG8_SCHED; PG8_LDA(At, 1, 0); PG8_STAGE(PG8_SA(0, 1), a2 + hstep, voffA);
            PG8_WAIT_V(8); PG8_WAIT_L(0); PG8_BAR; PG8_MMA(0, 0, At, B0); PG8_MMA(0, 1, At, B1); PG8_BAR; PG8_SCHED;
            PG8_LDA(At, 1, 1); PG8_STAGE(PG8_SB(1, 0), b3, voffB); PG8_STAGE(PG8_SB(1, 1), b3 + hstep, voffB); PG8_STAGE(PG8_SA(1, 0), a3, voffA);
            PG8_WAIT_V(8); PG8_WAIT_L(0); PG8_BAR; PG8_MMA(1, 0, At, B0); PG8_MMA(1, 1, At, B1); PG8_BAR; PG8_SCHED;
            } else {
            PG8_LDB(B0, 0, 0); PG8_SCHED; PG8_LDA(At, 0, 0); PG8_STAGE(PG8_SA(1, 1), a1 + hstep, voffA);
            PG8_WAIT_L(8); PG8_BAR; PG8_WAIT_L(0); PG8_MMA(0, 0, At, B0); PG8_BAR; PG8_SCHED;
            PG8_LDB(B1, 0, 1); PG8_STAGE(PG8_SB(0, 0), b2, voffB);
            PG8_BAR; PG8_WAIT_L(0); PG8_MMA(0, 1, At, B1); PG8_BAR;
            PG8_LDA(At, 0, 1); PG8_STAGE(PG8_SA(0, 0), a2, voffA);
            PG8_BAR; PG8_WAIT_L(0); PG8_MMA(1, 0, At, B0); PG8_BAR; PG8_SCHED;
            PG8_STAGE(PG8_SB(0, 1), b2 + hstep, voffB);
            PG8_WAIT_V(6); PG8_BAR; PG8_MMA(1, 1, At, B1); PG8_BAR;
            PG8_LDB(B0, 1, 0); PG8_SCHED; PG8_LDA(At, 1, 0); PG8_STAGE(PG8_SA(0, 1), a2 + hstep, voffA);
            PG8_WAIT_L(8); PG8_BAR; PG8_WAIT_L(0); PG8_MMA(0, 0, At, B0); PG8_BAR; PG8_SCHED;
            PG8_LDB(B1, 1, 1); PG8_STAGE(PG8_SB(1, 0), b3, voffB);
            PG8_BAR; PG8_WAIT_L(0); PG8_MMA(0, 1, At, B1); PG8_BAR;
            PG8_LDA(At, 1, 1); PG8_STAGE(PG8_SA(1, 0), a3, voffA);
            PG8_BAR; PG8_WAIT_L(0); PG8_MMA(1, 0, At, B0); PG8_BAR; PG8_SCHED;
            PG8_STAGE(PG8_SB(1, 1), b3 + hstep, voffB);
            PG8_WAIT_V(6); PG8_BAR; PG8_MMA(1, 1, At, B1); PG8_BAR;
            }
        }
        if constexpr (ALIGN_EPI) { if (wr == 0) PG8_BAR; }
        if constexpr (!Epi::AFTER_DRAIN) { E(acc, cur, wr, wc, fr, fq); S.done(cur); }
        if (!has_next) break;
#pragma unroll
        for (int a = 0; a < 2; ++a)
#pragma unroll
            for (int b = 0; b < 2; ++b)
#pragma unroll
                for (int m = 0; m < 4; ++m)
#pragma unroll
                    for (int n = 0; n < 2; ++n) acc[a][b][m][n] = (f32x4){0.f, 0.f, 0.f, 0.f};
        cur = nxt; cA = nA; cB = nB; ++ui;
        if constexpr (ALIGN_EPI) { if (wr == 1) PG8_BAR; }
    }
    PG8_WAIT_V(0);
    if constexpr (!ALIGN_EPI) { if (wr == 0) PG8_BAR; }
    PG8_BAR;
    if constexpr (Epi::AFTER_DRAIN) { E.fused(acc, cur, wr, wc, fr, fq, lds, wid, lane); S.done(cur); }
#undef PG8_SA
#undef PG8_SB
#undef PG8_STAGE
#undef PG8_LDA
#undef PG8_LDB
#undef PG8_MMA
#undef PG8_WAIT_V
#undef PG8_WAIT_L
#undef PG8_BAR
#undef PG8_SCHED
}
}
namespace att {
using bf16x8 = __attribute__((ext_vector_type(8))) short;
using s16x4  = __attribute__((ext_vector_type(4))) short;
using f32x16 = __attribute__((ext_vector_type(16))) float;
using u32x4  = __attribute__((ext_vector_type(4))) unsigned;
typedef unsigned short bf16_t;
constexpr int DQK = 96, DV = 64, NW = 8, QBLK = 32, KVBLK = 64;
constexpr float SCALE = 0.10206207261596575f;
constexpr float THR = 8.f;
constexpr int SHM_V = KVBLK * DV * 2, SHM_K = KVBLK * 256;
constexpr int OFF_V = 0, OFF_K = 2 * SHM_V, OFF_WS = OFF_K + 2 * SHM_K, OFF_OST = OFF_WS + NW * 64 * 4, SHM_ATTN = OFF_OST + NW * 4096;
#define KSWZ(row, colB) ((row) * 256 + ((colB) ^ (((row) & 15) << 4)))
#define SBAR() __builtin_amdgcn_sched_barrier(0)
__device__ __forceinline__ int crow(int r, int hi) { return (r & 3) + 8 * (r >> 2) + 4 * hi; }
__device__ __forceinline__ unsigned cvtpk(float lo, float hi) { unsigned r; asm volatile("v_cvt_pk_bf16_f32 %0, %1, %2" : "=v"(r) : "v"(lo), "v"(hi)); return r; }
__device__ __forceinline__ bf16x8 ld8(const bf16_t* p) { return *reinterpret_cast<const bf16x8*>(p); }

__device__ __forceinline__ void partialSM(f32x16& p0, f32x16& p1, float& m_reg, float& mn, float& alpha) {
  constexpr float C = SCALE * 1.4426950408889634f;
  float pmax = p0[0];
#pragma unroll
  for (int r = 1; r < 16; ++r) pmax = fmaxf(pmax, p0[r]);
#pragma unroll
  for (int r = 0; r < 16; ++r) pmax = fmaxf(pmax, p1[r]);
  { auto rr = __builtin_amdgcn_permlane32_swap(__float_as_uint(pmax), __float_as_uint(pmax), false, false);
    pmax = fmaxf(__uint_as_float(rr[0]), __uint_as_float(rr[1])); }
  if (__builtin_expect(__all(pmax - m_reg <= THR / SCALE), 1)) { mn = m_reg; alpha = 1.f; }
  else { mn = fmaxf(m_reg, pmax); alpha = __builtin_amdgcn_exp2f((m_reg - mn) * C); m_reg = mn; }
  float mnC = -mn * C;
#pragma unroll
  for (int r = 0; r < 16; ++r) p0[r] = fmaf(p0[r], C, mnC);
#pragma unroll
  for (int r = 0; r < 16; ++r) p1[r] = fmaf(p1[r], C, mnC);
#pragma unroll
  for (int r = 0; r < 16; ++r) p0[r] = __builtin_amdgcn_exp2f(p0[r]);
}
__device__ __forceinline__ void finishSM(f32x16& p0, f32x16& p1, float alpha, float& l_reg, bf16x8& pa0, bf16x8& pa1, bf16x8& pa2, bf16x8& pa3) {
#pragma unroll
  for (int r = 0; r < 16; ++r) p1[r] = __builtin_amdgcn_exp2f(p1[r]);
  float ps = 0;
#pragma unroll
  for (int r = 0; r < 16; ++r) ps += p0[r];
#pragma unroll
  for (int r = 0; r < 16; ++r) ps += p1[r];
  { auto rr = __builtin_amdgcn_permlane32_swap(__float_as_uint(ps), __float_as_uint(ps), false, false);
    ps = __uint_as_float(rr[0]) + __uint_as_float(rr[1]); }
  l_reg = l_reg * alpha + ps;
#define PK4(P, BASE, OUT) do { unsigned a0 = cvtpk(P[BASE + 0], P[BASE + 1]), a1 = cvtpk(P[BASE + 2], P[BASE + 3]);   \
    unsigned b0 = cvtpk(P[BASE + 4], P[BASE + 5]), b1 = cvtpk(P[BASE + 6], P[BASE + 7]);                              \
    auto r0 = __builtin_amdgcn_permlane32_swap(a0, b0, false, false); auto r1 = __builtin_amdgcn_permlane32_swap(a1, b1, false, false); \
    u32x4 w = {r0[0], r1[0], r0[1], r1[1]}; OUT = *reinterpret_cast<bf16x8*>(&w); } while (0)
  PK4(p0, 0, pa0); PK4(p0, 8, pa1); PK4(p1, 0, pa2); PK4(p1, 8, pa3);
#undef PK4
}
__device__ __forceinline__ void qkt(f32x16& p0, f32x16& p1, const char* Ks, const bf16x8* qr, int r32, int hi) {
  p0 = f32x16{}; p1 = f32x16{};
#pragma unroll
  for (int d0 = 0; d0 < 6; ++d0) { int cb = (d0 * 16 + hi * 8) * 2;
    bf16x8 b0 = *reinterpret_cast<const bf16x8*>(Ks + KSWZ(r32, cb));
    bf16x8 b1 = *reinterpret_cast<const bf16x8*>(Ks + KSWZ(32 + r32, cb));
    p0 = __builtin_amdgcn_mfma_f32_32x32x16_bf16(b0, qr[d0], p0, 0, 0, 0);
    p1 = __builtin_amdgcn_mfma_f32_32x32x16_bf16(b1, qr[d0], p1, 0, 0, 0); }
}
__device__ __forceinline__ int v_st(int k, int c) { const int kk = (k & ~0xC) | ((k & 4) << 1) | ((k & 8) >> 1); return ((kk >> 3) * 2 + (c >> 5)) * 512 + ((kk & 7) * 32 + (c & 31)) * 2; }
__device__ __forceinline__ int v_rd_base(int lane) { return ((lane & 3) << 3) | (((lane >> 2) & 3) << 6) | (((lane >> 4) & 1) << 5) | (((lane >> 5) & 1) << 8); }
constexpr int v_rd_off(int d0, int ks, int half) { return d0 * 512 + ks * 2048 + half * 1024; }
template <int OFF> __device__ __forceinline__ s16x4 tr_read(int vb) {
  s16x4 r; asm volatile("ds_read_b64_tr_b16 %0, %1 offset:%2" : "=&v"(r) : "v"(vb), "i"(OFF) : "memory"); return r;
}
template <int D0> __device__ __forceinline__ void pv_one(f32x16& od, int vb, bf16x8 pa0, bf16x8 pa1, bf16x8 pa2, bf16x8 pa3) {
  const s16x4 l0 = tr_read<v_rd_off(D0, 0, 0)>(vb), h0 = tr_read<v_rd_off(D0, 0, 1)>(vb), l1 = tr_read<v_rd_off(D0, 1, 0)>(vb), h1 = tr_read<v_rd_off(D0, 1, 1)>(vb);
  const s16x4 l2 = tr_read<v_rd_off(D0, 2, 0)>(vb), h2 = tr_read<v_rd_off(D0, 2, 1)>(vb), l3 = tr_read<v_rd_off(D0, 3, 0)>(vb), h3 = tr_read<v_rd_off(D0, 3, 1)>(vb);
  asm volatile("s_waitcnt lgkmcnt(0)" ::: "memory"); SBAR();
#define PK(L, H) (bf16x8){L[0], L[1], L[2], L[3], H[0], H[1], H[2], H[3]}
  od = __builtin_amdgcn_mfma_f32_32x32x16_bf16(pa0, PK(l0, h0), od, 0, 0, 0);
  od = __builtin_amdgcn_mfma_f32_32x32x16_bf16(pa1, PK(l1, h1), od, 0, 0, 0);
  od = __builtin_amdgcn_mfma_f32_32x32x16_bf16(pa2, PK(l2, h2), od, 0, 0, 0);
  od = __builtin_amdgcn_mfma_f32_32x32x16_bf16(pa3, PK(l3, h3), od, 0, 0, 0);
#undef PK
}
__device__ __forceinline__ void pv_d0(f32x16* o, int vb, bf16x8 pa0, bf16x8 pa1, bf16x8 pa2, bf16x8 pa3) {
  pv_one<0>(o[0], vb, pa0, pa1, pa2, pa3); pv_one<1>(o[1], vb, pa0, pa1, pa2, pa3);
}
__device__ __forceinline__ void attn_unit(const bf16_t* __restrict__ Qb, const bf16_t* __restrict__ Kh, const bf16_t* __restrict__ Vh, bf16_t* __restrict__ Ob, int ldo, int seq, char* lds) {
  const int tid = threadIdx.x, wid = tid >> 6, lane = tid & 63, r32 = lane & 31, hi = lane >> 5;
  char* V_lds = lds + OFF_V; char* K_lds = lds + OFF_K;
  float* ws = (float*)(lds + OFF_WS) + wid * 64; float* li_l = ws; float* al_l = ws + 32;
  float m_reg = -1e30f, l_reg = 0; f32x16 o[2] = {}; bf16x8 qr[6];
  const bf16_t* Qw = Qb + (long)(wid * QBLK + r32) * DQK + hi * 8;
#pragma unroll
  for (int d0 = 0; d0 < 6; ++d0) qr[d0] = ld8(Qw + d0 * 16);
  const int kid1 = (tid < 256) ? 512 + tid : tid;
  const int kr0 = tid / 12, kc0 = tid % 12, kr1 = kid1 / 12, kc1 = kid1 % 12;
  const int kst0 = KSWZ(kr0, kc0 * 16), kst1 = KSWZ(kr1, kc1 * 16);
  const int vst = v_st(tid >> 3, (tid & 7) * 8);
  const int vb0 = (int)(uintptr_t)V_lds + v_rd_base(lane);
  const bool w2 = tid < 256;
  struct { bf16x8 vs, ks0, ks1; } sr_[2];
#define SLOAD(i, k0) do { sr_[i].vs = ld8(Vh + (long)(k0) * DV + tid * 8); sr_[i].ks0 = ld8(Kh + (long)(k0) * DQK + tid * 8); sr_[i].ks1 = ld8(Kh + (long)(k0) * DQK + kid1 * 8); } while (0)
#define SWRITE(b, i) do { *(bf16x8*)(V_lds + (b) * SHM_V + vst) = sr_[i].vs; *(bf16x8*)(K_lds + (b) * SHM_K + kst0) = sr_[i].ks0; \
    if (w2) *(bf16x8*)(K_lds + (b) * SHM_K + kst1) = sr_[i].ks1; } while (0)
#define SWAIT() asm volatile("s_waitcnt vmcnt(3)" ::: "memory")
#define RESC(a) do { if (__any((a) < 1.f)) { if (hi == 0) al_l[r32] = (a); asm volatile("s_waitcnt lgkmcnt(0)" ::: "memory"); \
    _Pragma("unroll") for (int d = 0; d < 2; ++d) _Pragma("unroll") for (int r = 0; r < 16; ++r) o[d][r] *= al_l[crow(r, hi)]; } } while (0)
  f32x16 pA0, pA1, pB0, pB1; float mnA, mnB, alA, alB; bf16x8 pa0, pa1, pa2, pa3; const int NT = seq / KVBLK;
  SLOAD(0, 0); asm volatile("s_waitcnt vmcnt(0)" ::: "memory"); SWRITE(0, 0); __syncthreads();
  qkt(pA0, pA1, K_lds, qr, r32, hi); partialSM(pA0, pA1, m_reg, mnA, alA);
  SLOAD(1, KVBLK); if (2 < NT) SLOAD(0, 2 * KVBLK);
  SWAIT(); SWRITE(1, 1); __syncthreads();
  for (int j = 1; j + 1 < NT; j += 2) {
    SBAR(); qkt(pB0, pB1, K_lds + SHM_K, qr, r32, hi);
    finishSM(pA0, pA1, alA, l_reg, pa0, pa1, pa2, pa3); SBAR();
    SLOAD(1, (j + 2) * KVBLK); SBAR();
    pv_d0(o, vb0, pa0, pa1, pa2, pa3); partialSM(pB0, pB1, m_reg, mnB, alB);
    __syncthreads(); SWAIT(); SWRITE(0, 0);
    RESC(alB); __syncthreads();
    SBAR(); qkt(pA0, pA1, K_lds, qr, r32, hi);
    finishSM(pB0, pB1, alB, l_reg, pa0, pa1, pa2, pa3); SBAR();
    if (j + 3 < NT) SLOAD(0, (j + 3) * KVBLK); SBAR();
    pv_d0(o, vb0 + SHM_V, pa0, pa1, pa2, pa3); partialSM(pA0, pA1, m_reg, mnA, alA);
    __syncthreads(); SWAIT(); SWRITE(1, 1);
    RESC(alA); __syncthreads();
  }
  SBAR(); qkt(pB0, pB1, K_lds + SHM_K, qr, r32, hi);
  finishSM(pA0, pA1, alA, l_reg, pa0, pa1, pa2, pa3); SBAR();
  pv_d0(o, vb0, pa0, pa1, pa2, pa3); partialSM(pB0, pB1, m_reg, mnB, alB);
  __syncthreads(); RESC(alB);
  finishSM(pB0, pB1, alB, l_reg, pa0, pa1, pa2, pa3); SBAR();
  pv_d0(o, vb0 + SHM_V, pa0, pa1, pa2, pa3);
  if (hi == 0) li_l[r32] = l_reg; asm volatile("s_waitcnt lgkmcnt(0)" ::: "memory");
  float rli[16];
#pragma unroll
  for (int r = 0; r < 16; ++r) rli[r] = __builtin_amdgcn_rcpf(li_l[crow(r, hi)]);
  bf16_t* Ow = Ob + (long)(wid * QBLK) * ldo;
  { bf16_t* stg = (bf16_t*)(lds + OFF_OST) + wid * 2048;
#pragma unroll
    for (int r = 0; r < 16; ++r) { const int orow = crow(r, hi);
#pragma unroll
      for (int d0 = 0; d0 < 2; ++d0) { const unsigned pk = cvtpk(o[d0][r] * rli[r], 0.f); stg[orow * 64 + d0 * 32 + r32] = (bf16_t)(pk & 0xffffu); } }
    asm volatile("s_waitcnt lgkmcnt(0)" ::: "memory");
#pragma unroll
    for (int i = 0; i < 4; ++i) { const int row = i * 8 + (lane >> 3), ch = lane & 7; const u32x4 v = *(const u32x4*)(stg + row * 64 + ch * 8); *(u32x4*)(Ow + (long)row * ldo + ch * 8) = v; } }
  __syncthreads();
#undef SLOAD
#undef SWRITE
#undef SWAIT
#undef RESC
}
#undef KSWZ
#undef SBAR
}

#define GAS __attribute__((address_space(1)))
#define LAS __attribute__((address_space(3)))
typedef unsigned short bf16;
typedef unsigned v4u __attribute__((ext_vector_type(4)));
typedef float f32x4 __attribute__((ext_vector_type(4)));
typedef short bf16x8 __attribute__((ext_vector_type(8)));
typedef GAS unsigned gu32;
typedef GAS unsigned long long gu64;
#define RLX_AGENT __ATOMIC_RELAXED, __HIP_MEMORY_SCOPE_AGENT
#define LDS_WAIT() asm volatile("s_waitcnt lgkmcnt(0)" ::: "memory")
#define VM_WAIT() asm volatile("s_waitcnt vmcnt(0)" ::: "memory")
__device__ __forceinline__ unsigned long long rt() { return __builtin_amdgcn_s_memrealtime(); }
__device__ __forceinline__ unsigned f2bf(float f) { unsigned u = __builtin_bit_cast(unsigned, f); return (u + 0x7fffu + ((u >> 16) & 1u)) >> 16; }
__device__ __forceinline__ unsigned pk2(float lo, float hi) { return f2bf(lo) | (f2bf(hi) << 16); }

#define XB_TMO      128
#define XB_XCNT(j)  (256  + 64 * (j))
#define XB_XSUB(j)  (1280 + 64 * (j))
#define XB_XGEN(j)  (2304 + 64 * (j))
#define XB_TOP      3328
#define XB_TOPGEN   3392
#define XCD_BAR_WORDS 3456
#define XB_SPIN_CAP (1u << 18)

__device__ __forceinline__ unsigned xb_ld(unsigned* p)              { return __hip_atomic_load(p, __ATOMIC_RELAXED, __HIP_MEMORY_SCOPE_AGENT); }
__device__ __forceinline__ unsigned xb_add(unsigned* p, unsigned v) { return __hip_atomic_fetch_add(p, v, __ATOMIC_RELAXED, __HIP_MEMORY_SCOPE_AGENT); }
__device__ __forceinline__ unsigned xb_xcc_id() { return (unsigned)__builtin_amdgcn_s_getreg((3 << 11) | 20) & 0xFu; }
#define XB_SPIN(cond, bar) do { unsigned _sp = 0; while (cond) { __builtin_amdgcn_s_sleep(1); \
    if ((++_sp & 255u) == 0u) { if (xb_ld(&(bar)[XB_TMO])) break; if (_sp > XB_SPIN_CAP) { atomicAdd(&(bar)[XB_TMO], 1u); break; } } } } while (0)

struct XcdBarrier {
    unsigned* bar; unsigned x;
    volatile LAS unsigned* st;
};

__device__ __forceinline__ XcdBarrier xcd_barrier_post(unsigned* bar, volatile LAS unsigned* st) {
    XcdBarrier b; b.bar = bar; b.x = xb_xcc_id(); b.st = st;
    if (threadIdx.x == 0) (void)xb_add(&bar[XB_XCNT(b.x)], 1u);
    return b;
}
__device__ __forceinline__ void xcd_barrier_complete(unsigned* bar, unsigned x, unsigned& nloc, unsigned& nx) {
    const unsigned G = gridDim.x * gridDim.y * gridDim.z;
    unsigned sum, cnt, mine, sp = 0u;
    for (;;) {
        sum = 0u; cnt = 0u; mine = 0u;
#pragma unroll
        for (unsigned j = 0; j < 16; ++j) { const unsigned c = xb_ld(&bar[XB_XCNT(j)]); sum += c; cnt += (c > 0u) ? 1u : 0u; mine = (j == x) ? c : mine; }
        if (sum == G) break;
        __builtin_amdgcn_s_sleep(1);
        if ((++sp & 255u) == 0u) { if (xb_ld(&bar[XB_TMO])) break; if (sp > XB_SPIN_CAP) { atomicAdd(&bar[XB_TMO], 1u); break; } }
    }
    nloc = mine > 0u ? mine : 1u; nx = cnt > 0u ? cnt : 1u;
}

__device__ __forceinline__ void xcd_barrier(const XcdBarrier& b) {
    asm volatile("s_waitcnt vmcnt(0)" ::: "memory");
    __syncthreads();
    if (threadIdx.x == 0) {
        unsigned* bar = b.bar;
        __builtin_amdgcn_s_waitcnt(0);
        unsigned nloc = b.st[0], nx = b.st[1];
        if (nloc == 0u) { xcd_barrier_complete(bar, b.x, nloc, nx); b.st[0] = nloc; b.st[1] = nx; }
        const unsigned old = xb_add(&bar[XB_XSUB(b.x)], 1u);
        const unsigned gen = old / nloc;
        if (old + 1u == (gen + 1u) * nloc) {
            __builtin_amdgcn_fence(__ATOMIC_RELEASE, "agent");
            asm volatile("s_waitcnt vmcnt(0)" ::: "memory");
            const unsigned og = xb_add(&bar[XB_TOP], 1u);
            const unsigned tg = og / nx;
            if (og + 1u == (tg + 1u) * nx) xb_add(&bar[XB_TOPGEN], 1u);
            else XB_SPIN(xb_ld(&bar[XB_TOPGEN]) == tg, bar);
            __builtin_amdgcn_fence(__ATOMIC_ACQUIRE, "agent");
            xb_add(&bar[XB_XGEN(b.x)], 1u);
            asm volatile("s_waitcnt vmcnt(0)" ::: "memory");
        } else {
            XB_SPIN(xb_ld(&bar[XB_XGEN(b.x)]) == gen, bar);
            __builtin_amdgcn_fence(__ATOMIC_ACQUIRE, "agent");
            asm volatile("s_waitcnt vmcnt(0)" ::: "memory");
        }
    }
    __syncthreads();
}

constexpr int NWAVES = 8;
constexpr int BATCH = 16, SEQ = 2048, DM = 1024, M = BATCH * SEQ, DFF = 2816, NMOD = 9216, WIN = 1440, WINP = 1536, NH = 8;
constexpr float EPS = 1e-6f;
constexpr size_t MiB = 1u << 20;
constexpr size_t WS_CTL = 0, CTL_ZERO_BYTES = 1 * MiB;
constexpr size_t WS_MOD = 1 * MiB, WS_ROPE = 2 * MiB;
constexpr size_t WS_W1T = 6 * MiB, WS_WD1T = 17 * MiB, WS_W2T = 23 * MiB, WS_WD2T = 34 * MiB, WS_WINT = 40 * MiB, WS_WQT = 43 * MiB, WS_WKVT = 43 * MiB + 512 * 1024, WS_WOUTT = 44 * MiB;
constexpr size_t WS_A1 = 48 * MiB, WS_ACT = 112 * MiB, WS_ZG = 112 * MiB, WS_ZC = 144 * MiB, WS_Q = 176 * MiB, WS_K = 224 * MiB, WS_V = 288 * MiB, WS_MIX = 320 * MiB, WS_END = 384 * MiB;
static_assert(WS_W1T + (size_t)2 * DFF * DM * 2 <= WS_WD1T && WS_WD1T + (size_t)DM * DFF * 2 <= WS_W2T && WS_WD2T + (size_t)DM * DFF * 2 <= WS_WINT && WS_WINT + (size_t)WINP * DM * 2 <= WS_WQT, "weights map");
static_assert(WS_ACT + (size_t)M * DFF * 2 <= WS_V && WS_K + (size_t)M * 768 * 2 <= WS_V && WS_MIX + (size_t)M * DM * 2 <= WS_END, "ws map");
constexpr int CW_TMO = 0, CW_BAR = 4096;
constexpr int LDS_BYTES = 147456, MISC_OFF = LDS_BYTES - 256;
constexpr int NPHASE = 13;
#ifndef MK_N_LAUNCHES
#define MK_N_LAUNCHES 13
#endif

__device__ __forceinline__ unsigned cvtpk(float lo, float hi) { unsigned r; asm volatile("v_cvt_pk_bf16_f32 %0, %1, %2" : "=v"(r) : "v"(lo), "v"(hi)); return r; }
__device__ __forceinline__ float bf_lo(unsigned w) { return __uint_as_float(w << 16); }
__device__ __forceinline__ float bf_hi(unsigned w) { return __uint_as_float(w & 0xffff0000u); }
__device__ __forceinline__ float sigm(float x) { return __builtin_amdgcn_rcpf(1.0f + __builtin_amdgcn_exp2f(-1.4426950408889634f * x)); }
__device__ __forceinline__ float wave_sum(float v) {
#pragma unroll
    for (int o = 1; o < 64; o <<= 1) v += __shfl_xor(v, o);
    return v;
}
__device__ __forceinline__ float swap_add(float v) { auto rr = __builtin_amdgcn_permlane32_swap(__float_as_uint(v), __float_as_uint(v), false, false); return __uint_as_float(rr[0]) + __uint_as_float(rr[1]); }

struct Args { const void* in[24]; float* out; unsigned char* ws; double invf[16]; int ph_lo, ph_hi, li, pad; };

struct Frame {
    char* lds;
    volatile LAS unsigned* MISC;
    gu32* ctl;
    int tid, lane, wave, vcu, G;
    unsigned char* ws;
};

__device__ __forceinline__ void ph_mod(Frame& F, const float* c, const float* w_ada, const float* b_ada, float* mod) {
    float* sc = (float*)F.lds;
    float* red = (float*)(F.lds + 65536);
    for (int idx = F.tid; idx < 16384; idx += 512) { const int b = idx >> 10, k = idx & 1023; const float v = c[idx]; sc[k * 16 + b] = v * sigm(v); }
    __syncthreads();
    for (int u = blockIdx.x; u < 256; u += F.G) {
        const int j0 = u * 36, kg = F.tid / 36, col = F.tid % 36;
        if (kg < 14) {
            f32x4 a0 = {0.f, 0.f, 0.f, 0.f}, a1 = a0, a2 = a0, a3 = a0;
            const float* wp = w_ada + j0 + col;
#pragma unroll 4
            for (int k = kg; k < 1024; k += 14) {
                const float w = wp[(size_t)k * NMOD];
                const f32x4* s = (const f32x4*)(sc + k * 16);
                a0 += s[0] * w; a1 += s[1] * w; a2 += s[2] * w; a3 += s[3] * w;
            }
            f32x4* rp = (f32x4*)(red + (kg * 36 + col) * 16);
            rp[0] = a0; rp[1] = a1; rp[2] = a2; rp[3] = a3;
        }
        __syncthreads();
        for (int idx = F.tid; idx < 576; idx += 512) { const int cl = idx >> 4, b = idx & 15; float s = 0.f;
#pragma unroll
            for (int g = 0; g < 14; ++g) s += red[(g * 36 + cl) * 16 + b];
            mod[(size_t)b * NMOD + j0 + cl] = s + b_ada[j0 + cl]; }
        __syncthreads();
    }
}

template <int MODE> __device__ __forceinline__ void ph_rownorm(Frame& F, const float* src, const float* sc, const float* sh, bf16* dstb, float* dstf) {
    const int gw = F.vcu * NWAVES + F.wave, NGW = F.G * NWAVES, lane = F.lane;
    for (int rb = gw; rb < M / 16; rb += NGW) {
        const int row0 = rb * 16, b = row0 >> 11;
        f32x4 s[4], t[4];
#pragma unroll
        for (int j = 0; j < 4; ++j) {
            if (MODE == 0) { s[j] = *(const f32x4*)(sc + (size_t)b * NMOD + 4 * lane + 256 * j) + 1.0f; t[j] = *(const f32x4*)(sh + (size_t)b * NMOD + 4 * lane + 256 * j); }
            else { s[j] = *(const f32x4*)(sc + 4 * lane + 256 * j); t[j] = (f32x4){0.f, 0.f, 0.f, 0.f}; }
        }
#pragma unroll 2
        for (int r = 0; r < 16; ++r) {
            const f32x4* xr = (const f32x4*)(src + (size_t)(row0 + r) * DM) + lane;
            f32x4 v[4]; float ss = 0.f;
#pragma unroll
            for (int j = 0; j < 4; ++j) { v[j] = xr[64 * j]; ss += (v[j].x * v[j].x + v[j].y * v[j].y) + (v[j].z * v[j].z + v[j].w * v[j].w); }
            const float rs = __builtin_amdgcn_rsqf(wave_sum(ss) * (1.0f / DM) + EPS);
            if (MODE == 0) {
                unsigned long long* o8 = (unsigned long long*)(dstb + (size_t)(row0 + r) * DM) + lane;
#pragma unroll
                for (int j = 0; j < 4; ++j) { const f32x4 o = v[j] * rs * s[j] + t[j]; o8[64 * j] = (unsigned long long)cvtpk(o.x, o.y) | ((unsigned long long)cvtpk(o.z, o.w) << 32); }
            } else {
                f32x4* o4 = (f32x4*)(dstf + (size_t)(row0 + r) * DM) + lane;
#pragma unroll
                for (int j = 0; j < 4; ++j) o4[64 * j] = v[j] * rs * s[j];
            }
        }
    }
}

__device__ __forceinline__ void transpose_item(const float* W, int K, int N, bf16* WT, int k0, int n0, int drow0, const float* kscale, float* scr, int lane) {
#pragma unroll 8
    for (int i = 0; i < 32; ++i) { const int kk = 2 * i + (lane >> 5); float v = W[(size_t)(k0 + kk) * N + n0 + (lane & 31)]; if (kscale) v *= kscale[k0 + kk]; scr[kk * 33 + (lane & 31)] = v; }
    LDS_WAIT(); asm volatile("" ::: "memory");
    const int c = lane & 7;
#pragma unroll
    for (int j = 0; j < 4; ++j) { const int n = (lane >> 3) + 8 * j; const float* s = scr + (8 * c) * 33 + n;
        v4u o; o.x = cvtpk(s[0 * 33], s[1 * 33]); o.y = cvtpk(s[2 * 33], s[3 * 33]); o.z = cvtpk(s[4 * 33], s[5 * 33]); o.w = cvtpk(s[6 * 33], s[7 * 33]);
        *(v4u*)(WT + (size_t)(drow0 + n) * K + k0 + 8 * c) = o; }
    LDS_WAIT(); asm volatile("" ::: "memory");
}
__device__ __forceinline__ int drow_of(int kind, int n0) {
    if (kind == 0) return n0;
    if (kind == 1) return 256 * (n0 >> 7) + (n0 & 127);
    if (kind == 2) return 256 * (n0 >> 7) + 128 + (n0 & 127);
    if (n0 < 512) return 256 * (n0 >> 7) + (n0 & 127);
    if (n0 < 1024) return 256 * ((n0 - 512) >> 7) + 128 + (n0 & 127);
    return n0;
}
__device__ __forceinline__ void ph_prep(Frame& F, const Args& a) {
    const float* const* in = (const float* const*)a.in;
    unsigned char* ws = F.ws;
    const int gw = F.vcu * NWAVES + F.wave, NGW = F.G * NWAVES;
    float* scr = (float*)(F.lds + F.wave * 16384);
    constexpr int I_GU = (DM / 64) * (DFF / 32), I_D = (DFF / 64) * (DM / 32), I_IN = (DM / 64) * (WIN / 32), I_Q = (256 / 64) * (768 / 32), I_KV = (128 / 64) * (1024 / 32), I_O = (DM / 64) * (DM / 32);
    constexpr int NITEMS = 4 * I_GU + 2 * I_D + I_IN + I_Q + I_KV + I_O;
    for (int it = gw; it < NITEMS; it += NGW) {
        int r = it; const float* W; int K, N, kind; bf16* WT; const float* ks = nullptr;
        if (r < I_GU) { W = in[5]; K = DM; N = DFF; kind = 1; WT = (bf16*)(ws + WS_W1T); }
        else if ((r -= I_GU) < I_GU) { W = in[6]; K = DM; N = DFF; kind = 2; WT = (bf16*)(ws + WS_W1T); }
        else if ((r -= I_GU) < I_D) { W = in[7]; K = DFF; N = DM; kind = 0; WT = (bf16*)(ws + WS_WD1T); }
        else if ((r -= I_D) < I_GU) { W = in[20]; K = DM; N = DFF; kind = 1; WT = (bf16*)(ws + WS_W2T); }
        else if ((r -= I_GU) < I_GU) { W = in[21]; K = DM; N = DFF; kind = 2; WT = (bf16*)(ws + WS_W2T); }
        else if ((r -= I_GU) < I_D) { W = in[22]; K = DFF; N = DM; kind = 0; WT = (bf16*)(ws + WS_WD2T); }
        else if ((r -= I_D) < I_IN) { W = in[8]; K = DM; N = WIN; kind = 3; WT = (bf16*)(ws + WS_WINT); }
        else if ((r -= I_IN) < I_Q) { W = in[11]; K = 256; N = 768; kind = 0; WT = (bf16*)(ws + WS_WQT); ks = in[9]; }
        else if ((r -= I_Q) < I_KV) { W = in[12]; K = 128; N = 1024; kind = 0; WT = (bf16*)(ws + WS_WKVT); ks = in[10]; }
        else { r -= I_KV; W = in[19]; K = DM; N = DM; kind = 0; WT = (bf16*)(ws + WS_WOUTT); }
        const int nblk = N / 32, kb = r / nblk, nb = r % nblk;
        transpose_item(W, K, N, WT, 64 * kb, 32 * nb, drow_of(kind, 32 * nb), ks, scr, F.lane);
    }
    { const int gt = F.vcu * 512 + F.tid, NT = F.G * 512; v4u z = {0u, 0u, 0u, 0u};
      for (int i = gt; i < 96 * 128; i += NT) *((v4u*)(ws + WS_WINT + (size_t)1440 * DM * 2) + i) = z; }
    { const int gt = F.vcu * 512 + F.tid, NT = F.G * 512; const int* pos = (const int*)a.in[2]; float* tab = (float*)(ws + WS_ROPE);
      for (int idx = gt; idx < M * 16; idx += NT) { const int m = idx >> 4, i = idx & 15; double f = 0.0;
#pragma unroll
          for (int k = 0; k < 16; ++k) f = (i == k) ? a.invf[k] : f;
          double rv = (double)pos[m] * f * 0.15915494309189535; rv -= __builtin_rint(rv); const float fr = (float)rv;
          tab[m * 32 + i] = __builtin_amdgcn_cosf(fr); tab[m * 32 + 16 + i] = __builtin_amdgcn_sinf(fr); } }
    const float* mod = (const float*)(ws + WS_MOD);
    ph_rownorm<0>(F, in[0], mod + 1 * DM, mod + 0 * DM, (bf16*)(ws + WS_A1), nullptr);
}

__device__ __forceinline__ void ph_conv(Frame& F, const bf16* ZG, const float* cw, const float* cb, const float* lg, const float* lb, bf16* MIX) {
    char* lds = F.lds; const int tid = F.tid, lane = F.lane, wave = F.wave;
    const int cp = tid & 255, th = tid >> 8;
    for (int u = blockIdx.x; u < M / 64; u += F.G) {
        const int m0 = u * 64, t0 = m0 & (SEQ - 1);
#pragma unroll
        for (int i = 0; i < 12; ++i) { const int id = tid + 512 * i; if (id < 94 * 64) { const int row = id >> 6, c = id & 63, t = t0 - 15 + row;
                v4u v = {0u, 0u, 0u, 0u}; if (t >= 0 && t < SEQ) v = *(const v4u*)(ZG + (size_t)(m0 - 15 + row) * 512 + c * 8);
                *(v4u*)(lds + row * 1024 + c * 16) = v; } }
        float w0[31], w1[31];
#pragma unroll
        for (int j = 0; j < 31; ++j) { const float2 w = *(const float2*)(cw + j * 512 + 2 * cp); w0[j] = w.x; w1[j] = w.y; }
        const float2 bias = *(const float2*)(cb + 2 * cp);
        float a0[32], a1[32];
#pragma unroll
        for (int t = 0; t < 32; ++t) { a0[t] = bias.x; a1[t] = bias.y; }
        __syncthreads();
#pragma unroll
        for (int s = 0; s < 62; ++s) { const unsigned v = *(const unsigned*)(lds + (th * 32 + s) * 1024 + cp * 4); const float x0 = bf_lo(v), x1 = bf_hi(v);
#pragma unroll
            for (int j = 0; j < 31; ++j) { const int t = s - j; if (t >= 0 && t < 32) { a0[t] = fmaf(w0[j], x0, a0[t]); a1[t] = fmaf(w1[j], x1, a1[t]); } } }
        __syncthreads();
#pragma unroll
        for (int t = 0; t < 32; ++t) *(float2*)(lds + (th * 32 + t) * 2048 + cp * 8) = make_float2(a0[t], a1[t]);
        __syncthreads();
        const f32x4 g0 = *(const f32x4*)(lg + 8 * lane), g1 = *(const f32x4*)(lg + 8 * lane + 4), b0 = *(const f32x4*)(lb + 8 * lane), b1 = *(const f32x4*)(lb + 8 * lane + 4);
#pragma unroll 2
        for (int i = 0; i < 8; ++i) { const int t = wave * 8 + i;
            const f32x4 x0 = *(const f32x4*)(lds + t * 2048 + lane * 32), x1 = *(const f32x4*)(lds + t * 2048 + lane * 32 + 16);
            const float mu = wave_sum((x0.x + x0.y) + (x0.z + x0.w) + (x1.x + x1.y) + (x1.z + x1.w)) * (1.0f / 512.0f);
            const f32x4 d0 = x0 - mu, d1 = x1 - mu;
            const float var = wave_sum((d0.x * d0.x + d0.y * d0.y) + (d0.z * d0.z + d0.w * d0.w) + (d1.x * d1.x + d1.y * d1.y) + (d1.z * d1.z + d1.w * d1.w)) * (1.0f / 512.0f);
            const float rs = __builtin_amdgcn_rsqf(var + 1e-5f);
            f32x4 y0 = d0 * rs * g0 + b0, y1 = d1 * rs * g1 + b1;
            y0.x *= sigm(y0.x); y0.y *= sigm(y0.y); y0.z *= sigm(y0.z); y0.w *= sigm(y0.w); y1.x *= sigm(y1.x); y1.y *= sigm(y1.y); y1.z *= sigm(y1.z); y1.w *= sigm(y1.w);
            v4u o; o.x = cvtpk(y0.x, y0.y); o.y = cvtpk(y0.z, y0.w); o.z = cvtpk(y1.x, y1.y); o.w = cvtpk(y1.z, y1.w);
            *(v4u*)(MIX + (size_t)(m0 + t) * DM + 8 * lane) = o; }
        __syncthreads();
    }
}

namespace lat {
using f32x16 = __attribute__((ext_vector_type(16))) float;
constexpr int WQ_OFF = 0, WKV_OFF = 49152, SCR_OFF = 81920, SCR_W = 6656, G_OFF = SCR_OFF + 8 * SCR_W;
__device__ __forceinline__ int crow(int r, int hi) { return (r & 3) + 8 * (r >> 2) + 4 * hi; }
}
__device__ __forceinline__ void ph_latent(Frame& F, const bf16* ZC, const bf16* Wqt, const bf16* Wkvt, const float* gqh, const float* gkh, const float* tab, bf16* Qo, bf16* Ko, bf16* Vo) {
    using namespace lat;
    char* lds = F.lds; const int tid = F.tid, lane = F.lane, wave = F.wave, r32 = lane & 31, hi = lane >> 5;
    float* gl = (float*)(lds + G_OFF);
    if (tid < 96) gl[tid] = gqh[tid]; else if (tid < 192) gl[tid] = gkh[tid - 96];
    char* scr = lds + SCR_OFF + wave * SCR_W;
    const int sw = (r32 & 15) << 4;
    for (int u = blockIdx.x; u < 256; u += F.G) {
        const int tt = u >> 1, hg = u & 1;
        const int m = tt * 256 + wave * 32 + r32, b = m >> 11, s0 = (tt * 256 + wave * 32) & (SEQ - 1);
        const bf16* zrow = ZC + (size_t)m * 512;
        float cs[8], sn[8];
#pragma unroll
        for (int g = 0; g < 2; ++g) { const f32x4 c4 = *(const f32x4*)(tab + (size_t)m * 32 + 8 * g + 4 * hi), s4 = *(const f32x4*)(tab + (size_t)m * 32 + 16 + 8 * g + 4 * hi);
#pragma unroll
            for (int e = 0; e < 4; ++e) { cs[4 * g + e] = c4[e]; sn[4 * g + e] = s4[e]; } }
        {
            bf16x8 ql[16];
#pragma unroll
            for (int ks = 0; ks < 16; ++ks) ql[ks] = *(const bf16x8*)(zrow + ks * 16 + hi * 8);
            float sq = 0.f;
#pragma unroll
            for (int ks = 0; ks < 16; ++ks)
#pragma unroll
                for (int e = 0; e < 8; ++e) { const float v = __uint_as_float(((unsigned)(unsigned short)ql[ks][e]) << 16); sq = fmaf(v, v, sq); }
            const float rq = __builtin_amdgcn_rsqf(swap_add(sq) * (1.0f / 256.0f) + EPS);
            for (int hh = 0; hh < 4; ++hh) {
                const int h = hg * 4 + hh;
                __syncthreads();
#pragma unroll
                for (int i = 0; i < 6; ++i) { const int id = tid + 512 * i, row = id >> 5, c = id & 31; const v4u v = *((const v4u*)(Wqt + (size_t)h * 96 * 256) + id);
                    *(v4u*)(lds + WQ_OFF + row * 512 + ((c * 16) ^ ((row & 15) << 4))) = v; }
                __syncthreads();
                f32x16 q0 = {}, q1 = {}, q2 = {};
#pragma unroll
                for (int ks = 0; ks < 16; ++ks) { const int cb = (ks * 32 + hi * 16) ^ sw; const char* wp = lds + WQ_OFF + r32 * 512 + cb;
                    const bf16x8 a0 = *(const bf16x8*)(wp), a1 = *(const bf16x8*)(wp + 32 * 512), a2 = *(const bf16x8*)(wp + 64 * 512);
                    q0 = __builtin_amdgcn_mfma_f32_32x32x16_bf16(a0, ql[ks], q0, 0, 0, 0);
                    q1 = __builtin_amdgcn_mfma_f32_32x32x16_bf16(a1, ql[ks], q1, 0, 0, 0);
                    q2 = __builtin_amdgcn_mfma_f32_32x32x16_bf16(a2, ql[ks], q2, 0, 0, 0); }
                float ss = 0.f;
#pragma unroll
                for (int r = 0; r < 16; ++r) ss += q0[r] * q0[r] + q1[r] * q1[r] + q2[r] * q2[r];
                ss = swap_add(ss);
                const float f = rq * __builtin_amdgcn_rsqf(rq * rq * ss * (1.0f / 96.0f) + EPS);
#pragma unroll
                for (int g = 0; g < 4; ++g) { const f32x4 ga = *(const f32x4*)(gl + 8 * g + 4 * hi), gb = *(const f32x4*)(gl + 32 + 8 * g + 4 * hi), gc = *(const f32x4*)(gl + 64 + 8 * g + 4 * hi);
#pragma unroll
                    for (int e = 0; e < 4; ++e) { q0[4 * g + e] *= f * ga[e]; q1[4 * g + e] *= f * gb[e]; q2[4 * g + e] *= f * gc[e]; } }
#pragma unroll
                for (int r = 0; r < 8; ++r) { const float x1 = q2[r], x2 = q2[r + 8]; q2[r] = x1 * cs[r] - x2 * sn[r]; q2[r + 8] = x2 * cs[r] + x1 * sn[r]; }
#pragma unroll
                for (int g = 0; g < 4; ++g) {
                    *(uint2*)(scr + r32 * 208 + (8 * g + 4 * hi) * 2) = make_uint2(cvtpk(q0[4 * g], q0[4 * g + 1]), cvtpk(q0[4 * g + 2], q0[4 * g + 3]));
                    *(uint2*)(scr + r32 * 208 + (32 + 8 * g + 4 * hi) * 2) = make_uint2(cvtpk(q1[4 * g], q1[4 * g + 1]), cvtpk(q1[4 * g + 2], q1[4 * g + 3]));
                    *(uint2*)(scr + r32 * 208 + (64 + 8 * g + 4 * hi) * 2) = make_uint2(cvtpk(q2[4 * g], q2[4 * g + 1]), cvtpk(q2[4 * g + 2], q2[4 * g + 3])); }
                LDS_WAIT();
                bf16* dst = Qo + ((size_t)(b * NH + h) * SEQ + s0) * 96;
#pragma unroll
                for (int i = 0; i < 6; ++i) { const int id = lane + 64 * i, row = id / 12, c = id % 12; *((v4u*)dst + id) = *(const v4u*)(scr + row * 208 + c * 16); }
                LDS_WAIT();
            }
        }
        {
            bf16x8 kl[8];
#pragma unroll
            for (int ks = 0; ks < 8; ++ks) kl[ks] = *(const bf16x8*)(zrow + 256 + ks * 16 + hi * 8);
            float skv = 0.f;
#pragma unroll
            for (int ks = 0; ks < 8; ++ks)
#pragma unroll
                for (int e = 0; e < 8; ++e) { const float v = __uint_as_float(((unsigned)(unsigned short)kl[ks][e]) << 16); skv = fmaf(v, v, skv); }
            const float rkv = __builtin_amdgcn_rsqf(swap_add(skv) * (1.0f / 128.0f) + EPS);
            float kr[16];
#pragma unroll
            for (int g = 0; g < 4; ++g) { const uint2 w = *(const uint2*)(zrow + 384 + 8 * g + 4 * hi); kr[4 * g] = bf_lo(w.x); kr[4 * g + 1] = bf_hi(w.x); kr[4 * g + 2] = bf_lo(w.y); kr[4 * g + 3] = bf_hi(w.y); }
            float skr = 0.f;
#pragma unroll
            for (int r = 0; r < 16; ++r) skr = fmaf(kr[r], kr[r], skr);
            skr = swap_add(skr);
            for (int hh = 0; hh < 4; ++hh) {
                const int h = hg * 4 + hh;
                __syncthreads();
#pragma unroll
                for (int i = 0; i < 4; ++i) { const int id = tid + 512 * i, row = id >> 4, c = id & 15; const v4u v = *((const v4u*)(Wkvt + (size_t)h * 128 * 128) + id);
                    *(v4u*)(lds + WKV_OFF + row * 256 + ((c * 16) ^ ((row & 15) << 4))) = v; }
                __syncthreads();
                f32x16 k0 = {}, k1 = {}, v0 = {}, v1 = {};
#pragma unroll
                for (int ks = 0; ks < 8; ++ks) { const int cb = (ks * 32 + hi * 16) ^ sw; const char* wp = lds + WKV_OFF + r32 * 256 + cb;
                    const bf16x8 a0 = *(const bf16x8*)(wp), a1 = *(const bf16x8*)(wp + 32 * 256), a2 = *(const bf16x8*)(wp + 64 * 256), a3 = *(const bf16x8*)(wp + 96 * 256);
                    k0 = __builtin_amdgcn_mfma_f32_32x32x16_bf16(a0, kl[ks], k0, 0, 0, 0);
                    k1 = __builtin_amdgcn_mfma_f32_32x32x16_bf16(a1, kl[ks], k1, 0, 0, 0);
                    v0 = __builtin_amdgcn_mfma_f32_32x32x16_bf16(a2, kl[ks], v0, 0, 0, 0);
                    v1 = __builtin_amdgcn_mfma_f32_32x32x16_bf16(a3, kl[ks], v1, 0, 0, 0); }
#pragma unroll
                for (int g = 0; g < 4; ++g) {
                    *(uint2*)(scr + r32 * 144 + (8 * g + 4 * hi) * 2) = make_uint2(cvtpk(v0[4 * g] * rkv, v0[4 * g + 1] * rkv), cvtpk(v0[4 * g + 2] * rkv, v0[4 * g + 3] * rkv));
                    *(uint2*)(scr + r32 * 144 + (32 + 8 * g + 4 * hi) * 2) = make_uint2(cvtpk(v1[4 * g] * rkv, v1[4 * g + 1] * rkv), cvtpk(v1[4 * g + 2] * rkv, v1[4 * g + 3] * rkv)); }
                LDS_WAIT();
                bf16* dv = Vo + ((size_t)(b * NH + h) * SEQ + s0) * 64;
#pragma unroll
                for (int i = 0; i < 4; ++i) { const int id = lane + 64 * i, row = id >> 3, c = id & 7; *((v4u*)dv + id) = *(const v4u*)(scr + row * 144 + c * 16); }
                LDS_WAIT();
                float ss = 0.f;
#pragma unroll
                for (int r = 0; r < 16; ++r) ss += k0[r] * k0[r] + k1[r] * k1[r];
                ss = swap_add(ss);
                const float rn = __builtin_amdgcn_rsqf((rkv * rkv * ss + skr) * (1.0f / 96.0f) + EPS), f = rkv * rn;
                float kq[16];
#pragma unroll
                for (int g = 0; g < 4; ++g) { const f32x4 ga = *(const f32x4*)(gl + 96 + 8 * g + 4 * hi), gb = *(const f32x4*)(gl + 96 + 32 + 8 * g + 4 * hi), gc = *(const f32x4*)(gl + 96 + 64 + 8 * g + 4 * hi);
#pragma unroll
                    for (int e = 0; e < 4; ++e) { k0[4 * g + e] *= f * ga[e]; k1[4 * g + e] *= f * gb[e]; kq[4 * g + e] = kr[4 * g + e] * rn * gc[e]; } }
#pragma unroll
                for (int r = 0; r < 8; ++r) { const float x1 = kq[r], x2 = kq[r + 8]; kq[r] = x1 * cs[r] - x2 * sn[r]; kq[r + 8] = x2 * cs[r] + x1 * sn[r]; }
#pragma unroll
                for (int g = 0; g < 4; ++g) {
                    *(uint2*)(scr + r32 * 208 + (8 * g + 4 * hi) * 2) = make_uint2(cvtpk(k0[4 * g], k0[4 * g + 1]), cvtpk(k0[4 * g + 2], k0[4 * g + 3]));
                    *(uint2*)(scr + r32 * 208 + (32 + 8 * g + 4 * hi) * 2) = make_uint2(cvtpk(k1[4 * g], k1[4 * g + 1]), cvtpk(k1[4 * g + 2], k1[4 * g + 3]));
                    *(uint2*)(scr + r32 * 208 + (64 + 8 * g + 4 * hi) * 2) = make_uint2(cvtpk(kq[4 * g], kq[4 * g + 1]), cvtpk(kq[4 * g + 2], kq[4 * g + 3])); }
                LDS_WAIT();
                bf16* dk = Ko + ((size_t)(b * NH + h) * SEQ + s0) * 96;
#pragma unroll
                for (int i = 0; i < 6; ++i) { const int id = lane + 64 * i, row = id / 12, c = id % 12; *((v4u*)dk + id) = *(const v4u*)(scr + row * 208 + c * 16); }
                LDS_WAIT();
            }
        }
    }
    __syncthreads();
}

__device__ __forceinline__ void ph_attn(Frame& F, const bf16* Q, const bf16* K, const bf16* V, bf16* MIX) {
    for (int i = 0;; ++i) {
        const int L = i * F.G + F.vcu; if (L >= BATCH * NH * 8) break;
        const int bh = L >> 3, qb = L & 7, b = bh >> 3, h = bh & 7;
        att::attn_unit(Q + ((size_t)bh * SEQ + qb * 256) * 96, K + (size_t)bh * SEQ * 96, V + (size_t)bh * SEQ * 64,
                       MIX + ((size_t)b * SEQ + qb * 256) * DM + 512 + h * 64, DM, SEQ, F.lds);
    }
}

__global__ void __launch_bounds__(NWAVES * 64, 2) mega_fwd(Args args) {
    extern __shared__ __attribute__((aligned(16))) unsigned char lds[];
    Frame F;
    F.lds = (char*)lds;
    F.MISC = (volatile LAS unsigned*)((LAS unsigned char*)lds + MISC_OFF);
    F.tid = threadIdx.x; F.lane = F.tid & 63; F.wave = __builtin_amdgcn_readfirstlane(F.tid >> 6);
    F.G = gridDim.x; { const int bx = blockIdx.x; F.vcu = (F.G % 8 == 0) ? (bx % 8) * (F.G / 8) + bx / 8 : bx; }
    F.ws = args.ws; F.ctl = (gu32*)(args.ws + WS_CTL);
    if (F.tid < 64) F.MISC[F.tid] = 0u;
    __syncthreads();
    const bool one_phase = (args.ph_hi - args.ph_lo) == 1;
    XcdBarrier bar; bar.bar = (unsigned*)(F.ctl + CW_BAR) + args.li * XCD_BAR_WORDS; bar.x = 0; bar.st = nullptr;
    if (!one_phase) bar = xcd_barrier_post((unsigned*)(F.ctl + CW_BAR) + args.li * XCD_BAR_WORDS, F.MISC + 8);
    const int lo = args.ph_lo, hi = args.ph_hi;
#ifndef PH_MASK
#define PH_MASK 0x1fff
#endif
#define IN(k) (((PH_MASK >> (k)) & 1) && lo <= (k) && (k) < hi)
#define SEAM(k) do { if (IN(k) && IN((k) + 1)) xcd_barrier(bar); } while (0)
    unsigned char* ws = args.ws;
    const float* const* in = (const float* const*)args.in;
    float* mod = (float*)(ws + WS_MOD);
    float* hbuf = args.out;
    bf16* A1 = (bf16*)(ws + WS_A1); bf16* ACT = (bf16*)(ws + WS_ACT);
    LAS unsigned char* ring = (LAS unsigned char*)lds;

    if (IN(0)) { ph_mod(F, in[1], in[3], in[4], mod); } SEAM(0);
    if (IN(1)) { ph_prep(F, args); } SEAM(1);
    if (IN(2)) { pg8::Gemm g{A1, (const bf16*)(ws + WS_W1T), M, 2 * DFF, DM}; pg8::StaticOrder S; S.init(M, 2 * DFF, F.G, (int)blockIdx.x);
        pg8::EpiSwiglu E{ACT, DFF}; pg8::gemm_phase<pg8::EpiSwiglu, pg8::StaticOrder, true, true>(ring, g, S, E); } SEAM(2);
    if (IN(3)) { pg8::Gemm g{ACT, (const bf16*)(ws + WS_WD1T), M, DM, DFF}; pg8::StaticOrder S; S.init(M, DM, F.G, (int)blockIdx.x);
        pg8::EpiResid E{in[0], hbuf, mod + 2 * DM, 0.5f}; pg8::gemm_phase<pg8::EpiResid, pg8::StaticOrder, true, true>(ring, g, S, E); } SEAM(3);
    if (IN(4)) { ph_rownorm<0>(F, hbuf, mod + 4 * DM, mod + 3 * DM, A1, nullptr); } SEAM(4);
    if (IN(5)) { pg8::Gemm g{A1, (const bf16*)(ws + WS_WINT), M, WINP, DM}; pg8::StaticOrder S; S.init(M, WINP, F.G, (int)blockIdx.x);
        pg8::EpiG3 E{(bf16*)(ws + WS_ZG), (bf16*)(ws + WS_ZC)}; pg8::gemm_phase<pg8::EpiG3, pg8::StaticOrder, true, true>(ring, g, S, E); } SEAM(5);
    if (IN(6)) {
#ifndef NO_LAT
 ph_latent(F, (const bf16*)(ws + WS_ZC), (const bf16*)(ws + WS_WQT), (const bf16*)(ws + WS_WKVT), in[13], in[14], (const float*)(ws + WS_ROPE),
                           (bf16*)(ws + WS_Q), (bf16*)(ws + WS_K), (bf16*)(ws + WS_V));
#endif
#ifndef NO_CONV
                 ph_conv(F, (const bf16*)(ws + WS_ZG), in[15], in[16], in[17], in[18], (bf16*)(ws + WS_MIX));
#endif
 } SEAM(6);
    if (IN(7)) { ph_attn(F, (const bf16*)(ws + WS_Q), (const bf16*)(ws + WS_K), (const bf16*)(ws + WS_V), (bf16*)(ws + WS_MIX)); } SEAM(7);
    if (IN(8)) { pg8::Gemm g{(const bf16*)(ws + WS_MIX), (const bf16*)(ws + WS_WOUTT), M, DM, DM}; pg8::StaticOrder S; S.init(M, DM, F.G, (int)blockIdx.x);
        pg8::EpiResid E{hbuf, hbuf, mod + 5 * DM, 1.0f}; pg8::gemm_phase<pg8::EpiResid, pg8::StaticOrder, true, true>(ring, g, S, E); } SEAM(8);
    if (IN(9)) { ph_rownorm<0>(F, hbuf, mod + 7 * DM, mod + 6 * DM, A1, nullptr); } SEAM(9);
    if (IN(10)) { pg8::Gemm g{A1, (const bf16*)(ws + WS_W2T), M, 2 * DFF, DM}; pg8::StaticOrder S; S.init(M, 2 * DFF, F.G, (int)blockIdx.x);
        pg8::EpiSwiglu E{ACT, DFF}; pg8::gemm_phase<pg8::EpiSwiglu, pg8::StaticOrder, true, true>(ring, g, S, E); } SEAM(10);
    if (IN(11)) { pg8::Gemm g{ACT, (const bf16*)(ws + WS_WD2T), M, DM, DFF}; pg8::StaticOrder S; S.init(M, DM, F.G, (int)blockIdx.x);
        pg8::EpiResid E{hbuf, hbuf, mod + 8 * DM, 0.5f}; pg8::gemm_phase<pg8::EpiResid, pg8::StaticOrder, true, true>(ring, g, S, E); } SEAM(11);
    if (IN(12)) { ph_rownorm<1>(F, hbuf, in[23], nullptr, nullptr, hbuf); }
#undef IN
#undef SEAM
}

extern "C" void kernel_launch(void* const* d_in, const int* in_sizes, int n_in, void* d_out, int out_size, void* d_ws, size_t ws_size, hipStream_t stream) {
    static int grid = 0;
    if (grid == 0) {
        if (n_in != 24 || in_sizes[0] != M * DM || out_size != M * DM || ws_size < WS_END) { fprintf(stderr, "kernel_launch: unexpected shapes (n_in %d, in0 %d, out %d, ws %zu)\n", n_in, n_in > 0 ? in_sizes[0] : -1, out_size, ws_size); grid = -1; return; }
        int dev = 0, cus = 0, per_cu = 0;
        if (hipGetDevice(&dev) != hipSuccess || hipDeviceGetAttribute(&cus, hipDeviceAttributeMultiprocessorCount, dev) != hipSuccess) { grid = -1; return; }
        if (hipFuncSetAttribute((const void*)mega_fwd, hipFuncAttributeMaxDynamicSharedMemorySize, LDS_BYTES) != hipSuccess) { fprintf(stderr, "kernel_launch: hipFuncSetAttribute failed\n"); grid = -1; return; }
        if (hipOccupancyMaxActiveBlocksPerMultiprocessor(&per_cu, (const void*)mega_fwd, NWAVES * 64, LDS_BYTES) != hipSuccess || per_cu < 1) { fprintf(stderr, "kernel_launch: occupancy query says %d blocks per CU\n", per_cu); (void)hipGetLastError(); grid = -1; return; }
        grid = cus;
    }
    if (grid < 0) return;
    if (hipMemsetAsync((char*)d_ws + WS_CTL, 0, CTL_ZERO_BYTES, stream) != hipSuccess) return;
    Args a{};
    for (int i = 0; i < 24; ++i) a.in[i] = d_in[i];
    a.out = (float*)d_out; a.ws = (unsigned char*)d_ws;
    for (int i = 0; i < 16; ++i) a.invf[i] = 1.0 / pow(10000.0, (double)(2 * i) / 32.0);
    constexpr int NL = MK_N_LAUNCHES;
    for (int li = 0; li < NL; ++li) {
        a.ph_lo = (NL == NPHASE) ? li : (li * NPHASE) / NL; a.ph_hi = (NL == NPHASE) ? li + 1 : ((li + 1) * NPHASE) / NL; a.li = (NL == NPHASE) ? 0 : li;
        hipLaunchKernelGGL(mega_fwd, dim3(grid), dim3(NWAVES * 64), LDS_BYTES, stream, a);
        const hipError_t le = hipPeekAtLastError();
        if (le != hipSuccess) { fprintf(stderr, "kernel_launch: launch %d failed: %s\n", li, hipGetErrorName(le)); break; }
    }
}
```

```cpp
#include <hip/hip_runtime.h>
#include <hip/hip_bf16.h>
#include <cstdio>
#include <cstdint>
#include <cmath>
namespace pg8 {
#define PG8_LAS __attribute__((address_space(3)))
typedef unsigned short bf16_t;
typedef short bf16x8 __attribute__((ext_vector_type(8)));
typedef float f32x4 __attribute__((ext_vector_type(4)));
typedef unsigned u32x4 __attribute__((ext_vector_type(4)));
constexpr int BM = 256, BK = 64, HALF = 128, HTB = HALF * BK * 2  , STAGE_BYTES = 8 * HTB, NXCD = 8, WGM = 8;

__host__ __device__ __forceinline__ int lds_byte(int r, int c) { const int st = (r >> 4) * 2 + (c >> 5), rr = r & 15, cc = c & 31, ob = rr * 64 + cc * 2; return st * 1024 + (ob ^ (((ob >> 9) & 1) << 5)); }
__host__ __device__ __forceinline__ void stage_rc(int b, int& R, int& C) { const int st = b / 1024, sb = b % 1024, swz = sb ^ (((sb >> 9) & 1) << 5); R = (st >> 1) * 16 + swz / 64; C = (st & 1) * 32 + (swz % 64) / 2; }
__host__ __device__ __forceinline__ int perm32(int rho) { const int n = rho >> 4, i = rho & 15; return 8 * (i >> 2) + 4 * n + (i & 3); }

struct Unit { int pm, pn; };
struct Gemm { const bf16_t* A; const bf16_t* Bt; int M, N, K; };

struct StaticOrder {
    int nM, nN, nwg, G, c;
    __host__ __device__ void init(int M, int N, int G_, int c_) { nM = M / BM; nN = N / BM; nwg = nM * nN; G = G_; c = c_; }
    __host__ __device__ bool next(int i, Unit& u) const {
        const long L = (long)i * G + c; if (L >= nwg) return false;
        int wgid = (int)L; { const int q = nwg / NXCD, r = nwg % NXCD, xcd = wgid % NXCD, off = wgid / NXCD; wgid = (xcd < r ? xcd * (q + 1) : r * (q + 1) + (xcd - r) * q) + off; }
        const int nig = WGM * nN, gid = wgid / nig, fm = gid * WGM, gsz = (nM - fm) < WGM ? (nM - fm) : WGM;
        u.pm = fm + ((wgid % nig) % gsz); u.pn = (wgid % nig) / gsz; return true;
    }
    __device__ __forceinline__ void a_ready(const Unit&) const {}
    __device__ __forceinline__ void done(const Unit&) const {}
};

__device__ __forceinline__ unsigned cvt_pk_bf16(float lo, float hi) { unsigned r; asm volatile("v_cvt_pk_bf16_f32 %0, %1, %2" : "=v"(r) : "v"(lo), "v"(hi)); return r; }
__device__ __forceinline__ float sigm(float x) { return __builtin_amdgcn_rcpf(1.0f + __builtin_amdgcn_exp2f(-1.4426950408889634f * x)); }
typedef float f32x2 __attribute__((ext_vector_type(2)));
struct PkC { f32x2 nl, one;
    __device__ __forceinline__ PkC() { nl = (f32x2){-1.4426950408889634f, -1.4426950408889634f}; one = (f32x2){1.0f, 1.0f}; asm volatile("" : "+v"(nl), "+v"(one)); } };
__device__ __forceinline__ f32x2 pk_mul(f32x2 a, f32x2 b) { f32x2 d; asm("v_pk_mul_f32 %0, %1, %2" : "=v"(d) : "v"(a), "v"(b)); return d; }
__device__ __forceinline__ f32x2 pk_add(f32x2 a, f32x2 b) { f32x2 d; asm("v_pk_add_f32 %0, %1, %2" : "=v"(d) : "v"(a), "v"(b)); return d; }
__device__ __forceinline__ f32x4 sigm4(f32x4 x, const PkC& c) {
    const f32x2 m0 = pk_mul(__builtin_shufflevector(x, x, 0, 1), c.nl), m1 = pk_mul(__builtin_shufflevector(x, x, 2, 3), c.nl);
    f32x2 t0, t1; t0[0] = __builtin_amdgcn_exp2f(m0[0]); t0[1] = __builtin_amdgcn_exp2f(m0[1]); t1[0] = __builtin_amdgcn_exp2f(m1[0]); t1[1] = __builtin_amdgcn_exp2f(m1[1]);
    const f32x2 d0 = pk_add(t0, c.one), d1 = pk_add(t1, c.one);
    f32x4 r; r[0] = __builtin_amdgcn_rcpf(d0[0]); r[1] = __builtin_amdgcn_rcpf(d0[1]); r[2] = __builtin_amdgcn_rcpf(d1[0]); r[3] = __builtin_amdgcn_rcpf(d1[1]);
    return r; }
__device__ __forceinline__ f32x4 swiglu4(f32x4 g, f32x4 up, const PkC& c) { return (g * up) * sigm4(g, c); }
struct EpiSwiglu {
    static constexpr int ID = 20;
    static constexpr bool PERM = true, AFTER_DRAIN = false, PREF = false;
    bf16_t* O; int ldc;
    __device__ __forceinline__ void operator()(const f32x4 (&acc)[2][2][4][2], const Unit& u, int wr, int wc, int fr, int fq) const {
        const int row0 = u.pm * BM + wr * 64 + fr, col0 = u.pn * HALF + wc * 32 + 8 * fq;
        const PkC pkc;
#pragma unroll
        for (int ai = 0; ai < 2; ++ai)
#pragma unroll
            for (int m = 0; m < 4; ++m) { bf16_t* rowp = O + (size_t)(row0 + ai * HALF + m * 16) * ldc + col0;
                const f32x4 o0 = swiglu4(acc[ai][0][m][0], acc[ai][1][m][0], pkc), o1 = swiglu4(acc[ai][0][m][1], acc[ai][1][m][1], pkc);
                u32x4 w; w.x = cvt_pk_bf16(o0[0], o0[1]); w.y = cvt_pk_bf16(o0[2], o0[3]); w.z = cvt_pk_bf16(o1[0], o1[1]); w.w = cvt_pk_bf16(o1[2], o1[3]);
                *(u32x4*)rowp = w; }
    }
};
struct EpiG3 {
    static constexpr int ID = 21;
    static constexpr bool PERM = true, AFTER_DRAIN = false, PREF = false;
    bf16_t* ZG; bf16_t* ZC;
    __device__ __forceinline__ void operator()(const f32x4 (&acc)[2][2][4][2], const Unit& u, int wr, int wc, int fr, int fq) const {
        const int row0 = u.pm * BM + wr * 64 + fr;
        if (u.pn < 4) {
            const int col0 = u.pn * HALF + wc * 32 + 8 * fq;
#pragma unroll
            for (int ai = 0; ai < 2; ++ai)
#pragma unroll
                for (int m = 0; m < 4; ++m) { bf16_t* rowp = ZG + (size_t)(row0 + ai * HALF + m * 16) * 512 + col0;
                    float o[8];
#pragma unroll
                    for (int n = 0; n < 2; ++n)
#pragma unroll
                        for (int e = 0; e < 4; ++e) o[4 * n + e] = acc[ai][0][m][n][e] * sigm(acc[ai][1][m][n][e]);
                    u32x4 w; w.x = cvt_pk_bf16(o[0], o[1]); w.y = cvt_pk_bf16(o[2], o[3]); w.z = cvt_pk_bf16(o[4], o[5]); w.w = cvt_pk_bf16(o[6], o[7]);
                    *(u32x4*)rowp = w; }
        } else {
            const int col0 = (u.pn - 4) * BM + wc * 32 + 8 * fq;
#pragma unroll
            for (int ai = 0; ai < 2; ++ai)
#pragma unroll
                for (int m = 0; m < 4; ++m) { bf16_t* rowp = ZC + (size_t)(row0 + ai * HALF + m * 16) * 512 + col0;
#pragma unroll
                    for (int bj = 0; bj < 2; ++bj) { const f32x4 v0 = acc[ai][bj][m][0], v1 = acc[ai][bj][m][1];
                        u32x4 w; w.x = cvt_pk_bf16(v0[0], v0[1]); w.y = cvt_pk_bf16(v0[2], v0[3]); w.z = cvt_pk_bf16(v1[0], v1[1]); w.w = cvt_pk_bf16(v1[2], v1[3]);
                        *(u32x4*)(rowp + bj * HALF) = w; } }
        }
    }
};
struct EpiResid {
    static constexpr int ID = 22;
    static constexpr bool PERM = false, AFTER_DRAIN = false, PREF = false;
    const float* res; float* out; const float* gate; float coef;
    __device__ __forceinline__ void operator()(const f32x4 (&acc)[2][2][4][2], const Unit& u, int wr, int wc, int fr, int fq) const {
        const int row0 = u.pm * BM + wr * 64 + fr, col0 = u.pn * BM + wc * 32 + 4 * fq;
        const float* gp = gate + (size_t)(u.pm >> 3) * 9216 + col0;
        f32x4 gv[2][2];
#pragma unroll
        for (int bj = 0; bj < 2; ++bj)
#pragma unroll
            for (int n = 0; n < 2; ++n) gv[bj][n] = *(const f32x4*)(gp + bj * HALF + n * 16) * coef;
#pragma unroll
        for (int ai = 0; ai < 2; ++ai)
#pragma unroll
            for (int m = 0; m < 4; ++m) { const size_t off = (size_t)(row0 + ai * HALF + m * 16) * 1024 + col0;
                f32x4 r[2][2];
#pragma unroll
                for (int bj = 0; bj < 2; ++bj)
#pragma unroll
                    for (int n = 0; n < 2; ++n) r[bj][n] = *(const f32x4*)(res + off + bj * HALF + n * 16);
#pragma unroll
                for (int bj = 0; bj < 2; ++bj)
#pragma unroll
                    for (int n = 0; n < 2; ++n) *(f32x4*)(out + off + bj * HALF + n * 16) = r[bj][n] + gv[bj][n] * acc[ai][bj][m][n];
                if (m & 1) asm volatile("" ::: "memory"); }
    }
};

constexpr float PG_EPS = 1e-6f;
__device__ __forceinline__ f32x4 ada_scale(f32x4 v) { f32x4 r;
#pragma unroll
    for (int e = 0; e < 4; ++e) { const float x = 1.0f + v[e]; r[e] = fabsf(x) < 9.5367431640625e-07f ? (x < 0.f ? -9.5367431640625e-07f : 9.5367431640625e-07f) : x; }
    return r; }
template <bool HALFC, int RMODE, bool WAN, bool WH> struct EpiResidNorm {
    static constexpr int ID = HALFC ? 2 : 3;
    static constexpr bool PERM = true, AFTER_DRAIN = false, PREF = false;
    const void* res; bf16_t* hout; const float* gate; int sc_delta; int sp_delta; bf16_t* AN; float* ss;
    __device__ __forceinline__ void operator()(const f32x4 (&acc)[2][2][4][2], const Unit& u, int wr, int wc, int fr, int fq) const { run<true>(acc, u, wr, wc, fr, fq); }
    template <bool ATOM> __device__ __forceinline__ void run(const f32x4 (&acc)[2][2][4][2], const Unit& u, int wr, int wc, int fr, int fq) const {
        const int row0 = u.pm * BM + wr * 64 + fr, col0 = u.pn * BM + wc * 32 + 8 * fq;
        const float* gp = gate + (size_t)(u.pm >> 3) * 9216 + col0; constexpr float coef = HALFC ? 0.5f : 1.0f;
        f32x4 gv[2][2], sv[2][2], iv[2][2];
#pragma unroll
        for (int bj = 0; bj < 2; ++bj)
#pragma unroll
            for (int n = 0; n < 2; ++n) { gv[bj][n] = *(const f32x4*)(gp + bj * HALF + n * 4) * coef;
                if constexpr (WAN) sv[bj][n] = ada_scale(*(const f32x4*)(gp + sc_delta + bj * HALF + n * 4));
                if constexpr (RMODE == 2) { const f32x4 p = ada_scale(*(const f32x4*)(gp + sp_delta + bj * HALF + n * 4)); iv[bj][n] = (f32x4){__builtin_amdgcn_rcpf(p[0]), __builtin_amdgcn_rcpf(p[1]), __builtin_amdgcn_rcpf(p[2]), __builtin_amdgcn_rcpf(p[3])}; } }
        constexpr int PD = (RMODE == 2) ? 2 : 1;
        u32x4 rw[8][2]; f32x4 rf[8][2][2];
#define RES_LOAD(i) do { const size_t off_ = (size_t)(row0 + ((i) >> 2) * HALF + ((i) & 3) * 16) * 1024 + col0; \
            _Pragma("unroll") for (int bj = 0; bj < 2; ++bj) { \
                if constexpr (RMODE == 2) rw[i][bj] = *(const u32x4*)((const bf16_t*)res + off_ + bj * HALF); \
                else { rf[i][bj][0] = *(const f32x4*)((const float*)res + off_ + bj * HALF); rf[i][bj][1] = *(const f32x4*)((const float*)res + off_ + bj * HALF + 4); } } } while (0)
#pragma unroll
        for (int i = 0; i < PD; ++i) RES_LOAD(i);
#pragma unroll
        for (int i = 0; i < 8; ++i) {
            if (i + PD < 8) RES_LOAD(i + PD);
            const int ai = i >> 2, m = i & 3;
            const int row = row0 + ai * HALF + m * 16; const size_t off = (size_t)row * 1024 + col0;
            float q = 0.f;
#pragma unroll
            for (int bj = 0; bj < 2; ++bj) {
                f32x4 r0, r1;
                if constexpr (RMODE == 2) { const u32x4 w = rw[i][bj];
                    r0 = (f32x4){__uint_as_float(w.x << 16), __uint_as_float(w.x & 0xffff0000u), __uint_as_float(w.y << 16), __uint_as_float(w.y & 0xffff0000u)} * iv[bj][0];
                    r1 = (f32x4){__uint_as_float(w.z << 16), __uint_as_float(w.z & 0xffff0000u), __uint_as_float(w.w << 16), __uint_as_float(w.w & 0xffff0000u)} * iv[bj][1]; }
                else { r0 = rf[i][bj][0]; r1 = rf[i][bj][1]; }
                const f32x4 o0 = r0 + gv[bj][0] * acc[ai][bj][m][0], o1 = r1 + gv[bj][1] * acc[ai][bj][m][1];
                if constexpr (WH) { u32x4 hw; hw.x = cvt_pk_bf16(o0[0], o0[1]); hw.y = cvt_pk_bf16(o0[2], o0[3]); hw.z = cvt_pk_bf16(o1[0], o1[1]); hw.w = cvt_pk_bf16(o1[2], o1[3]);
                    *(u32x4*)(hout + off + bj * HALF) = hw; }
                q += (o0[0] * o0[0] + o0[1] * o0[1]) + (o0[2] * o0[2] + o0[3] * o0[3]) + (o1[0] * o1[0] + o1[1] * o1[1]) + (o1[2] * o1[2] + o1[3] * o1[3]);
                if constexpr (WAN) { const f32x4 a0 = o0 * sv[bj][0], a1 = o1 * sv[bj][1];
                    u32x4 w; w.x = cvt_pk_bf16(a0[0], a0[1]); w.y = cvt_pk_bf16(a0[2], a0[3]); w.z = cvt_pk_bf16(a1[0], a1[1]); w.w = cvt_pk_bf16(a1[2], a1[3]);
                    *(u32x4*)(AN + off + bj * HALF) = w; } }
            q += __shfl_xor(q, 16); q += __shfl_xor(q, 32);
            if (ATOM && fq == 0) (void)__hip_atomic_fetch_add((__attribute__((address_space(1))) float*)(ss + row), q, __ATOMIC_RELAXED, __HIP_MEMORY_SCOPE_AGENT);
            asm volatile("" ::: "memory");
        }
#undef RES_LOAD
    }
};
template <bool HALFC> struct EpiResidOut {
    static constexpr int ID = 26;
    static constexpr bool PERM = true, AFTER_DRAIN = false, PREF = false;
    const bf16_t* res; float* out; const float* gate;
    __device__ __forceinline__ void operator()(const f32x4 (&acc)[2][2][4][2], const Unit& u, int wr, int wc, int fr, int fq) const {
        const int row0 = u.pm * BM + wr * 64 + fr, col0 = u.pn * BM + wc * 32 + 8 * fq;
        const float* gp = gate + (size_t)(u.pm >> 3) * 9216 + col0; constexpr float coef = HALFC ? 0.5f : 1.0f;
        f32x4 gv[2][2];
#pragma unroll
        for (int bj = 0; bj < 2; ++bj)
#pragma unroll
            for (int n = 0; n < 2; ++n) gv[bj][n] = *(const f32x4*)(gp + bj * HALF + n * 4) * coef;
#pragma unroll
        for (int ai = 0; ai < 2; ++ai) {
            u32x4 rw[4][2];
#pragma unroll
            for (int m = 0; m < 4; ++m) { const size_t off = (size_t)(row0 + ai * HALF + m * 16) * 1024 + col0;
#pragma unroll
                for (int bj = 0; bj < 2; ++bj) rw[m][bj] = *(const u32x4*)(res + off + bj * HALF); }
#pragma unroll
            for (int m = 0; m < 4; ++m) { const size_t off = (size_t)(row0 + ai * HALF + m * 16) * 1024 + col0;
#pragma unroll
                for (int bj = 0; bj < 2; ++bj) { const u32x4 w = rw[m][bj];
                    const f32x4 r0 = {__uint_as_float(w.x << 16), __uint_as_float(w.x & 0xffff0000u), __uint_as_float(w.y << 16), __uint_as_float(w.y & 0xffff0000u)};
                    const f32x4 r1 = {__uint_as_float(w.z << 16), __uint_as_float(w.z & 0xffff0000u), __uint_as_float(w.w << 16), __uint_as_float(w.w & 0xffff0000u)};
                    *(f32x4*)(out + off + bj * HALF) = r0 + gv[bj][0] * acc[ai][bj][m][0]; *(f32x4*)(out + off + bj * HALF + 4) = r1 + gv[bj][1] * acc[ai][bj][m][1]; } }
            asm volatile("" ::: "memory"); }
    }
};
struct EpiSwigluN {
    static constexpr int ID = 1;
    static constexpr bool PERM = true, AFTER_DRAIN = false, PREF = true;
    bf16_t* O; int ldc; const float* ss; const float* bias; int nb;
    __device__ __forceinline__ float prefetch(const Unit& u, int tid) const {
        return tid < 256 ? ss[u.pm * BM + tid] : bias[(size_t)(u.pm >> 3) * nb + u.pn * BM + (tid - 256)]; }
    __device__ __forceinline__ void operator()(const f32x4 (&acc)[2][2][4][2], const Unit& u, int wr, int wc, int fr, int fq, float pre, PG8_LAS float* sp) const {
        const int tid = threadIdx.x;
        sp[tid] = tid < 256 ? __builtin_amdgcn_rsqf(pre * (1.0f / 1024.0f) + PG_EPS) : pre;
        asm volatile("s_waitcnt lgkmcnt(0)" ::: "memory"); __builtin_amdgcn_s_barrier(); asm volatile("" ::: "memory");
        const int row0 = u.pm * BM + wr * 64 + fr, col0 = u.pn * HALF + wc * 32 + 8 * fq;
        const PkC pkc;
        f32x4 bv[2][2];
#pragma unroll
        for (int bj = 0; bj < 2; ++bj)
#pragma unroll
            for (int n = 0; n < 2; ++n) bv[bj][n] = *(const PG8_LAS f32x4*)(sp + 256 + bj * HALF + wc * 32 + 8 * fq + n * 4);
#pragma unroll
        for (int ai = 0; ai < 2; ++ai)
#pragma unroll
            for (int m = 0; m < 4; ++m) { const int rl = ai * HALF + wr * 64 + m * 16 + fr; bf16_t* rowp = O + (size_t)(u.pm * BM + rl) * ldc + col0;
                const float rs = sp[rl];
                const f32x4 o0 = swiglu4(acc[ai][0][m][0] * rs + bv[0][0], acc[ai][1][m][0] * rs + bv[1][0], pkc), o1 = swiglu4(acc[ai][0][m][1] * rs + bv[0][1], acc[ai][1][m][1] * rs + bv[1][1], pkc);
                u32x4 w; w.x = cvt_pk_bf16(o0[0], o0[1]); w.y = cvt_pk_bf16(o0[2], o0[3]); w.z = cvt_pk_bf16(o1[0], o1[1]); w.w = cvt_pk_bf16(o1[2], o1[3]);
                *(u32x4*)rowp = w; }
        (void)row0;
    }
};
struct EpiG3N {
    static constexpr int ID = 23;
    static constexpr bool PERM = true, AFTER_DRAIN = false, PREF = true;
    bf16_t* ZGb; bf16_t* ZCb; const float* ss; const float* bias; size_t dzg, dzc;
    __device__ __forceinline__ float prefetch(const Unit& u, int tid) const {
        return tid < 256 ? ss[u.pm * BM + tid] : bias[(size_t)(u.pm >> 3) * 1536 + u.pn * BM + (tid - 256)]; }
    __device__ __forceinline__ void operator()(const f32x4 (&acc)[2][2][4][2], const Unit& u, int wr, int wc, int fr, int fq, float pre, PG8_LAS float* sp) const {
        { const int tid = threadIdx.x; sp[tid] = tid < 256 ? __builtin_amdgcn_rsqf(pre * (1.0f / 1024.0f) + PG_EPS) : pre; }
        asm volatile("s_waitcnt lgkmcnt(0)" ::: "memory"); __builtin_amdgcn_s_barrier(); asm volatile("" ::: "memory");
        const int row0 = u.pm * BM + wr * 64 + fr;
        bf16_t* const ZG = ZGb + (size_t)(u.pm >> 4) * dzg; bf16_t* const ZC = ZCb + (size_t)(u.pm >> 4) * dzc;
        f32x4 bv[2][2];
#pragma unroll
        for (int bj = 0; bj < 2; ++bj)
#pragma unroll
            for (int n = 0; n < 2; ++n) bv[bj][n] = *(const PG8_LAS f32x4*)(sp + 256 + bj * HALF + wc * 32 + 8 * fq + n * 4);
        if (u.pn < 4) {
            const PkC pkc;
            const int col0 = u.pn * HALF + wc * 32 + 8 * fq;
#pragma unroll
            for (int ai = 0; ai < 2; ++ai)
#pragma unroll
                for (int m = 0; m < 4; ++m) { const int row = row0 + ai * HALF + m * 16; bf16_t* rowp = ZG + (size_t)row * 512 + col0;
                    const float rs = sp[row - u.pm * BM];
                    const f32x4 o0 = (acc[ai][0][m][0] * rs + bv[0][0]) * sigm4(acc[ai][1][m][0] * rs + bv[1][0], pkc), o1 = (acc[ai][0][m][1] * rs + bv[0][1]) * sigm4(acc[ai][1][m][1] * rs + bv[1][1], pkc);
                    u32x4 w; w.x = cvt_pk_bf16(o0[0], o0[1]); w.y = cvt_pk_bf16(o0[2], o0[3]); w.z = cvt_pk_bf16(o1[0], o1[1]); w.w = cvt_pk_bf16(o1[2], o1[3]);
                    *(u32x4*)rowp = w; }
        } else {
            const int col0 = (u.pn - 4) * BM + wc * 32 + 8 * fq;
#pragma unroll
            for (int ai = 0; ai < 2; ++ai)
#pragma unroll
                for (int m = 0; m < 4; ++m) { const int row = row0 + ai * HALF + m * 16;
                    const float rs = sp[row - u.pm * BM];
#pragma unroll
                    for (int bj = 0; bj < 2; ++bj) { const f32x4 v0 = acc[ai][bj][m][0] * rs + bv[bj][0], v1 = acc[ai][bj][m][1] * rs + bv[bj][1];
                        u32x4 w; w.x = cvt_pk_bf16(v0[0], v0[1]); w.y = cvt_pk_bf16(v0[2], v0[3]); w.z = cvt_pk_bf16(v1[0], v1[1]); w.w = cvt_pk_bf16(v1[2], v1[3]);
                        const int c8 = col0 + bj * HALF, kb = c8 >> 4;
                        if (kb < 26) *(u32x4*)((char*)ZC + ((size_t)((row >> 5) * 26 + kb) * 1024 + ((c8 >> 3) & 1) * 512 + (row & 31) * 16)) = w; } }
        }
    }
};

template <class Epi, class Sched, bool ALIGN_EPI = false, bool SP2 = false>
__device__ __forceinline__ void gemm_phase(PG8_LAS unsigned char* lds, const Gemm g, const Sched& S, const Epi& E) {
    const int tid = threadIdx.x, wid = __builtin_amdgcn_readfirstlane(tid >> 6), lane = tid & 63, wr = wid >> 2, wc = wid & 3, fr = lane & 15, fq = lane >> 4;
    const int K = g.K, nt = K / BK;
    unsigned voffA[2], voffB[2];
#pragma unroll
    for (int i = 0; i < 2; ++i) { int R, C; stage_rc(tid * 16 + i * 8192, R, C); const int Rb = Epi::PERM ? ((R & ~31) + perm32(R & 31)) : R;
        voffA[i] = (unsigned)(R * K + C) * 2u; voffB[i] = (unsigned)(Rb * K + C) * 2u; }
    const size_t kstep = (size_t)(BK * 2);
    const size_t hstep = (size_t)HALF * K * 2;
    const size_t tstep = 2 * hstep;
    const unsigned ldsw = (unsigned)wid * 1024u;
    const int aoff = lds_byte(wr * 64 + fr, fq * 8), boff = lds_byte(wc * 32 + fr, fq * 8);
#define PG8_SA(b, h) (((b) * 2 + (h)) * HTB)
#define PG8_SB(b, h) ((4 + (b) * 2 + (h)) * HTB)
#define PG8_STAGE(bufoff, gbase, voff) do { _Pragma("unroll") for (int _i = 0; _i < 2; ++_i) \
        __builtin_amdgcn_global_load_lds((const unsigned*)((const char*)(gbase) + (voff)[_i]), (PG8_LAS unsigned*)(lds + (bufoff) + ldsw + _i * 8192), 16, 0, 0); } while (0)
#define PG8_LDA(dst, b, h) do { _Pragma("unroll") for (int m = 0; m < 4; ++m) _Pragma("unroll") for (int k = 0; k < 2; ++k) dst[m][k] = *(const PG8_LAS bf16x8*)(lds + PG8_SA(b, h) + aoff + m * 2048 + k * 1024); } while (0)
#define PG8_LDB(dst, b, h) do { _Pragma("unroll") for (int n = 0; n < 2; ++n) _Pragma("unroll") for (int k = 0; k < 2; ++k) dst[n][k] = *(const PG8_LAS bf16x8*)(lds + PG8_SB(b, h) + boff + n * 2048 + k * 1024); } while (0)
#define PG8_MMA(ai, bj, At, Bt) do { __builtin_amdgcn_s_setprio(1); _Pragma("unroll") for (int m = 0; m < 4; ++m) _Pragma("unroll") for (int n = 0; n < 2; ++n) _Pragma("unroll") for (int k = 0; k < 2; ++k) \
        acc[ai][bj][m][n] = __builtin_amdgcn_mfma_f32_16x16x32_bf16(Bt[n][k], At[m][k], acc[ai][bj][m][n], 0, 0, 0); __builtin_amdgcn_s_setprio(0); } while (0)
#define PG8_WAIT_V(n) asm volatile("s_waitcnt vmcnt(" #n ")" ::: "memory")
#define PG8_WAIT_L(n) asm volatile("s_waitcnt lgkmcnt(" #n ")" ::: "memory")
#define PG8_BAR __builtin_amdgcn_s_barrier()
#define PG8_SCHED __builtin_amdgcn_sched_barrier(0)
    Unit cur, nxt; int ui = 0;
    if (!S.next(0, cur)) return;
    float epre = 0.f; if constexpr (Epi::PREF) epre = E.prefetch(cur, tid);
    f32x4 acc[2][2][4][2];
#pragma unroll
    for (int a = 0; a < 2; ++a)
#pragma unroll
        for (int b = 0; b < 2; ++b)
#pragma unroll
            for (int m = 0; m < 4; ++m)
#pragma unroll
                for (int n = 0; n < 2; ++n) acc[a][b][m][n] = (f32x4){0.f, 0.f, 0.f, 0.f};
    bf16x8 At[4][2], B0[2][2], B1[2][2];
    const char* cA = (const char*)g.A + (size_t)cur.pm * tstep; const char* cB = (const char*)g.Bt + (size_t)cur.pn * tstep;
    S.a_ready(cur);
    if constexpr (SP2) {
        PG8_STAGE(PG8_SB(0, 0), cB, voffB); PG8_STAGE(PG8_SB(0, 1), cB + hstep, voffB); PG8_STAGE(PG8_SA(0, 0), cA, voffA); PG8_STAGE(PG8_SA(0, 1), cA + hstep, voffA);
        if (wr == 1) PG8_BAR;
        PG8_WAIT_V(2); PG8_BAR;
        PG8_STAGE(PG8_SB(1, 0), cB + kstep, voffB); PG8_STAGE(PG8_SA(1, 0), cA + kstep, voffA); PG8_STAGE(PG8_SB(1, 1), cB + hstep + kstep, voffB);
        PG8_WAIT_V(6); PG8_BAR;
    } else {
        PG8_STAGE(PG8_SB(0, 0), cB, voffB); PG8_STAGE(PG8_SA(0, 0), cA, voffA); PG8_STAGE(PG8_SB(0, 1), cB + hstep, voffB); PG8_STAGE(PG8_SA(0, 1), cA + hstep, voffA);
        if (wr == 1) PG8_BAR;
        PG8_WAIT_V(4); PG8_BAR;
        PG8_STAGE(PG8_SB(1, 0), cB + kstep, voffB); PG8_STAGE(PG8_SA(1, 0), cA + kstep, voffA); PG8_STAGE(PG8_SB(1, 1), cB + hstep + kstep, voffB);
        PG8_WAIT_V(6); PG8_BAR;
    }
    for (;;) {
        const bool has_next = S.next(ui + 1, nxt);
        const char* nA = has_next ? (const char*)g.A + (size_t)nxt.pm * tstep : cA; const char* nB = has_next ? (const char*)g.Bt + (size_t)nxt.pn * tstep : cB;
        for (int t = 0; t < nt; t += 2) {
            const bool last = (t == nt - 2);
            const char* a1 = cA + (size_t)(t + 1) * kstep;
            const char* a2 = last ? nA : cA + (size_t)(t + 2) * kstep; const char* b2 = last ? nB : cB + (size_t)(t + 2) * kstep;
            const char* a3 = a2 + kstep; const char* b3 = b2 + kstep;
            if (last && has_next) S.a_ready(nxt);
            if constexpr (SP2) {
            PG8_LDB(B0, 0, 0); PG8_LDB(B1, 0, 1); PG8_SCHED; PG8_LDA(At, 0, 0); PG8_STAGE(PG8_SA(1, 1), a1 + hstep, voffA);
            PG8_WAIT_V(8); PG8_WAIT_L(0); PG8_BAR; PG8_MMA(0, 0, At, B0); PG8_MMA(0, 1, At, B1); PG8_BAR; PG8_SCHED;
            PG8_LDA(At, 0, 1); PG8_STAGE(PG8_SB(0, 0), b2, voffB); PG8_STAGE(PG8_SB(0, 1), b2 + hstep, voffB); PG8_STAGE(PG8_SA(0, 0), a2, voffA);
            PG8_WAIT_V(8); PG8_WAIT_L(0); PG8_BAR; PG8_MMA(1, 0, At, B0); PG8_MMA(1, 1, At, B1); PG8_BAR; PG8_SCHED;
            PG8_LDB(B0, 1, 0); PG8_LDB(B1, 1, 1); PG8_SCHED; PG8_LDA(At, 1, 0); PG8_STAGE(PG8_SA(0, 1), a2 + hstep, voffA);
            PG8_WAIT_V(8); PG8_WAIT_L(0); PG8_BAR; PG8_MMA(0, 0, At, B0); PG8_MMA(0, 1, At, B1); PG8_BAR; PG8_SCHED;
            PG8_LDA(At, 1, 1); PG8_STAGE(PG8_SB(1, 0), b3, voffB); PG8_STAGE(PG8_SB(1, 1), b3 + hstep, voffB); PG8_STAGE(PG8_SA(1, 0), a3, voffA);
            PG8_WAIT_V(8); PG8_WAIT_L(0); PG8_BAR; PG8_MMA(1, 0, At, B0); PG8_MMA(1, 1, At, B1); PG8_BAR; PG8_SCHED;
            } else {
            PG8_LDB(B0, 0, 0); PG8_SCHED; PG8_LDA(At, 0, 0); PG8_STAGE(PG8_SA(1, 1), a1 + hstep, voffA);
            PG8_WAIT_L(8); PG8_BAR; PG8_WAIT_L(0); PG8_MMA(0, 0, At, B0); PG8_BAR; PG8_SCHED;
            PG8_LDB(B1, 0, 1); PG8_STAGE(PG8_SB(0, 0), b2, voffB);
            PG8_BAR; PG8_WAIT_L(0); PG8_MMA(0, 1, At, B1); PG8_BAR;
            PG8_LDA(At, 0, 1); PG8_STAGE(PG8_SA(0, 0), a2, voffA);
            PG8_BAR; PG8_WAIT_L(0); PG8_MMA(1, 0, At, B0); PG8_BAR; PG8_SCHED;
            PG8_STAGE(PG8_SB(0, 1), b2 + hstep, voffB);
            PG8_WAIT_V(6); PG8_BAR; PG8_MMA(1, 1, At, B1); PG8_BAR;
            PG8_LDB(B0, 1, 0); PG8_SCHED; PG8_LDA(At, 1, 0); PG8_STAGE(PG8_SA(0, 1), a2 + hstep, voffA);
            PG8_WAIT_L(8); PG8_BAR; PG8_WAIT_L(0); PG8_MMA(0, 0, At, B0); PG8_BAR; PG8_SCHED;
            PG8_LDB(B1, 1, 1); PG8_STAGE(PG8_SB(1, 0), b3, voffB);
            PG8_BAR; PG8_WAIT_L(0); PG8_MMA(0, 1, At, B1); PG8_BAR;
            PG8_LDA(At, 1, 1); PG8_STAGE(PG8_SA(1, 0), a3, voffA);
            PG8_BAR; PG8_WAIT_L(0); PG8_MMA(1, 0, At, B0); PG8_BAR; PG8_SCHED;
            PG8_STAGE(PG8_SB(1, 1), b3 + hstep, voffB);
            PG8_WAIT_V(6); PG8_BAR; PG8_MMA(1, 1, At, B1); PG8_BAR;
            }
        }
        if constexpr (ALIGN_EPI) { if (wr == 0) PG8_BAR; }
        if constexpr (!Epi::AFTER_DRAIN) { if constexpr (Epi::PREF) E(acc, cur, wr, wc, fr, fq, epre, (PG8_LAS float*)(lds + STAGE_BYTES)); else E(acc, cur, wr, wc, fr, fq);
#ifdef EPI_REP_DISABLED
            if constexpr (((EPI_REP >> Epi::ID) & 1) != 0) { asm volatile("" ::: "memory"); if constexpr (Epi::ID == 2) E.template run<false>(acc, cur, wr, wc, fr, fq); else E(acc, cur, wr, wc, fr, fq); }
#endif
            S.done(cur); }
        if (!has_next) break;
#pragma unroll
        for (int a = 0; a < 2; ++a)
#pragma unroll
            for (int b = 0; b < 2; ++b)
#pragma unroll
                for (int m = 0; m < 4; ++m)
#pragma unroll
                    for (int n = 0; n < 2; ++n) acc[a][b][m][n] = (f32x4){0.f, 0.f, 0.f, 0.f};
        cur = nxt; cA = nA; cB = nB; ++ui;
        if constexpr (Epi::PREF) epre = E.prefetch(cur, tid);
        if constexpr (ALIGN_EPI) { if (wr == 1) PG8_BAR; }
    }
    PG8_WAIT_V(0);
    if constexpr (!ALIGN_EPI) { if (wr == 0) PG8_BAR; }
    PG8_BAR;
    if constexpr (Epi::AFTER_DRAIN) { E.fused(acc, cur, wr, wc, fr, fq, lds, wid, lane); S.done(cur); }
#undef PG8_SA
#undef PG8_SB
#undef PG8_STAGE
#undef PG8_LDA
#undef PG8_LDB
#undef PG8_MMA
#undef PG8_WAIT_V
#undef PG8_WAIT_L
#undef PG8_BAR
#undef PG8_SCHED
}
}
namespace att {
using bf16x8 = __attribute__((ext_vector_type(8))) short;
using s16x4  = __attribute__((ext_vector_type(4))) short;
using f32x16 = __attribute__((ext_vector_type(16))) float;
using u32x4  = __attribute__((ext_vector_type(4))) unsigned;
typedef unsigned short bf16_t;
constexpr int DQK = 96, DV = 64, NW = 8, QBLK = 32, KVBLK = 64;
constexpr float QSCALE = 0.10206207261596575f * 1.4426950408889634f;
constexpr float THRL = 11.5f;
constexpr int SHM_V = KVBLK * DV * 2, SHM_K = KVBLK * 256;
constexpr int OST_W = 32 * 144;
constexpr int OFF_V = 0, OFF_K = 2 * SHM_V, OFF_OST = OFF_K + 2 * SHM_K, SHM_ATTN = OFF_OST + NW * OST_W;
#define KSWZ(row, colB) ((row) * 256 + ((colB) ^ (((row) & 15) << 4)))
#define SBAR() __builtin_amdgcn_sched_barrier(0)
__device__ __forceinline__ int crow(int r, int hi) { return (r & 3) + 8 * (r >> 2) + 4 * hi; }
__device__ __forceinline__ unsigned cvtpk(float lo, float hi) { unsigned r; asm volatile("v_cvt_pk_bf16_f32 %0, %1, %2" : "=v"(r) : "v"(lo), "v"(hi)); return r; }
typedef __bf16 bf16n2 __attribute__((ext_vector_type(2)));
typedef float f32n2 __attribute__((ext_vector_type(2)));
__device__ __forceinline__ unsigned cvtpk_n(float lo, float hi) { const f32n2 v = {lo, hi}; return __builtin_bit_cast(unsigned, __builtin_convertvector(v, bf16n2)); }
__device__ __forceinline__ bf16x8 ld8(const bf16_t* p) { return *reinterpret_cast<const bf16x8*>(p); }
__device__ __forceinline__ float max3(float a, float b, float c) { return fmaxf(fmaxf(a, b), c); }

template <bool FIRST, int ABL = 0> __device__ __forceinline__ void partialSM(f32x16& p0, f32x16& p1, float& mref, float& alpha) {
  if constexpr (ABL & 1) { alpha = 1.f; return; }
  float a = max3(p0[0], p0[1], p0[2]), b = max3(p1[0], p1[1], p1[2]);
#pragma unroll
  for (int r = 3; r < 15; r += 2) { a = max3(a, p0[r], p0[r + 1]); b = max3(b, p1[r], p1[r + 1]); }
  float pmax = max3(a, b, fmaxf(p0[15], p1[15]));
  { auto rr = __builtin_amdgcn_permlane32_swap(__float_as_uint(pmax), __float_as_uint(pmax), false, false);
    pmax = fmaxf(__uint_as_float(rr[0]), __uint_as_float(rr[1])); }
  pmax -= mref;
  if (__builtin_expect(__all(FIRST ? (fabsf(pmax) <= THRL) : (pmax <= THRL)), 1)) { alpha = 1.f; }
  else { const float dl = FIRST ? pmax : fmaxf(pmax, 0.f); mref += dl; alpha = __builtin_amdgcn_exp2f(-dl); }
  if (__any(mref != 0.f)) {
#pragma unroll
    for (int r = 0; r < 16; ++r) { p0[r] -= mref; p1[r] -= mref; } }
#pragma unroll
  for (int r = 0; r < 16; ++r) p0[r] = __builtin_amdgcn_exp2f(p0[r]);
}
template <int ABL = 0> __device__ __forceinline__ void finishSM(f32x16& p0, f32x16& p1, float alpha, float& l_reg, bf16x8& pa0, bf16x8& pa1, bf16x8& pa2, bf16x8& pa3) {
  if constexpr (!(ABL & 1)) {
#pragma unroll
  for (int r = 0; r < 16; ++r) p1[r] = __builtin_amdgcn_exp2f(p1[r]);
  float ps0 = 0.f, ps1 = 0.f;
#pragma unroll
  for (int r = 0; r < 16; ++r) { ps0 += p0[r]; ps1 += p1[r]; }
  l_reg = l_reg * alpha + (ps0 + ps1); } else { l_reg = 1.f; }
#define PK8(P, BASE, OUT) do { u32x4 w = {cvtpk(P[BASE + 0], P[BASE + 1]), cvtpk(P[BASE + 2], P[BASE + 3]), cvtpk(P[BASE + 4], P[BASE + 5]), cvtpk(P[BASE + 6], P[BASE + 7])}; \
    OUT = *reinterpret_cast<bf16x8*>(&w); } while (0)
  PK8(p0, 0, pa0); PK8(p0, 8, pa1); PK8(p1, 0, pa2); PK8(p1, 8, pa3);
#undef PK8
}
template <int ABL = 0> __device__ __forceinline__ void qkt(f32x16& p0, f32x16& p1, const char* Ks, const bf16x8* qr, int r32, int hi) {
  p0 = f32x16{}; p1 = f32x16{};
  if constexpr (ABL & 4) {
#pragma unroll
    for (int d0 = 0; d0 < 6; ++d0) { int cb = (d0 * 16 + hi * 8) * 2;
      bf16x8 b0 = *reinterpret_cast<const bf16x8*>(Ks + KSWZ(r32, cb)); bf16x8 b1 = *reinterpret_cast<const bf16x8*>(Ks + KSWZ(32 + r32, cb));
      asm volatile("" :: "v"(b0), "v"(b1)); }
    return; }
#pragma unroll
  for (int d0 = 0; d0 < 6; ++d0) { int cb = (d0 * 16 + hi * 8) * 2;
    bf16x8 b0 = *reinterpret_cast<const bf16x8*>(Ks + KSWZ(r32, cb));
    bf16x8 b1 = *reinterpret_cast<const bf16x8*>(Ks + KSWZ(32 + r32, cb));
    p0 = __builtin_amdgcn_mfma_f32_32x32x16_bf16(b0, qr[d0], p0, 0, 0, 0); p1 = __builtin_amdgcn_mfma_f32_32x32x16_bf16(b1, qr[d0], p1, 0, 0, 0); }
}
__device__ __forceinline__ int v_st(int k, int c) { return ((k >> 3) * 2 + (c >> 5)) * 512 + ((k & 7) * 32 + (c & 31)) * 2; }
__device__ __forceinline__ int v_rd_base(int lane) { return ((lane & 3) << 3) | (((lane >> 2) & 3) << 6) | (((lane >> 4) & 1) << 5) | (((lane >> 5) & 1) << 8); }
constexpr int v_rd_off(int d0, int ks, int half) { return d0 * 512 + ks * 2048 + half * 1024; }
template <int OFF> __device__ __forceinline__ s16x4 tr_read(int vb) {
  s16x4 r; asm volatile("ds_read_b64_tr_b16 %0, %1 offset:%2" : "=&v"(r) : "v"(vb), "i"(OFF) : "memory"); return r;
}
template <int D0> __device__ __forceinline__ void pv_one(f32x16& od, int vb, bf16x8 pa0, bf16x8 pa1, bf16x8 pa2, bf16x8 pa3) {
  const s16x4 l0 = tr_read<v_rd_off(D0, 0, 0)>(vb), h0 = tr_read<v_rd_off(D0, 0, 1)>(vb), l1 = tr_read<v_rd_off(D0, 1, 0)>(vb), h1 = tr_read<v_rd_off(D0, 1, 1)>(vb);
  const s16x4 l2 = tr_read<v_rd_off(D0, 2, 0)>(vb), h2 = tr_read<v_rd_off(D0, 2, 1)>(vb), l3 = tr_read<v_rd_off(D0, 3, 0)>(vb), h3 = tr_read<v_rd_off(D0, 3, 1)>(vb);
  asm volatile("s_waitcnt lgkmcnt(0)" ::: "memory"); SBAR();
#define PK(L, H) (bf16x8){L[0], L[1], L[2], L[3], H[0], H[1], H[2], H[3]}
  od = __builtin_amdgcn_mfma_f32_32x32x16_bf16(PK(l0, h0), pa0, od, 0, 0, 0);
  od = __builtin_amdgcn_mfma_f32_32x32x16_bf16(PK(l1, h1), pa1, od, 0, 0, 0);
  od = __builtin_amdgcn_mfma_f32_32x32x16_bf16(PK(l2, h2), pa2, od, 0, 0, 0);
  od = __builtin_amdgcn_mfma_f32_32x32x16_bf16(PK(l3, h3), pa3, od, 0, 0, 0);
#undef PK
}
__device__ __forceinline__ void pv_d0(f32x16* o, int vb, bf16x8 pa0, bf16x8 pa1, bf16x8 pa2, bf16x8 pa3) {
  pv_one<0>(o[0], vb, pa0, pa1, pa2, pa3); pv_one<1>(o[1], vb, pa0, pa1, pa2, pa3);
}
__device__ __forceinline__ void glds16(const void* gsrc, unsigned lds_dst) { unsigned keep;
  asm volatile("s_mov_b32 %0, m0\n\ts_mov_b32 m0, %2\n\ts_nop 0\n\tglobal_load_lds_dwordx4 %1, off\n\ts_mov_b32 m0, %0" : "=&s"(keep) : "v"(gsrc), "s"(lds_dst) : "memory"); }
struct VFrag { s16x4 l[4], h[4]; };
template <int D0> __device__ __forceinline__ void v_read(VFrag& f, int vb) {
  f.l[0] = tr_read<v_rd_off(D0, 0, 0)>(vb); f.h[0] = tr_read<v_rd_off(D0, 0, 1)>(vb); f.l[1] = tr_read<v_rd_off(D0, 1, 0)>(vb); f.h[1] = tr_read<v_rd_off(D0, 1, 1)>(vb);
  f.l[2] = tr_read<v_rd_off(D0, 2, 0)>(vb); f.h[2] = tr_read<v_rd_off(D0, 2, 1)>(vb); f.l[3] = tr_read<v_rd_off(D0, 3, 0)>(vb); f.h[3] = tr_read<v_rd_off(D0, 3, 1)>(vb);
}
__device__ __forceinline__ void pv_blk(f32x16& od, const VFrag& f, bf16x8 pa0, bf16x8 pa1, bf16x8 pa2, bf16x8 pa3) {
#define PK(L, H) (bf16x8){L[0], L[1], L[2], L[3], H[0], H[1], H[2], H[3]}
  od = __builtin_amdgcn_mfma_f32_32x32x16_bf16(PK(f.l[0], f.h[0]), pa0, od, 0, 0, 0);
  od = __builtin_amdgcn_mfma_f32_32x32x16_bf16(PK(f.l[1], f.h[1]), pa1, od, 0, 0, 0);
  od = __builtin_amdgcn_mfma_f32_32x32x16_bf16(PK(f.l[2], f.h[2]), pa2, od, 0, 0, 0);
  od = __builtin_amdgcn_mfma_f32_32x32x16_bf16(PK(f.l[3], f.h[3]), pa3, od, 0, 0, 0);
#undef PK
}
constexpr int NSLOT = 3;
constexpr int RK = 0, RV = NSLOT * SHM_K, ROST = RV + NSLOT * SHM_V, SHM_ATTN2 = ROST + NW * OST_W;
template <int ABL = 0> __device__ __forceinline__ void attn_unit(const bf16_t* __restrict__ Qb, const bf16_t* __restrict__ Kh, const bf16_t* __restrict__ Vh, bf16_t* __restrict__ Ob, int ldo, int seq, char* lds) {
  const int tid = threadIdx.x, lane = tid & 63, r32 = lane & 31, hi = lane >> 5; const int wid = __builtin_amdgcn_readfirstlane(tid >> 6);
  const unsigned lds0 = (unsigned)(uintptr_t)lds;
  float mref = 0.f, l_reg = 0.f; f32x16 o[2] = {}; bf16x8 qr[6];
  const int krow = 4 * wid + (lane >> 4), kch = (lane & 15) ^ (krow & 15);
  const bf16_t* ksrc = Kh + (long)krow * DQK + (kch < 12 ? kch * 8 : 0);
  const bf16_t* vsrc = Vh + (long)(8 * wid + ((lane & 31) >> 2)) * DV + 32 * (lane >> 5) + 8 * (lane & 3);
  const unsigned kdst = lds0 + RK + wid * 1024, vdst = lds0 + RV + wid * 1024;
#define DMA_K(t, slot) do { if constexpr (ABL & 8) break; glds16(ksrc + (long)(t) * KVBLK * DQK, (unsigned)__builtin_amdgcn_readfirstlane(kdst + (slot) * SHM_K)); \
                            glds16(ksrc + (long)(t) * KVBLK * DQK + 32 * DQK, (unsigned)__builtin_amdgcn_readfirstlane(kdst + (slot) * SHM_K + 8192)); } while (0)
#define DMA_V(t, slot) do { if constexpr (!(ABL & 8)) glds16(vsrc + (long)(t) * KVBLK * DV, (unsigned)__builtin_amdgcn_readfirstlane(vdst + (slot) * SHM_V)); } while (0)
#define WAIT_BAR(N) asm volatile("s_waitcnt vmcnt(" #N ") lgkmcnt(0)\n\ts_barrier" ::: "memory")
  const int NT = seq / KVBLK;
  const bf16_t* Qw = Qb + (long)(wid * QBLK + r32) * DQK + hi * 8;
#pragma unroll
  for (int d0 = 0; d0 < 6; ++d0) qr[d0] = ld8(Qw + d0 * 16);
  asm volatile("" ::: "memory");
  DMA_K(0, 0); DMA_K(1, 1); DMA_V(0, 0);
  const int vb0 = (int)(lds0 + RV) + v_rd_base(lane);
#define RESC(a) do { if (__any((a) < 1.f)) { _Pragma("unroll") for (int d = 0; d < 2; ++d) _Pragma("unroll") for (int r = 0; r < 16; ++r) o[d][r] *= (a); } } while (0)
  f32x16 pA0, pA1, pB0, pB1; float alA, alB; bf16x8 pa0, pa1, pa2, pa3; VFrag vf, vg;
  int ks = 0, vs = 0;
#define ROTK() do { ks = (ks == NSLOT - 1) ? 0 : ks + 1; } while (0)
#define ROTV() do { vs = (vs == NSLOT - 1) ? 0 : vs + 1; } while (0)
#define TOP(t) do { if ((t) + 1 < NT) { WAIT_BAR(3); } else { WAIT_BAR(0); } \
    if ((t) + 2 < NT) { int kn = ks + 2; kn = kn >= NSLOT ? kn - NSLOT : kn; DMA_K((t) + 2, kn); } \
    if ((t) + 1 < NT) { int vn = vs + 2; vn = vn >= NSLOT ? vn - NSLOT : vn; DMA_V((t) + 1, vn); } SBAR(); } while (0)
#define C_QK(PC0, PC1) do { qkt<ABL>(PC0, PC1, lds + RK + ks * SHM_K, qr, r32, hi); SBAR(); } while (0)
#define C_FIN(PP0, PP1, ALP) do { v_read<0>(vf, vb0 + vs * SHM_V); finishSM<ABL>(PP0, PP1, ALP, l_reg, pa0, pa1, pa2, pa3); SBAR(); } while (0)
#define C_PV() do { asm volatile("s_waitcnt lgkmcnt(0)" ::: "memory"); SBAR(); v_read<1>(vg, vb0 + vs * SHM_V); SBAR(); \
    if constexpr (!(ABL & 2)) pv_blk(o[0], vf, pa0, pa1, pa2, pa3); else { asm volatile("" :: "v"(vf.l[0]), "v"(vf.h[3]), "v"(pa0), "v"(pa3)); } \
    asm volatile("s_waitcnt lgkmcnt(0)" ::: "memory"); SBAR(); \
    if constexpr (!(ABL & 2)) pv_blk(o[1], vg, pa0, pa1, pa2, pa3); else { asm volatile("" :: "v"(vg.l[0]), "v"(vg.h[3])); } SBAR(); } while (0)
#define C_PAR(FIRST_, PC0, PC1, ALC) do { partialSM<FIRST_, ABL>(PC0, PC1, mref, ALC); RESC(ALC); SBAR(); } while (0)
  if (wid < 4) {
    WAIT_BAR(3); DMA_K(2, 2); DMA_V(1, 1); SBAR(); C_QK(pA0, pA1); C_PAR(true, pA0, pA1, alA); ROTK();
    int t = 1;
    for (; t + 1 < NT; t += 2) {
      TOP(t);     C_QK(pB0, pB1); C_FIN(pA0, pA1, alA); C_PV(); C_PAR(false, pB0, pB1, alB); ROTK(); ROTV();
      TOP(t + 1); C_QK(pA0, pA1); C_FIN(pB0, pB1, alB); C_PV(); C_PAR(false, pA0, pA1, alA); ROTK(); ROTV();
    }
    TOP(NT - 1);  C_QK(pB0, pB1); C_FIN(pA0, pA1, alA); C_PV(); C_PAR(false, pB0, pB1, alB); ROTK(); ROTV();
    WAIT_BAR(0);
    C_FIN(pB0, pB1, alB); C_PV();
  } else {
    WAIT_BAR(3); DMA_K(2, 2); DMA_V(1, 1); SBAR(); C_QK(pA0, pA1); ROTK();
    TOP(1); C_PAR(true, pA0, pA1, alA); C_QK(pB0, pB1); C_FIN(pA0, pA1, alA); C_PV(); ROTK(); ROTV();
    int t = 2;
    for (; t + 1 < NT; t += 2) {
      TOP(t);     C_PAR(false, pB0, pB1, alB); C_QK(pA0, pA1); C_FIN(pB0, pB1, alB); C_PV(); ROTK(); ROTV();
      TOP(t + 1); C_PAR(false, pA0, pA1, alA); C_QK(pB0, pB1); C_FIN(pA0, pA1, alA); C_PV(); ROTK(); ROTV();
    }
    WAIT_BAR(0);
    C_PAR(false, pB0, pB1, alB); C_FIN(pB0, pB1, alB); C_PV();
  }
#undef TOP
#undef C_QK
#undef C_FIN
#undef C_PV
#undef C_PAR
  { auto rr = __builtin_amdgcn_permlane32_swap(__float_as_uint(l_reg), __float_as_uint(l_reg), false, false); l_reg = __uint_as_float(rr[0]) + __uint_as_float(rr[1]); }
  const float rl = __builtin_amdgcn_rcpf(l_reg);
  bf16_t* Ow = Ob + (long)(wid * QBLK) * ldo;
  { char* stg = lds + ROST + wid * OST_W;
#pragma unroll
    for (int d0 = 0; d0 < 2; ++d0)
#pragma unroll
      for (int g = 0; g < 4; ++g) { uint2 w; w.x = cvtpk(o[d0][4 * g] * rl, o[d0][4 * g + 1] * rl); w.y = cvtpk(o[d0][4 * g + 2] * rl, o[d0][4 * g + 3] * rl);
        *(uint2*)(stg + r32 * 144 + (32 * d0 + 8 * g + 4 * hi) * 2) = w; }
    asm volatile("s_waitcnt lgkmcnt(0)" ::: "memory");
#pragma unroll
    for (int i = 0; i < 4; ++i) { const int row = i * 8 + (lane >> 3), ch = lane & 7; const u32x4 v = *(const u32x4*)(stg + row * 144 + ch * 16); *(u32x4*)(Ow + (long)row * ldo + ch * 8) = v; } }
  asm volatile("s_waitcnt vmcnt(0) lgkmcnt(0)\n\ts_barrier" ::: "memory");
#undef DMA_K
#undef DMA_V
#undef WAIT_BAR
#undef RESC
#undef ROTK
#undef ROTV
}
template <bool NOMAX> __device__ __forceinline__ void softmax_blk(f32x16& p0, f32x16& p1, bool first, float& mref, float& l_reg, f32x16* o, bf16x8& pa0, bf16x8& pa1, bf16x8& pa2, bf16x8& pa3) {
  if constexpr (!NOMAX) {
  float a = max3(p0[0], p0[1], p0[2]), b = max3(p1[0], p1[1], p1[2]);
#pragma unroll
  for (int r = 3; r < 15; r += 2) { a = max3(a, p0[r], p0[r + 1]); b = max3(b, p1[r], p1[r + 1]); }
  float pmax = max3(a, b, fmaxf(p0[15], p1[15]));
  { auto rr = __builtin_amdgcn_permlane32_swap(__float_as_uint(pmax), __float_as_uint(pmax), false, false);
    pmax = fmaxf(__uint_as_float(rr[0]), __uint_as_float(rr[1])); }
  pmax -= mref;
  if (!__builtin_expect(__all(first ? (fabsf(pmax) <= THRL) : (pmax <= THRL)), 1)) {
    const float dl = first ? pmax : fmaxf(pmax, 0.f); mref += dl; const float alpha = __builtin_amdgcn_exp2f(-dl); l_reg *= alpha;
#pragma unroll
    for (int d = 0; d < 2; ++d)
#pragma unroll
      for (int r = 0; r < 16; ++r) o[d][r] *= alpha; }
  if (__any(mref != 0.f)) {
#pragma unroll
    for (int r = 0; r < 16; ++r) { p0[r] -= mref; p1[r] -= mref; } }
  }
#pragma unroll
  for (int r = 0; r < 16; ++r) { p0[r] = __builtin_amdgcn_exp2f(p0[r]); p1[r] = __builtin_amdgcn_exp2f(p1[r]); }
  float ps0 = 0.f, ps1 = 0.f;
#pragma unroll
  for (int r = 0; r < 16; ++r) { ps0 += p0[r]; ps1 += p1[r]; }
  l_reg += ps0 + ps1;
#define PK8(P, BASE, OUT) do { u32x4 w = {cvtpk(P[BASE + 0], P[BASE + 1]), cvtpk(P[BASE + 2], P[BASE + 3]), cvtpk(P[BASE + 4], P[BASE + 5]), cvtpk(P[BASE + 6], P[BASE + 7])}; \
    OUT = *reinterpret_cast<bf16x8*>(&w); } while (0)
  PK8(p0, 0, pa0); PK8(p0, 8, pa1); PK8(p1, 0, pa2); PK8(p1, 8, pa3);
#undef PK8
}
constexpr int NSV = 4;
constexpr int QB_W = 32 * 208;
constexpr int R2K = 0, R2V = NSLOT * SHM_K, R2Q = R2V + NSV * SHM_V, R2OST = R2K, SHM_ATTN3 = R2Q + NW * QB_W;
template <bool NOMAX> __device__ __forceinline__ void attn_unit64(const bf16_t* __restrict__ Qb, const bf16_t* __restrict__ Kh, const bf16_t* __restrict__ Vh, bf16_t* __restrict__ Ob, int ldo, int seq, char* lds) {
  const int tid = threadIdx.x, lane = tid & 63, r32 = lane & 31, hi = lane >> 5; const int wid = __builtin_amdgcn_readfirstlane(tid >> 6);
  const unsigned lds0 = (unsigned)(uintptr_t)lds;
  float mrefa = 0.f, la = 0.f, mrefb = 0.f, lb = 0.f; f32x16 oa[2] = {}, ob[2] = {}; bf16x8 qa[6];
  const int krow = 4 * wid + (lane >> 4), kch = (lane & 15) ^ (krow & 15);
  const bf16_t* ksrc = Kh + (long)krow * DQK + (kch < 12 ? kch * 8 : 0);
  const bf16_t* vsrc = Vh + (long)(8 * wid + ((lane & 31) >> 2)) * DV + 32 * (lane >> 5) + 8 * (lane & 3);
  const unsigned kdst = lds0 + R2K + wid * 1024, vdst = lds0 + R2V + wid * 1024;
#define DMA_K(t, slot) do { glds16(ksrc + (long)(t) * KVBLK * DQK, (unsigned)__builtin_amdgcn_readfirstlane(kdst + (slot) * SHM_K)); \
                            glds16(ksrc + (long)(t) * KVBLK * DQK + 32 * DQK, (unsigned)__builtin_amdgcn_readfirstlane(kdst + (slot) * SHM_K + 8192)); } while (0)
#define DMA_V(t, slot) glds16(vsrc + (long)(t) * KVBLK * DV, (unsigned)__builtin_amdgcn_readfirstlane(vdst + (slot) * SHM_V))
#define WAIT_BAR(N) asm volatile("s_waitcnt vmcnt(" #N ") lgkmcnt(0)\n\ts_barrier" ::: "memory")
  const int NT = seq / KVBLK;
  const bf16_t* Qw = Qb + (long)(wid * 64 + r32) * DQK + hi * 8;
  DMA_K(0, 0); DMA_V(0, 0); DMA_K(1, 1); DMA_V(1, 1);
  char* qbl = lds + R2Q + wid * QB_W + r32 * 208 + hi * 16;
  { bf16x8 qt[6];
#pragma unroll
    for (int d0 = 0; d0 < 6; ++d0) qt[d0] = ld8(Qw + 32 * DQK + d0 * 16);
#pragma unroll
    for (int d0 = 0; d0 < 6; ++d0) qa[d0] = ld8(Qw + d0 * 16);
#pragma unroll
    for (int d0 = 0; d0 < 6; ++d0) *(bf16x8*)(qbl + d0 * 32) = qt[d0]; }
  asm volatile("s_waitcnt vmcnt(0) lgkmcnt(0)" ::: "memory");
  const int vb0 = (int)(lds0 + R2V) + v_rd_base(lane);
  int ks = 0, vs = 0;
#define PK(L, H) (bf16x8){L[0], L[1], L[2], L[3], H[0], H[1], H[2], H[3]}
#define C_QK() do { pa0s = f32x16{}; pa1s = f32x16{}; pb0s = f32x16{}; pb1s = f32x16{}; const char* Ks = lds + R2K + ks * SHM_K; \
      _Pragma("unroll") for (int d0 = 0; d0 < 6; ++d0) { const int cb = (d0 * 16 + hi * 8) * 2; \
        const bf16x8 k0 = *reinterpret_cast<const bf16x8*>(Ks + KSWZ(r32, cb)), k1 = *reinterpret_cast<const bf16x8*>(Ks + KSWZ(32 + r32, cb)); \
        const bf16x8 qbf = *reinterpret_cast<const bf16x8*>(qbl + d0 * 32); \
        pa0s = __builtin_amdgcn_mfma_f32_32x32x16_bf16(k0, qa[d0], pa0s, 0, 0, 0); pb0s = __builtin_amdgcn_mfma_f32_32x32x16_bf16(k0, qbf, pb0s, 0, 0, 0); \
        pa1s = __builtin_amdgcn_mfma_f32_32x32x16_bf16(k1, qa[d0], pa1s, 0, 0, 0); pb1s = __builtin_amdgcn_mfma_f32_32x32x16_bf16(k1, qbf, pb1s, 0, 0, 0); } SBAR(); } while (0)
#define C_SM(first_) do { softmax_blk<NOMAX>(pa0s, pa1s, first_, mrefa, la, oa, a0, a1, a2, a3); softmax_blk<NOMAX>(pb0s, pb1s, first_, mrefb, lb, ob, b0, b1, b2, b3); SBAR(); } while (0)
#define C_PV(vslot) do { const int vb = vb0 + (vslot) * SHM_V; VFrag vf, vg; \
      v_read<0>(vf, vb); asm volatile("s_waitcnt lgkmcnt(0)" ::: "memory"); SBAR(); v_read<1>(vg, vb); SBAR(); \
      oa[0] = __builtin_amdgcn_mfma_f32_32x32x16_bf16(PK(vf.l[0], vf.h[0]), a0, oa[0], 0, 0, 0); ob[0] = __builtin_amdgcn_mfma_f32_32x32x16_bf16(PK(vf.l[0], vf.h[0]), b0, ob[0], 0, 0, 0); \
      oa[0] = __builtin_amdgcn_mfma_f32_32x32x16_bf16(PK(vf.l[1], vf.h[1]), a1, oa[0], 0, 0, 0); ob[0] = __builtin_amdgcn_mfma_f32_32x32x16_bf16(PK(vf.l[1], vf.h[1]), b1, ob[0], 0, 0, 0); \
      oa[0] = __builtin_amdgcn_mfma_f32_32x32x16_bf16(PK(vf.l[2], vf.h[2]), a2, oa[0], 0, 0, 0); ob[0] = __builtin_amdgcn_mfma_f32_32x32x16_bf16(PK(vf.l[2], vf.h[2]), b2, ob[0], 0, 0, 0); \
      oa[0] = __builtin_amdgcn_mfma_f32_32x32x16_bf16(PK(vf.l[3], vf.h[3]), a3, oa[0], 0, 0, 0); ob[0] = __builtin_amdgcn_mfma_f32_32x32x16_bf16(PK(vf.l[3], vf.h[3]), b3, ob[0], 0, 0, 0); \
      asm volatile("s_waitcnt lgkmcnt(0)" ::: "memory"); SBAR(); \
      oa[1] = __builtin_amdgcn_mfma_f32_32x32x16_bf16(PK(vg.l[0], vg.h[0]), a0, oa[1], 0, 0, 0); ob[1] = __builtin_amdgcn_mfma_f32_32x32x16_bf16(PK(vg.l[0], vg.h[0]), b0, ob[1], 0, 0, 0); \
      oa[1] = __builtin_amdgcn_mfma_f32_32x32x16_bf16(PK(vg.l[1], vg.h[1]), a1, oa[1], 0, 0, 0); ob[1] = __builtin_amdgcn_mfma_f32_32x32x16_bf16(PK(vg.l[1], vg.h[1]), b1, ob[1], 0, 0, 0); \
      oa[1] = __builtin_amdgcn_mfma_f32_32x32x16_bf16(PK(vg.l[2], vg.h[2]), a2, oa[1], 0, 0, 0); ob[1] = __builtin_amdgcn_mfma_f32_32x32x16_bf16(PK(vg.l[2], vg.h[2]), b2, ob[1], 0, 0, 0); \
      oa[1] = __builtin_amdgcn_mfma_f32_32x32x16_bf16(PK(vg.l[3], vg.h[3]), a3, oa[1], 0, 0, 0); ob[1] = __builtin_amdgcn_mfma_f32_32x32x16_bf16(PK(vg.l[3], vg.h[3]), b3, ob[1], 0, 0, 0); SBAR(); } while (0)
#define TOP(t) do { if ((t) + 1 < NT) { WAIT_BAR(3); } else { WAIT_BAR(0); } \
    if ((t) + 2 < NT) { int kn = ks + 2; kn = kn >= NSLOT ? kn - NSLOT : kn; int vn = vs + 2; vn = vn >= NSV ? vn - NSV : vn; DMA_K((t) + 2, kn); DMA_V((t) + 2, vn); } SBAR(); } while (0)
#define ROT() do { ks = (ks == NSLOT - 1) ? 0 : ks + 1; vs = (vs == NSV - 1) ? 0 : vs + 1; } while (0)
#define ATT_LOOP(late) do { \
    f32x16 pa0s, pa1s, pb0s, pb1s; bf16x8 a0 = {}, a1 = {}, a2 = {}, a3 = {}, b0 = {}, b1 = {}, b2 = {}, b3 = {}; \
    for (int t = 0; t < NT; ++t) { \
      TOP(t); \
      if (late && t > 0) C_PV(vs == 0 ? NSV - 1 : vs - 1); \
      C_QK(); C_SM(t == 0); \
      if (!late) C_PV(vs); \
      ROT(); \
    } \
    if (late) C_PV(vs == 0 ? NSV - 1 : vs - 1); } while (0)
  if constexpr (NOMAX) {
    f32x16 pa0s, pa1s, pb0s, pb1s; unsigned wa0[8], wb0[8], wa1[8], wb1[8];
#define HC(P, i, S, W) do { P[(i) & 15] = __builtin_amdgcn_exp2f(P[(i) & 15]); P[((i) + 1) & 15] = __builtin_amdgcn_exp2f(P[((i) + 1) & 15]); S += P[(i) & 15]; S += P[((i) + 1) & 15]; \
                            W = cvtpk_n(P[(i) & 15], P[((i) + 1) & 15]); } while (0)
#define HC0(h) do { if ((h) < 8) HC(pa0s, 2 * (h), la, wa0[(h) & 7]); else HC(pb0s, 2 * ((h) - 8), lb, wb0[(h) & 7]); } while (0)
#define MK8(W, o) __builtin_bit_cast(bf16x8, (u32x4){W[(o)], W[(o) + 1], W[(o) + 2], W[(o) + 3]})
#define LDSK(row, d) (*reinterpret_cast<const bf16x8*>(Ks + KSWZ((row), ((d) * 16 + hi * 8) * 2)))
#define LDSQ(d) (*reinterpret_cast<const bf16x8*>(qbl + (d) * 32))
#define MF(A, B, C) C = __builtin_amdgcn_mfma_f32_32x32x16_bf16(A, B, C, 0, 0, 0)
    VFrag vf, vg; bf16x8 kcarry, qcarry;
#define VRD(J, VB) do { vf.l[J] = tr_read<v_rd_off(0, J, 0)>(VB); vf.h[J] = tr_read<v_rd_off(0, J, 1)>(VB); vg.l[J] = tr_read<v_rd_off(1, J, 0)>(VB); vg.h[J] = tr_read<v_rd_off(1, J, 1)>(VB); } while (0)
#define HCB(k) HC(pb1s, 2 * (k), lb, wb1[(k) & 7])
#define STA(PREV) do { pa0s = f32x16{}; pb0s = f32x16{}; bf16x8 kc = LDSK(r32, 0), qc = LDSQ(0); \
      _Pragma("unroll") for (int d0 = 0; d0 < 6; ++d0) { bf16x8 kn, qn; if (d0 < 5) { kn = LDSK(r32, d0 + 1); qn = LDSQ(d0 + 1); } else { kn = LDSK(32 + r32, 0); qn = LDSQ(0); } \
        MF(kc, qa[d0], pa0s); if (PREV && d0 < 4) HCB(2 * d0); SBAR(); MF(kc, qc, pb0s); if (PREV && d0 < 4) HCB(2 * d0 + 1); SBAR(); kc = kn; qc = qn; } kcarry = kc; qcarry = qc; } while (0)
#define STB() do { const bf16x8 b2 = MK8(wb1, 0), b3 = MK8(wb1, 4); \
      MF(PK(vf.l[2], vf.h[2]), b2, ob[0]); HC0(0); SBAR(); MF(PK(vg.l[2], vg.h[2]), b2, ob[1]); HC0(1); SBAR(); \
      MF(PK(vf.l[3], vf.h[3]), b3, ob[0]); HC0(2); SBAR(); MF(PK(vg.l[3], vg.h[3]), b3, ob[1]); HC0(3); SBAR(); } while (0)
#define STC(VB) do { pa1s = f32x16{}; pb1s = f32x16{}; bf16x8 kc = kcarry, qc = qcarry; \
      _Pragma("unroll") for (int d0 = 0; d0 < 6; ++d0) { bf16x8 kn = kc, qn = qc; if (d0 < 5) { kn = LDSK(32 + r32, d0 + 1); qn = LDSQ(d0 + 1); } else { VRD(0, VB); VRD(1, VB); } \
        MF(kc, qa[d0], pa1s); HC0(4 + 2 * d0); SBAR(); MF(kc, qc, pb1s); HC0(5 + 2 * d0); SBAR(); kc = kn; qc = qn; } } while (0)
#define STD(VB) do { const bf16x8 a0 = MK8(wa0, 0), a1 = MK8(wa0, 4), b0 = MK8(wb0, 0), b1 = MK8(wb0, 4); \
      asm volatile("s_waitcnt lgkmcnt(0)" ::: "memory"); SBAR(); \
      MF(PK(vf.l[0], vf.h[0]), a0, oa[0]); HC(pa1s, 0, la, wa1[0]); SBAR(); \
      MF(PK(vf.l[0], vf.h[0]), b0, ob[0]); HC(pa1s, 2, la, wa1[1]); SBAR(); \
      MF(PK(vg.l[0], vg.h[0]), a0, oa[1]); HC(pa1s, 4, la, wa1[2]); SBAR(); \
      MF(PK(vg.l[0], vg.h[0]), b0, ob[1]); HC(pa1s, 6, la, wa1[3]); VRD(2, VB); VRD(3, VB); SBAR();        \
      MF(PK(vf.l[1], vf.h[1]), a1, oa[0]); HC(pa1s, 8, la, wa1[4]); SBAR(); \
      MF(PK(vf.l[1], vf.h[1]), b1, ob[0]); HC(pa1s, 10, la, wa1[5]); SBAR(); \
      MF(PK(vg.l[1], vg.h[1]), a1, oa[1]); HC(pa1s, 12, la, wa1[6]); SBAR(); \
      MF(PK(vg.l[1], vg.h[1]), b1, ob[1]); HC(pa1s, 14, la, wa1[7]); SBAR(); } while (0)
#define STE() do { const bf16x8 a2 = MK8(wa1, 0), a3 = MK8(wa1, 4); asm volatile("s_waitcnt lgkmcnt(0)" ::: "memory"); SBAR(); \
      MF(PK(vf.l[2], vf.h[2]), a2, oa[0]); MF(PK(vg.l[2], vg.h[2]), a2, oa[1]); MF(PK(vf.l[3], vf.h[3]), a3, oa[0]); MF(PK(vg.l[3], vg.h[3]), a3, oa[1]); SBAR(); } while (0)
    {
      TOP(0);
      const char* Ks = lds + R2K + ks * SHM_K; const int vb = vb0 + vs * SHM_V;
      STA(false); HC0(0); HC0(1); HC0(2); HC0(3); SBAR(); STC(vb); STD(vb); STE();
      ROT();
    }
    for (int t = 1; t < NT; ++t) {
      TOP(t);
      const char* Ks = lds + R2K + ks * SHM_K; const int vb = vb0 + vs * SHM_V;
      STA(true); STB(); STC(vb); STD(vb); STE();
      ROT();
    }
    {
#pragma unroll
      for (int k = 0; k < 8; ++k) HCB(k);
      const bf16x8 b2 = MK8(wb1, 0), b3 = MK8(wb1, 4);
      MF(PK(vf.l[2], vf.h[2]), b2, ob[0]); MF(PK(vg.l[2], vg.h[2]), b2, ob[1]); MF(PK(vf.l[3], vf.h[3]), b3, ob[0]); MF(PK(vg.l[3], vg.h[3]), b3, ob[1]); }
#undef VRD
#undef HCB
#undef STA
#undef STB
#undef STC
#undef STD
#undef STE
#undef HC
#undef HC0
#undef MK8
#undef LDSK
#undef LDSQ
#undef MF
  } else {
    if (wid < 4) { ATT_LOOP(false); } else { ATT_LOOP(true); }
  }
#undef ATT_LOOP
  WAIT_BAR(0);
#undef PK
#undef C_QK
#undef C_SM
#undef C_PV
#undef TOP
#undef ROT
  char* stg = lds + R2OST + wid * OST_W;
#pragma unroll
  for (int blk = 0; blk < 2; ++blk) {
    float l_reg = blk ? lb : la; f32x16* o = blk ? ob : oa;
    { auto rr = __builtin_amdgcn_permlane32_swap(__float_as_uint(l_reg), __float_as_uint(l_reg), false, false); l_reg = __uint_as_float(rr[0]) + __uint_as_float(rr[1]); }
    const float rl = __builtin_amdgcn_rcpf(l_reg);
    bf16_t* Ow = Ob + (long)(wid * 64 + blk * 32) * ldo;
#pragma unroll
    for (int d0 = 0; d0 < 2; ++d0)
#pragma unroll
      for (int g = 0; g < 4; ++g) { uint2 w; w.x = cvtpk(o[d0][4 * g] * rl, o[d0][4 * g + 1] * rl); w.y = cvtpk(o[d0][4 * g + 2] * rl, o[d0][4 * g + 3] * rl);
        *(uint2*)(stg + r32 * 144 + (32 * d0 + 8 * g + 4 * hi) * 2) = w; }
    asm volatile("s_waitcnt lgkmcnt(0)" ::: "memory");
#pragma unroll
    for (int i = 0; i < 4; ++i) { const int row = i * 8 + (lane >> 3), ch = lane & 7; const u32x4 v = *(const u32x4*)(stg + row * 144 + ch * 16); *(u32x4*)(Ow + (long)row * ldo + ch * 8) = v; }
    asm volatile("s_waitcnt lgkmcnt(0)" ::: "memory");
  }
  asm volatile("s_waitcnt vmcnt(0) lgkmcnt(0)\n\ts_barrier" ::: "memory");
#undef DMA_K
#undef DMA_V
#undef WAIT_BAR
}
#undef KSWZ
#undef SBAR
}

#define GAS __attribute__((address_space(1)))
#define LAS __attribute__((address_space(3)))
typedef unsigned short bf16;
typedef unsigned v4u __attribute__((ext_vector_type(4)));
typedef float f32x4 __attribute__((ext_vector_type(4)));
typedef short bf16x8 __attribute__((ext_vector_type(8)));
typedef GAS unsigned gu32;
typedef GAS unsigned long long gu64;
#define RLX_AGENT __ATOMIC_RELAXED, __HIP_MEMORY_SCOPE_AGENT
#define LDS_WAIT() asm volatile("s_waitcnt lgkmcnt(0)" ::: "memory")
#define VM_WAIT() asm volatile("s_waitcnt vmcnt(0)" ::: "memory")
__device__ __forceinline__ unsigned long long rt() { return __builtin_amdgcn_s_memrealtime(); }
__device__ __forceinline__ unsigned f2bf(float f) { unsigned u = __builtin_bit_cast(unsigned, f); return (u + 0x7fffu + ((u >> 16) & 1u)) >> 16; }
__device__ __forceinline__ unsigned pk2(float lo, float hi) { return f2bf(lo) | (f2bf(hi) << 16); }

#define XB_TMO      128
#define XB_XCNT(j)  (256  + 64 * (j))
#define XB_XSUB(j)  (1280 + 64 * (j))
#define XB_XGEN(j)  (2304 + 64 * (j))
#define XB_TOP      3328
#define XB_TOPGEN   3392
#define XB_LSUB(j)  (3456 + 64 * (j))
#define XB_LGEN(j)  (4480 + 64 * (j))
#define XCD_BAR_WORDS 5504
#define XB_SPIN_CAP (1u << 18)

__device__ __forceinline__ unsigned xb_ld(unsigned* p)              { return __hip_atomic_load(p, __ATOMIC_RELAXED, __HIP_MEMORY_SCOPE_AGENT); }
__device__ __forceinline__ unsigned xb_add(unsigned* p, unsigned v) { return __hip_atomic_fetch_add(p, v, __ATOMIC_RELAXED, __HIP_MEMORY_SCOPE_AGENT); }
__device__ __forceinline__ unsigned xb_xcc_id() { return (unsigned)__builtin_amdgcn_s_getreg((3 << 11) | 20) & 0xFu; }
#define XB_SPIN(cond, bar) do { unsigned _sp = 0; while (cond) { __builtin_amdgcn_s_sleep(1); \
    if ((++_sp & 255u) == 0u) { if (xb_ld(&(bar)[XB_TMO])) break; if (_sp > XB_SPIN_CAP) { atomicAdd(&(bar)[XB_TMO], 1u); break; } } } } while (0)

struct XcdBarrier {
    unsigned* bar; unsigned x;
    volatile LAS unsigned* st;
};

__device__ __forceinline__ XcdBarrier xcd_barrier_post(unsigned* bar, volatile LAS unsigned* st) {
    XcdBarrier b; b.bar = bar; b.x = xb_xcc_id(); b.st = st;
    if (threadIdx.x == 0) (void)xb_add(&bar[XB_XCNT(b.x)], 1u);
    return b;
}
__device__ __forceinline__ void xcd_barrier_complete(unsigned* bar, unsigned x, unsigned& nloc, unsigned& nx) {
    const unsigned G = gridDim.x * gridDim.y * gridDim.z;
    unsigned sum, cnt, mine, sp = 0u;
    for (;;) {
        sum = 0u; cnt = 0u; mine = 0u;
#pragma unroll
        for (unsigned j = 0; j < 16; ++j) { const unsigned c = xb_ld(&bar[XB_XCNT(j)]); sum += c; cnt += (c > 0u) ? 1u : 0u; mine = (j == x) ? c : mine; }
        if (sum == G) break;
        __builtin_amdgcn_s_sleep(1);
        if ((++sp & 255u) == 0u) { if (xb_ld(&bar[XB_TMO])) break; if (sp > XB_SPIN_CAP) { atomicAdd(&bar[XB_TMO], 1u); break; } }
    }
    nloc = mine > 0u ? mine : 1u; nx = cnt > 0u ? cnt : 1u;
}

__device__ __forceinline__ void xcd_barrier(const XcdBarrier& b) {
    asm volatile("s_waitcnt vmcnt(0)" ::: "memory");
    __syncthreads();
    if (threadIdx.x == 0) {
        unsigned* bar = b.bar;
        __builtin_amdgcn_s_waitcnt(0);
        unsigned nloc = b.st[0], nx = b.st[1];
        if (nloc == 0u) { xcd_barrier_complete(bar, b.x, nloc, nx); b.st[0] = nloc; b.st[1] = nx; }
        const unsigned old = xb_add(&bar[XB_XSUB(b.x)], 1u);
        const unsigned gen = old / nloc;
        if (old + 1u == (gen + 1u) * nloc) {
            __builtin_amdgcn_fence(__ATOMIC_RELEASE, "agent");
            asm volatile("s_waitcnt vmcnt(0)" ::: "memory");
            const unsigned og = xb_add(&bar[XB_TOP], 1u);
            const unsigned tg = og / nx;
            if (og + 1u == (tg + 1u) * nx) xb_add(&bar[XB_TOPGEN], 1u);
            else XB_SPIN(xb_ld(&bar[XB_TOPGEN]) == tg, bar);
            __builtin_amdgcn_fence(__ATOMIC_ACQUIRE, "agent");
            xb_add(&bar[XB_XGEN(b.x)], 1u);
            asm volatile("s_waitcnt vmcnt(0)" ::: "memory");
        } else {
            XB_SPIN(xb_ld(&bar[XB_XGEN(b.x)]) == gen, bar);
            __builtin_amdgcn_fence(__ATOMIC_ACQUIRE, "agent");
            asm volatile("s_waitcnt vmcnt(0)" ::: "memory");
        }
    }
    __syncthreads();
}

__device__ __forceinline__ void xcd_local_barrier(const XcdBarrier& b) {
    asm volatile("s_waitcnt vmcnt(0)" ::: "memory");
    __syncthreads();
    if (threadIdx.x == 0) {
        unsigned* bar = b.bar;
        __builtin_amdgcn_s_waitcnt(0);
        const unsigned nloc = b.st[0];
        const unsigned old = xb_add(&bar[XB_LSUB(b.x)], 1u);
        const unsigned gen = old / nloc;
        if (old + 1u == (gen + 1u) * nloc) xb_add(&bar[XB_LGEN(b.x)], 1u);
        else XB_SPIN(xb_ld(&bar[XB_LGEN(b.x)]) == gen, bar);
        __builtin_amdgcn_fence(__ATOMIC_ACQUIRE, "agent");
        asm volatile("s_waitcnt vmcnt(0)" ::: "memory");
    }
    __syncthreads();
}

constexpr int NWAVES = 8;
constexpr int BATCH = 16, SEQ = 2048, DM = 1024, M = BATCH * SEQ, DFF = 2816, NMOD = 9216, WIN = 1440, WINP = 1536, NH = 8;
constexpr float EPS = 1e-6f;
constexpr size_t MiB = 1u << 20;
constexpr size_t WS_CTL = 0, CTL_ZERO_BYTES = 64 * 1024;
constexpr size_t WS_MOD = 1 * MiB, WS_ROPE = 2 * MiB;
constexpr size_t WS_W1T = 6 * MiB, WS_WD1T = 17 * MiB, WS_W2T = 23 * MiB, WS_WD2T = 34 * MiB, WS_WINT = 40 * MiB, WS_WQT = 43 * MiB, WS_WKVT = 43 * MiB + 512 * 1024, WS_WOUTT = 44 * MiB;
constexpr size_t WS_A1 = 48 * MiB, WS_ACT = 112 * MiB, WS_V = 288 * MiB, WS_MIX = 320 * MiB, WS_HB = 384 * MiB, WS_END = 448 * MiB;
constexpr size_t WS_SLAB = 22 * MiB;
constexpr size_t WS_ZG = WS_ACT, WS_ZGD = WS_SLAB - 4 * MiB;
constexpr size_t WS_ZC = WS_ACT + 4 * MiB, WS_ZCD = WS_SLAB - (size_t)128 * 26 * 1024;
constexpr size_t WS_Q = WS_ACT + 8 * MiB, WS_QD = WS_SLAB - 6 * MiB;
constexpr size_t WS_K = WS_ACT + 14 * MiB, WS_KD = WS_SLAB - 6 * MiB;
static_assert((size_t)4096 * DFF * 2 == WS_SLAB && (size_t)4096 * 512 * 2 == 4 * MiB && (size_t)2 * 8 * 2048 * 96 * 2 == 6 * MiB && 4 * MiB + (size_t)128 * 26 * 1024 <= 8 * MiB, "class slabs");
static_assert(WS_W1T + (size_t)2 * DFF * DM * 2 <= WS_WD1T && WS_WD1T + (size_t)DM * DFF * 2 <= WS_W2T && WS_WD2T + (size_t)DM * DFF * 2 <= WS_WINT && WS_WINT + (size_t)WINP * DM * 2 <= WS_WQT, "weights map");
static_assert(WS_ACT + (size_t)M * DFF * 2 <= WS_V && WS_MIX + (size_t)M * DM * 2 <= WS_HB && WS_HB + (size_t)M * DM * 2 <= WS_END, "ws map");
constexpr size_t WS_SS1 = WS_CTL + 256 * 1024, WS_SS2 = WS_CTL + 512 * 1024, WS_SS3 = WS_CTL + 768 * 1024;
constexpr size_t WS_SS0 = WS_CTL + 128 * 1024;
constexpr size_t WS_BIAS1 = 46 * MiB + 512 * 1024;
constexpr size_t WS_BIASM = 46 * MiB, WS_BIAS2 = 46 * MiB + 128 * 1024;
constexpr int CW_TMO = 0, CW_BAR = 4096;
constexpr unsigned READY_MAGIC = 0x600DF00Du;
constexpr int LDS_BYTES = 147456, MISC_OFF = LDS_BYTES - 256;
constexpr int NPHASE = 13;
#ifndef MK_N_LAUNCHES
#define MK_N_LAUNCHES 1
#endif

__device__ __forceinline__ unsigned cvtpk(float lo, float hi) { unsigned r; asm volatile("v_cvt_pk_bf16_f32 %0, %1, %2" : "=v"(r) : "v"(lo), "v"(hi)); return r; }
__device__ __forceinline__ float bf_lo(unsigned w) { return __uint_as_float(w << 16); }
__device__ __forceinline__ float bf_hi(unsigned w) { return __uint_as_float(w & 0xffff0000u); }
__device__ __forceinline__ float sigm(float x) { return __builtin_amdgcn_rcpf(1.0f + __builtin_amdgcn_exp2f(-1.4426950408889634f * x)); }
__device__ __forceinline__ float wave_sum(float v) {
#pragma unroll
    for (int o = 1; o < 64; o <<= 1) v += __shfl_xor(v, o);
    return v;
}
__device__ __forceinline__ float swap_add(float v) { auto rr = __builtin_amdgcn_permlane32_swap(__float_as_uint(v), __float_as_uint(v), false, false); return __uint_as_float(rr[0]) + __uint_as_float(rr[1]); }

struct Args { const void* in[24]; float* out; unsigned char* ws; double invf[16]; int ph_lo, ph_hi, li, pad; };

struct Frame {
    char* lds;
    volatile LAS unsigned* MISC;
    int tid, lane, wave, vcu, G;
};

__device__ __forceinline__ void ph_final(Frame& F, const bf16* H, const float* ss, const float* g, float* out) {
    const int gw = F.vcu * NWAVES + F.wave, NGW = F.G * NWAVES, lane = F.lane;
    f32x4 g0[2], g1[2];
#pragma unroll
    for (int j = 0; j < 2; ++j) { g0[j] = *(const f32x4*)(g + 8 * lane + 512 * j); g1[j] = *(const f32x4*)(g + 8 * lane + 512 * j + 4); }
    for (int rb = gw; rb < M / 16; rb += NGW) {
        const int row0 = rb * 16;
        const float sv = ss[row0 + (lane & 15)];
#pragma unroll 4
        for (int r = 0; r < 16; ++r) {
            const float rs = __builtin_amdgcn_rsqf(__shfl(sv, r) * (1.0f / DM) + EPS);
            const v4u* hr = (const v4u*)(H + (size_t)(row0 + r) * DM) + lane; f32x4* o4 = (f32x4*)(out + (size_t)(row0 + r) * DM) + 2 * lane;
#pragma unroll
            for (int j = 0; j < 2; ++j) { const v4u w = __builtin_nontemporal_load(hr + 64 * j);
                const f32x4 a = {bf_lo(w.x), bf_hi(w.x), bf_lo(w.y), bf_hi(w.y)}, b = {bf_lo(w.z), bf_hi(w.z), bf_lo(w.w), bf_hi(w.w)};
                __builtin_nontemporal_store(a * rs * g0[j], o4 + 128 * j); __builtin_nontemporal_store(b * rs * g1[j], o4 + 128 * j + 1); }
        }
    }
}
__device__ __forceinline__ int drow_of(int kind, int n0) {
    if (kind == 0) return n0;
    if (kind == 1) return 256 * (n0 >> 7) + (n0 & 127);
    if (kind == 2) return 256 * (n0 >> 7) + 128 + (n0 & 127);
    if (n0 < 512) return 256 * (n0 >> 7) + (n0 & 127);
    if (n0 < 1024) return 256 * ((n0 - 512) >> 7) + 128 + (n0 & 127);
    return n0;
}
template <int NC> __device__ __forceinline__ void gemv16_unit(int tid, const float* vec, float* red, const float* W, int ldw, int c0, float* out, int ostride, int kind, const float* addv) {
    constexpr int KG = 512 / NC;
    const int kg = tid / NC, col = tid % NC;
    if (kg < KG) {
        f32x4 a0 = {0.f, 0.f, 0.f, 0.f}, a1 = a0, a2 = a0, a3 = a0;
        const float* wp = W + c0 + col;
        int k = kg;
        for (; k + 15 * KG < 1024; k += 16 * KG) {
            float w[16];
#pragma unroll
            for (int i = 0; i < 16; ++i) w[i] = wp[(size_t)(k + i * KG) * ldw];
#pragma unroll
            for (int i = 0; i < 16; ++i) { const f32x4* sv = (const f32x4*)(vec + (k + i * KG) * 16); a0 += sv[0] * w[i]; a1 += sv[1] * w[i]; a2 += sv[2] * w[i]; a3 += sv[3] * w[i]; }
        }
#pragma unroll 4
        for (; k < 1024; k += KG) {
            const float w = wp[(size_t)k * ldw];
            const f32x4* sv = (const f32x4*)(vec + k * 16);
            a0 += sv[0] * w; a1 += sv[1] * w; a2 += sv[2] * w; a3 += sv[3] * w;
        }
        f32x4* rp = (f32x4*)(red + (kg * NC + col) * 16);
        rp[0] = a0; rp[1] = a1; rp[2] = a2; rp[3] = a3;
    }
    __syncthreads();
    for (int idx = tid; idx < NC * 16; idx += 512) { const int cl = idx >> 4, b = idx & 15; float sum = 0.f;
#pragma unroll 8
        for (int g = 0; g < KG; ++g) sum += red[(g * NC + cl) * 16 + b];
        out[(size_t)b * ostride + drow_of(kind, c0 + cl)] = sum + (addv ? addv[c0 + cl] : 0.f); }
    __syncthreads();
}
__device__ __forceinline__ void ph_mod(Frame& F, const float* c, const float* w_ada, const float* b_ada, float* mod) {
    constexpr int SHP = 1032;
    bf16* sch = (bf16*)F.lds; bf16* scl = sch + 16 * SHP;
    float* red = (float*)(F.lds + 69632);
    for (int idx = F.tid; idx < 16384; idx += 512) { const int b = idx >> 10, k = idx & 1023; const float v = c[idx]; const float a = v * sigm(v);
        const unsigned h = f2bf(a); sch[b * SHP + k] = (bf16)h; scl[b * SHP + k] = (bf16)f2bf(a - __uint_as_float(h << 16)); }
    __syncthreads();
    const int j = F.lane & 15, kq = F.lane >> 4, w = F.wave, jc = j < 9 ? j : 8;
    for (int u = F.vcu; u < 256; u += F.G) {
        const int n0 = 36 * u;
        const float* wp = w_ada + (size_t)(128 * w + 8 * kq) * NMOD + n0 + 4 * jc;
        f32x4 wv[4][8];
#pragma unroll
        for (int ks = 0; ks < 4; ++ks)
#pragma unroll
            for (int i = 0; i < 8; ++i) wv[ks][i] = __builtin_nontemporal_load((const f32x4*)(wp + (size_t)(32 * ks + i) * NMOD));
        f32x4 acc[4];
#pragma unroll
        for (int cc = 0; cc < 4; ++cc) acc[cc] = (f32x4){0.f, 0.f, 0.f, 0.f};
#pragma unroll
        for (int ks = 0; ks < 4; ++ks) {
            const bf16x8 ah = *(const bf16x8*)(sch + j * SHP + 128 * w + 32 * ks + 8 * kq), al = *(const bf16x8*)(scl + j * SHP + 128 * w + 32 * ks + 8 * kq);
#pragma unroll
            for (int cc = 0; cc < 4; ++cc) {
                v4u bh, bl;
#pragma unroll
                for (int p = 0; p < 4; ++p) { const float x0 = wv[ks][2 * p][cc], x1 = wv[ks][2 * p + 1][cc]; const unsigned h = cvtpk(x0, x1);
                    bh[p] = h; bl[p] = cvtpk(x0 - __uint_as_float(h << 16), x1 - __uint_as_float(h & 0xffff0000u)); }
                const bf16x8 bhv = __builtin_bit_cast(bf16x8, bh), blv = __builtin_bit_cast(bf16x8, bl);
                acc[cc] = __builtin_amdgcn_mfma_f32_16x16x32_bf16(al, bhv, acc[cc], 0, 0, 0);
                acc[cc] = __builtin_amdgcn_mfma_f32_16x16x32_bf16(ah, blv, acc[cc], 0, 0, 0);
                acc[cc] = __builtin_amdgcn_mfma_f32_16x16x32_bf16(ah, bhv, acc[cc], 0, 0, 0); }
        }
#pragma unroll
        for (int cc = 0; cc < 4; ++cc) *(f32x4*)(red + ((w * 4 + cc) * 64 + F.lane) * 4) = acc[cc];
        __syncthreads();
        for (int idx = F.tid; idx < 576; idx += 512) { const int b = idx / 36, col = idx % 36, jj = col >> 2, cc = col & 3;
            float sum = b_ada[n0 + col];
#pragma unroll
            for (int w8 = 0; w8 < 8; ++w8) sum += red[((w8 * 4 + cc) * 64 + 16 * (b >> 2) + jj) * 4 + (b & 3)];
            mod[(size_t)b * NMOD + n0 + col] = sum; }
        __syncthreads();
    }
}

template <int MODE> __device__ __forceinline__ void ph_rownorm(Frame& F, const float* src, const float* sc, const float* sh, bf16* dstb, float* dstf) {
    const int gw = F.vcu * NWAVES + F.wave, NGW = F.G * NWAVES, lane = F.lane;
    for (int rb = gw; rb < M / 16; rb += NGW) {
        const int row0 = rb * 16, b = row0 >> 11;
        f32x4 s[4], t[4];
#pragma unroll
        for (int j = 0; j < 4; ++j) {
            if (MODE == 0) { s[j] = *(const f32x4*)(sc + (size_t)b * NMOD + 4 * lane + 256 * j) + 1.0f; t[j] = *(const f32x4*)(sh + (size_t)b * NMOD + 4 * lane + 256 * j); }
            else if (MODE == 2) { s[j] = pg8::ada_scale(*(const f32x4*)(sc + (size_t)b * NMOD + 4 * lane + 256 * j)); t[j] = (f32x4){0.f, 0.f, 0.f, 0.f}; }
            else { s[j] = *(const f32x4*)(sc + 4 * lane + 256 * j); t[j] = (f32x4){0.f, 0.f, 0.f, 0.f}; }
        }
#pragma unroll 2
        for (int r = 0; r < 16; ++r) {
            const f32x4* xr = (const f32x4*)(src + (size_t)(row0 + r) * DM) + lane;
            f32x4 v[4]; float ss = 0.f;
#pragma unroll
            for (int j = 0; j < 4; ++j) { v[j] = __builtin_nontemporal_load(xr + 64 * j); ss += (v[j].x * v[j].x + v[j].y * v[j].y) + (v[j].z * v[j].z + v[j].w * v[j].w); }
            if (MODE == 2) {
                unsigned long long* o8 = (unsigned long long*)(dstb + (size_t)(row0 + r) * DM) + lane;
#pragma unroll
                for (int j = 0; j < 4; ++j) { const f32x4 o = v[j] * s[j]; o8[64 * j] = (unsigned long long)cvtpk(o.x, o.y) | ((unsigned long long)cvtpk(o.z, o.w) << 32); }
                const float tot = wave_sum(ss); if (lane == 0) dstf[row0 + r] = tot;
                continue; }
            const float rs = __builtin_amdgcn_rsqf(wave_sum(ss) * (1.0f / DM) + EPS);
            if (MODE == 0) {
                unsigned long long* o8 = (unsigned long long*)(dstb + (size_t)(row0 + r) * DM) + lane;
#pragma unroll
                for (int j = 0; j < 4; ++j) { const f32x4 o = v[j] * rs * s[j] + t[j]; o8[64 * j] = (unsigned long long)cvtpk(o.x, o.y) | ((unsigned long long)cvtpk(o.z, o.w) << 32); }
            } else {
                f32x4* o4 = (f32x4*)(dstf + (size_t)(row0 + r) * DM) + lane;
#pragma unroll
                for (int j = 0; j < 4; ++j) o4[64 * j] = v[j] * rs * s[j];
            }
        }
    }
}

__device__ __forceinline__ void transpose_item(const float* W, int K, int N, bf16* WT, int k0, int n0, int drow0, const float* kscale, float* scr, int lane) {
#pragma unroll 8
    for (int i = 0; i < 32; ++i) { const int kk = 2 * i + (lane >> 5); float v = __builtin_nontemporal_load(W + (size_t)(k0 + kk) * N + n0 + (lane & 31)); if (kscale) v *= kscale[k0 + kk]; scr[kk * 33 + (lane & 31)] = v; }
    LDS_WAIT(); asm volatile("" ::: "memory");
    const int c = lane & 7;
#pragma unroll
    for (int j = 0; j < 4; ++j) { const int n = (lane >> 3) + 8 * j; const float* s = scr + (8 * c) * 33 + n;
        v4u o; o.x = cvtpk(s[0 * 33], s[1 * 33]); o.y = cvtpk(s[2 * 33], s[3 * 33]); o.z = cvtpk(s[4 * 33], s[5 * 33]); o.w = cvtpk(s[6 * 33], s[7 * 33]);
        { bf16* wp_ = WT + (size_t)(drow0 + n) * K + k0 + 8 * c; asm volatile("global_store_dwordx4 %0, %1, off sc1\n\ts_nop 1" :: "v"(wp_), "v"(o) : "memory"); } }
    LDS_WAIT(); asm volatile("" ::: "memory");
}
__device__ __forceinline__ void ph_weights(Frame& F, const __attribute__((address_space(4))) Args* ap) {
    const __attribute__((address_space(4))) Args& a = *ap;
    const float* in[24];
#pragma unroll
    for (int i = 0; i < 24; ++i) in[i] = (const float*)a.in[i];
    unsigned char* ws = a.ws;
    const int gw = F.vcu * NWAVES + F.wave, NGW = F.G * NWAVES;
    float* scr = (float*)(F.lds + F.wave * 16384);
    constexpr int I_GU = (DM / 64) * (DFF / 32), I_D = (DFF / 64) * (DM / 32), I_IN = (DM / 64) * (WIN / 32), I_Q = (256 / 64) * (768 / 32), I_KV = (128 / 64) * (1024 / 32), I_O = (DM / 64) * (DM / 32);
    constexpr int NITEMS = 4 * I_GU + 2 * I_D + I_IN + I_Q + I_KV + I_O;
    for (int it = gw; it < NITEMS; it += NGW) {
        int r = it; const float* W; int K, N, kind; bf16* WT; const float* ks = nullptr;
        if (r < I_GU) { W = in[5]; K = DM; N = DFF; kind = 1; WT = (bf16*)(ws + WS_W1T); }
        else if ((r -= I_GU) < I_GU) { W = in[6]; K = DM; N = DFF; kind = 2; WT = (bf16*)(ws + WS_W1T); }
        else if ((r -= I_GU) < I_D) { W = in[7]; K = DFF; N = DM; kind = 0; WT = (bf16*)(ws + WS_WD1T); }
        else if ((r -= I_D) < I_GU) { W = in[20]; K = DM; N = DFF; kind = 1; WT = (bf16*)(ws + WS_W2T); }
        else if ((r -= I_GU) < I_GU) { W = in[21]; K = DM; N = DFF; kind = 2; WT = (bf16*)(ws + WS_W2T); }
        else if ((r -= I_GU) < I_D) { W = in[22]; K = DFF; N = DM; kind = 0; WT = (bf16*)(ws + WS_WD2T); }
        else if ((r -= I_D) < I_IN) { W = in[8]; K = DM; N = WIN; kind = 3; WT = (bf16*)(ws + WS_WINT); }
        else if ((r -= I_IN) < I_Q) { W = in[11]; K = 256; N = 768; kind = 0; WT = (bf16*)(ws + WS_WQT); ks = in[9]; }
        else if ((r -= I_Q) < I_KV) { W = in[12]; K = 128; N = 1024; kind = 0; WT = (bf16*)(ws + WS_WKVT); ks = in[10]; }
        else { r -= I_KV; W = in[19]; K = DM; N = DM; kind = 0; WT = (bf16*)(ws + WS_WOUTT); }
        const int nblk = N / 32, kb = r / nblk, nb = r % nblk;
        transpose_item(W, K, N, WT, 64 * kb, 32 * nb, drow_of(kind, 32 * nb), ks, scr, F.lane);
    }
    { const int gt = F.vcu * 512 + F.tid, NT = F.G * 512; v4u z = {0u, 0u, 0u, 0u};
      for (int i = gt; i < 3 * (M / 4); i += NT) { const int a = i / (M / 4), j = i % (M / 4); *((v4u*)(ws + WS_SS1 + (size_t)a * 256 * 1024) + j) = z; } }
    { const int gt = F.vcu * 512 + F.tid, NT = F.G * 512; v4u z = {0u, 0u, 0u, 0u};
      for (int i = gt; i < 96 * 128; i += NT) *((v4u*)(ws + WS_WINT + (size_t)1440 * DM * 2) + i) = z; }
    { const int gt = F.vcu * 512 + F.tid, NT = F.G * 512; const int* pos = (const int*)a.in[2]; float* tab = (float*)(ws + WS_ROPE);
      for (int idx = gt; idx < M * 16; idx += NT) { const int m = idx >> 4, i = idx & 15; double f = 0.0;
#pragma unroll
          for (int k = 0; k < 16; ++k) f = (i == k) ? a.invf[k] : f;
          double rv = (double)pos[m] * f * 0.15915494309189535; rv -= __builtin_rint(rv); const float fr = (float)rv;
          tab[m * 32 + i] = __builtin_amdgcn_cosf(fr); tab[m * 32 + 16 + i] = __builtin_amdgcn_sinf(fr); } }
}
__device__ __forceinline__ void ph_prep(Frame& F, const __attribute__((address_space(4))) Args* ap) {
    const __attribute__((address_space(4))) Args& a = *ap;
    const float* in[24];
#pragma unroll
    for (int i = 0; i < 24; ++i) in[i] = (const float*)a.in[i];
    unsigned char* ws = a.ws;
    const int gw = F.vcu * NWAVES + F.wave, NGW = F.G * NWAVES;
    float* scr = (float*)(F.lds + F.wave * 16384);
    const float* mod = (const float*)(ws + WS_MOD);
    { constexpr int SHP = 1032;
      bf16* shl = (bf16*)F.lds;
      for (int idx = F.tid; idx < 3 * 16384; idx += 512) { const int ty = idx >> 14, b = (idx >> 10) & 15, k = idx & 1023; const int chunk = ty == 0 ? 0 : (ty == 1 ? 6 : 3);
          shl[(ty * 16 + b) * SHP + k] = (bf16)f2bf(mod[(size_t)b * NMOD + chunk * DM + k]); }
      __syncthreads();
      const int bl = F.lane & 15, kq = F.lane >> 4;
      for (int t = F.wave * F.G + F.vcu; t < 800; t += NGW) {
          int ty, r0, bs; const bf16* WT; float* bias;
          if (t < 352) { ty = 0; r0 = 16 * t; WT = (const bf16*)(ws + WS_W1T); bias = (float*)(ws + WS_BIAS1); bs = 2 * DFF; }
          else if (t < 704) { ty = 1; r0 = 16 * (t - 352); WT = (const bf16*)(ws + WS_W2T); bias = (float*)(ws + WS_BIAS2); bs = 2 * DFF; }
          else { ty = 2; r0 = 16 * (t - 704); WT = (const bf16*)(ws + WS_WINT); bias = (float*)(ws + WS_BIASM); bs = WINP; }
          const bf16* wrow = WT + (size_t)(r0 + bl) * DM + 8 * kq;
          const bf16* arow = shl + (ty * 16 + bl) * SHP + 8 * kq;
          f32x4 acc = {0.f, 0.f, 0.f, 0.f};
          bf16x8 bw[32];
#pragma unroll
          for (int ks = 0; ks < 32; ++ks) bw[ks] = *(const bf16x8*)(wrow + 32 * ks);
#pragma unroll
          for (int ks = 0; ks < 32; ++ks) {
              const bf16x8 av = *(const bf16x8*)(arow + 32 * ks);
              acc = __builtin_amdgcn_mfma_f32_16x16x32_bf16(av, bw[ks], acc, 0, 0, 0); }
#pragma unroll
          for (int e = 0; e < 4; ++e) bias[(size_t)(4 * kq + e) * bs + r0 + bl] = acc[e];
      }
      __syncthreads(); }
    ph_rownorm<2>(F, in[0], mod + 1 * DM, nullptr, (bf16*)(ws + WS_A1), (float*)(ws + WS_SS0));
}

typedef float cf32x2 __attribute__((ext_vector_type(2)));
template <int S> __device__ __forceinline__ void conv_row(cf32x2 (&a)[16], const cf32x2 (&w)[31], const char* base) {
    const unsigned v = *(const unsigned*)(base + S * 1024); const cf32x2 x = {bf_lo(v), bf_hi(v)};
#pragma unroll
    for (int t = 0; t < 16; ++t) { const int j = S - t; if (j >= 0 && j < 31) a[t] = __builtin_elementwise_fma(w[j], x, a[t]); }
}
template <int S0, int S1> __device__ __forceinline__ void conv_rows(cf32x2 (&a)[16], const cf32x2 (&w)[31], const char* base) {
    if constexpr (S0 < S1) { conv_row<S0>(a, w, base); conv_rows<S0 + 1, S1>(a, w, base); }
}
__device__ __forceinline__ void ph_conv(Frame& F, const bf16* ZG, const float* cw, const float* cb, const float* lg, const float* lb, bf16* MIX) {
    char* lds = F.lds; const int tid = F.tid, lane = F.lane, wave = F.wave;
    const int cp = tid & 255, th = tid >> 8;
    constexpr int NU = M / 32;
    const int per = (NU + F.G - 1) / F.G, u0 = F.vcu * per, u1 = (u0 + per < NU) ? u0 + per : NU;
    if (u0 >= u1) return;
    cf32x2 wv[31];
#pragma unroll
    for (int j = 0; j < 31; ++j) { const float2 w = *(const float2*)(cw + j * 512 + 2 * cp); wv[j] = (cf32x2){w.x, w.y}; }
    const float2 bias = *(const float2*)(cb + 2 * cp);
    const f32x4 g0 = *(const f32x4*)(lg + 8 * lane), g1 = *(const f32x4*)(lg + 8 * lane + 4), b0 = *(const f32x4*)(lb + 8 * lane), b1 = *(const f32x4*)(lb + 8 * lane + 4);
    v4u tv[8];
#define CONV_LOAD(uu) do { const int m0_ = (uu) * 32, t0_ = m0_ & (SEQ - 1); const bf16* ZGc = ZG + (size_t)(m0_ >> 12) * (WS_ZGD / 2); _Pragma("unroll") for (int i = 0; i < 8; ++i) { const int id = tid + 512 * i; const int row = id >> 6, c = id & 63, t = t0_ - 15 + row; \
        const int tc = t < 0 ? 0 : (t > SEQ - 1 ? SEQ - 1 : t); tv[i] = *(const v4u*)(ZGc + (size_t)(m0_ - t0_ + tc) * 512 + c * 8); } } while (0)
#define CONV_WRITE(uu) do { const int t0_ = ((uu) * 32) & (SEQ - 1); _Pragma("unroll") for (int i = 0; i < 8; ++i) { const int id = tid + 512 * i; const int row = id >> 6, c = id & 63, t = t0_ - 15 + row; const bool ok = (t >= 0 && t < SEQ); \
        v4u v = tv[i]; v.x = ok ? v.x : 0u; v.y = ok ? v.y : 0u; v.z = ok ? v.z : 0u; v.w = ok ? v.w : 0u; if (row < 62) *(v4u*)(lds + row * 1024 + c * 16) = v; } } while (0)
    CONV_LOAD(u0); CONV_WRITE(u0);
    __syncthreads();
    for (int u = u0; u < u1; ++u) {
        const int m0 = u * 32;
        if (u + 1 < u1) CONV_LOAD(u + 1);
        cf32x2 av[16];
#pragma unroll
        for (int t = 0; t < 16; ++t) av[t] = (cf32x2){bias.x, bias.y};
        conv_rows<0, 46>(av, wv, lds + th * 16 * 1024 + cp * 4);
#pragma unroll
        for (int t = 0; t < 16; ++t) *(cf32x2*)(lds + 65536 + (th * 16 + t) * 2048 + cp * 8) = av[t];
        __syncthreads();
        if (u + 1 < u1) CONV_WRITE(u + 1);
#pragma unroll
        for (int i = 0; i < 4; ++i) { const int t = wave * 4 + i;
            const f32x4 x0 = *(const f32x4*)(lds + 65536 + t * 2048 + lane * 32), x1 = *(const f32x4*)(lds + 65536 + t * 2048 + lane * 32 + 16);
            const float mu = wave_sum((x0.x + x0.y) + (x0.z + x0.w) + (x1.x + x1.y) + (x1.z + x1.w)) * (1.0f / 512.0f);
            const f32x4 d0 = x0 - mu, d1 = x1 - mu;
            const float var = wave_sum((d0.x * d0.x + d0.y * d0.y) + (d0.z * d0.z + d0.w * d0.w) + (d1.x * d1.x + d1.y * d1.y) + (d1.z * d1.z + d1.w * d1.w)) * (1.0f / 512.0f);
            const float rs = __builtin_amdgcn_rsqf(var + 1e-5f);
            f32x4 y0 = d0 * rs * g0 + b0, y1 = d1 * rs * g1 + b1;
            y0.x *= sigm(y0.x); y0.y *= sigm(y0.y); y0.z *= sigm(y0.z); y0.w *= sigm(y0.w); y1.x *= sigm(y1.x); y1.y *= sigm(y1.y); y1.z *= sigm(y1.z); y1.w *= sigm(y1.w);
            v4u o; o.x = cvtpk(y0.x, y0.y); o.y = cvtpk(y0.z, y0.w); o.z = cvtpk(y1.x, y1.y); o.w = cvtpk(y1.z, y1.w);
            *(v4u*)(MIX + (size_t)(m0 + t) * DM + 8 * lane) = o; }
        __syncthreads();
    }
#undef CONV_LOAD
#undef CONV_WRITE
}

namespace lat {
using f32x16 = __attribute__((ext_vector_type(16))) float;
constexpr int WQ_ROW = 528, WKV_ROW = 272;
constexpr int WQ_OFF = 0, WKV_OFF = 96 * WQ_ROW, SCR_OFF = WKV_OFF + 128 * WKV_ROW, SCR_W = 6656, G_OFF = SCR_OFF + 8 * SCR_W;
__device__ __forceinline__ int crow(int r, int hi) { return (r & 3) + 8 * (r >> 2) + 4 * hi; }
}
__device__ __forceinline__ void ph_latent(Frame& F, const bf16* ZC, const bf16* Wqt, const bf16* Wkvt, const float* gqh, const float* gkh, const float* tab, bf16* Qo, bf16* Ko, bf16* Vo) {
    using namespace lat;
    char* lds = F.lds; const int tid = F.tid, lane = F.lane, wave = F.wave, r32 = lane & 31, hi = lane >> 5;
    float* gl = (float*)(lds + G_OFF);
    if (tid < 96) gl[tid] = gqh[tid]; else if (tid < 192) gl[tid] = gkh[tid - 96];
    char* scr = lds + SCR_OFF + wave * SCR_W;
    const char* const wqb = lds + WQ_OFF + r32 * WQ_ROW + hi * 16; const char* const wkvb = lds + WKV_OFF + r32 * WKV_ROW + hi * 16;
    for (int u = F.vcu; u < 256; u += F.G) {
        const int h = u & 7, rng = u >> 3;
        const bf16* const ZCc = ZC + (size_t)(rng >> 2) * (WS_ZCD / 2); bf16* const Qc = Qo + (size_t)(rng >> 2) * (WS_QD / 2); bf16* const Kc = Ko + (size_t)(rng >> 2) * (WS_KD / 2);
        __syncthreads();
#pragma unroll
        for (int i = 0; i < 6; ++i) { const int id = tid + 512 * i, row = id >> 5, c = id & 31; const v4u v = *((const v4u*)(Wqt + (size_t)h * 96 * 256) + id);
            *(v4u*)(lds + WQ_OFF + row * WQ_ROW + c * 16) = v; }
#pragma unroll
        for (int i = 0; i < 4; ++i) { const int id = tid + 512 * i, row = id >> 4, c = id & 15; const v4u v = *((const v4u*)(Wkvt + (size_t)h * 128 * 128) + id);
            *(v4u*)(lds + WKV_OFF + row * WKV_ROW + c * 16) = v; }
        __syncthreads();
        bf16x8 ql[16];
        { const char* zt0 = (const char*)ZCc + (size_t)((rng * 1024 + wave * 32) >> 5) * 26 * 1024 + hi * 512 + r32 * 16;
#pragma unroll
          for (int ks = 0; ks < 8; ++ks) ql[ks] = *(const bf16x8*)(zt0 + ks * 1024); }
        for (int it = 0; it < 4; ++it) {
            const int mw = rng * 1024 + it * 256 + wave * 32;
            const int m = mw + r32, b = mw >> 11, s0 = mw & (SEQ - 1);
            const char* zt = (const char*)ZCc + (size_t)(mw >> 5) * 26 * 1024 + hi * 512 + r32 * 16;
#pragma unroll
            for (int ks = 8; ks < 16; ++ks) ql[ks] = *(const bf16x8*)(zt + ks * 1024);
            float cs[8], sn[8];
#pragma unroll
            for (int g = 0; g < 2; ++g) { const f32x4 c4 = *(const f32x4*)(tab + (size_t)m * 32 + 8 * g + 4 * hi), s4 = *(const f32x4*)(tab + (size_t)m * 32 + 16 + 8 * g + 4 * hi);
#pragma unroll
                for (int e = 0; e < 4; ++e) { cs[4 * g + e] = c4[e]; sn[4 * g + e] = s4[e]; } }
            {
                float sq = 0.f;
                f32x16 q0 = {}, q1 = {}, q2 = {};
#pragma unroll
                for (int ks = 0; ks < 16; ++ks) { const char* wp = wqb + ks * 32;
                    const bf16x8 a0 = *(const bf16x8*)(wp), a1 = *(const bf16x8*)(wp + 32 * WQ_ROW), a2 = *(const bf16x8*)(wp + 64 * WQ_ROW);
                    q0 = __builtin_amdgcn_mfma_f32_32x32x16_bf16(a0, ql[ks], q0, 0, 0, 0);
                    q1 = __builtin_amdgcn_mfma_f32_32x32x16_bf16(a1, ql[ks], q1, 0, 0, 0);
                    q2 = __builtin_amdgcn_mfma_f32_32x32x16_bf16(a2, ql[ks], q2, 0, 0, 0);
#pragma unroll
                    for (int e = 0; e < 8; ++e) { const float v = __uint_as_float(((unsigned)(unsigned short)ql[ks][e]) << 16); sq = fmaf(v, v, sq); }
                    __builtin_amdgcn_sched_barrier(0); }
                const float rq = __builtin_amdgcn_rsqf(swap_add(sq) * (1.0f / 256.0f) + EPS);
                float ss = 0.f;
#pragma unroll
                for (int r = 0; r < 16; ++r) ss += q0[r] * q0[r] + q1[r] * q1[r] + q2[r] * q2[r];
                ss = swap_add(ss);
                const float f = att::QSCALE * rq * __builtin_amdgcn_rsqf(rq * rq * ss * (1.0f / 96.0f) + EPS);
#pragma unroll
                for (int g = 0; g < 4; ++g) { const f32x4 ga = *(const f32x4*)(gl + 8 * g + 4 * hi), gb = *(const f32x4*)(gl + 32 + 8 * g + 4 * hi), gc = *(const f32x4*)(gl + 64 + 8 * g + 4 * hi);
#pragma unroll
                    for (int e = 0; e < 4; ++e) { q0[4 * g + e] *= f * ga[e]; q1[4 * g + e] *= f * gb[e]; q2[4 * g + e] *= f * gc[e]; } }
#pragma unroll
                for (int r = 0; r < 8; ++r) { const float x1 = q2[r], x2 = q2[r + 8]; q2[r] = x1 * cs[r] - x2 * sn[r]; q2[r + 8] = x2 * cs[r] + x1 * sn[r]; }
#pragma unroll
                for (int g = 0; g < 4; ++g) {
                    *(uint2*)(scr + r32 * 208 + (8 * g + 4 * hi) * 2) = make_uint2(cvtpk(q0[4 * g], q0[4 * g + 1]), cvtpk(q0[4 * g + 2], q0[4 * g + 3]));
                    *(uint2*)(scr + r32 * 208 + (32 + 8 * g + 4 * hi) * 2) = make_uint2(cvtpk(q1[4 * g], q1[4 * g + 1]), cvtpk(q1[4 * g + 2], q1[4 * g + 3]));
                    *(uint2*)(scr + r32 * 208 + (64 + 8 * g + 4 * hi) * 2) = make_uint2(cvtpk(q2[4 * g], q2[4 * g + 1]), cvtpk(q2[4 * g + 2], q2[4 * g + 3])); }
                LDS_WAIT();
                bf16* dst = Qc + ((size_t)(b * NH + h) * SEQ + s0) * 96;
#pragma unroll
                for (int i = 0; i < 6; ++i) { const int id = lane + 64 * i, row = id / 12, c = id % 12; *((v4u*)dst + id) = *(const v4u*)(scr + row * 208 + c * 16); }
                LDS_WAIT();
            }
            {
                asm volatile("" ::: "memory");
                bf16x8 kl[8];
#pragma unroll
                for (int ks = 0; ks < 8; ++ks) kl[ks] = *(const bf16x8*)(zt + (16 + ks) * 1024);
                uint2 krw[4];
#pragma unroll
                for (int g = 0; g < 4; ++g) krw[g] = *(const uint2*)((const char*)ZCc + (size_t)(mw >> 5) * 26 * 1024 + (24 + (g >> 1)) * 1024 + (g & 1) * 512 + r32 * 16 + hi * 8);
                float skv = 0.f;
#pragma unroll
                for (int ks = 0; ks < 8; ++ks)
#pragma unroll
                    for (int e = 0; e < 8; ++e) { const float v = __uint_as_float(((unsigned)(unsigned short)kl[ks][e]) << 16); skv = fmaf(v, v, skv); }
                const float rkv = __builtin_amdgcn_rsqf(swap_add(skv) * (1.0f / 128.0f) + EPS);
                float kr[16];
#pragma unroll
                for (int g = 0; g < 4; ++g) { kr[4 * g] = bf_lo(krw[g].x); kr[4 * g + 1] = bf_hi(krw[g].x); kr[4 * g + 2] = bf_lo(krw[g].y); kr[4 * g + 3] = bf_hi(krw[g].y); }
                float skr = 0.f;
#pragma unroll
                for (int r = 0; r < 16; ++r) skr = fmaf(kr[r], kr[r], skr);
                skr = swap_add(skr);
                f32x16 k0 = {}, k1 = {}, v0 = {}, v1 = {};
#pragma unroll
                for (int ks = 0; ks < 8; ++ks) { const char* wp = wkvb + ks * 32;
                    const bf16x8 a0 = *(const bf16x8*)(wp), a1 = *(const bf16x8*)(wp + 32 * WKV_ROW), a2 = *(const bf16x8*)(wp + 64 * WKV_ROW), a3 = *(const bf16x8*)(wp + 96 * WKV_ROW);
                    k0 = __builtin_amdgcn_mfma_f32_32x32x16_bf16(a0, kl[ks], k0, 0, 0, 0);
                    k1 = __builtin_amdgcn_mfma_f32_32x32x16_bf16(a1, kl[ks], k1, 0, 0, 0);
                    v0 = __builtin_amdgcn_mfma_f32_32x32x16_bf16(a2, kl[ks], v0, 0, 0, 0);
                    v1 = __builtin_amdgcn_mfma_f32_32x32x16_bf16(a3, kl[ks], v1, 0, 0, 0); }
#pragma unroll
                for (int g = 0; g < 4; ++g) {
                    *(uint2*)(scr + r32 * 144 + (8 * g + 4 * hi) * 2) = make_uint2(cvtpk(v0[4 * g] * rkv, v0[4 * g + 1] * rkv), cvtpk(v0[4 * g + 2] * rkv, v0[4 * g + 3] * rkv));
                    *(uint2*)(scr + r32 * 144 + (32 + 8 * g + 4 * hi) * 2) = make_uint2(cvtpk(v1[4 * g] * rkv, v1[4 * g + 1] * rkv), cvtpk(v1[4 * g + 2] * rkv, v1[4 * g + 3] * rkv)); }
                LDS_WAIT();
                bf16* dv = Vo + ((size_t)(b * NH + h) * SEQ + s0) * 64;
#pragma unroll
                for (int i = 0; i < 4; ++i) { const int id = lane + 64 * i, row = id >> 3, c = id & 7; *((v4u*)dv + id) = *(const v4u*)(scr + row * 144 + c * 16); }
                LDS_WAIT();
                asm volatile("" ::: "memory");
                if (it < 3) {
#pragma unroll
                    for (int ks = 0; ks < 8; ++ks) ql[ks] = *(const bf16x8*)(zt + 8 * 26 * 1024 + ks * 1024); }
                asm volatile("" ::: "memory");
                float ss = 0.f;
#pragma unroll
                for (int r = 0; r < 16; ++r) ss += k0[r] * k0[r] + k1[r] * k1[r];
                ss = swap_add(ss);
                const float rn = __builtin_amdgcn_rsqf((rkv * rkv * ss + skr) * (1.0f / 96.0f) + EPS), f = rkv * rn;
                float kq[16];
#pragma unroll
                for (int g = 0; g < 4; ++g) { const f32x4 ga = *(const f32x4*)(gl + 96 + 8 * g + 4 * hi), gb = *(const f32x4*)(gl + 96 + 32 + 8 * g + 4 * hi), gc = *(const f32x4*)(gl + 96 + 64 + 8 * g + 4 * hi);
#pragma unroll
                    for (int e = 0; e < 4; ++e) { k0[4 * g + e] *= f * ga[e]; k1[4 * g + e] *= f * gb[e]; kq[4 * g + e] = kr[4 * g + e] * rn * gc[e]; } }
#pragma unroll
                for (int r = 0; r < 8; ++r) { const float x1 = kq[r], x2 = kq[r + 8]; kq[r] = x1 * cs[r] - x2 * sn[r]; kq[r + 8] = x2 * cs[r] + x1 * sn[r]; }
#pragma unroll
                for (int g = 0; g < 4; ++g) {
                    *(uint2*)(scr + r32 * 208 + (8 * g + 4 * hi) * 2) = make_uint2(cvtpk(k0[4 * g], k0[4 * g + 1]), cvtpk(k0[4 * g + 2], k0[4 * g + 3]));
                    *(uint2*)(scr + r32 * 208 + (32 + 8 * g + 4 * hi) * 2) = make_uint2(cvtpk(k1[4 * g], k1[4 * g + 1]), cvtpk(k1[4 * g + 2], k1[4 * g + 3]));
                    *(uint2*)(scr + r32 * 208 + (64 + 8 * g + 4 * hi) * 2) = make_uint2(cvtpk(kq[4 * g], kq[4 * g + 1]), cvtpk(kq[4 * g + 2], kq[4 * g + 3])); }
                LDS_WAIT();
                bf16* dk = Kc + ((size_t)(b * NH + h) * SEQ + s0) * 96;
#pragma unroll
                for (int i = 0; i < 6; ++i) { const int id = lane + 64 * i, row = id / 12, c = id % 12; *((v4u*)dk + id) = *(const v4u*)(scr + row * 208 + c * 16); }
                LDS_WAIT();
            }
        }
    }
    __syncthreads();
}

__device__ __forceinline__ void ph_attn(Frame& F, const bf16* Q, const bf16* K, const bf16* V, bf16* MIX, bf16* DUMMY, const float* gqh, const float* gkh) {
    float gq = 0.f, gk = 0.f;
    for (int i = F.lane; i < 96; i += 64) { gq = fmaxf(gq, fabsf(gqh[i])); gk = fmaxf(gk, fabsf(gkh[i])); }
#pragma unroll
    for (int o = 1; o < 64; o <<= 1) { gq = fmaxf(gq, __shfl_xor(gq, o)); gk = fmaxf(gk, __shfl_xor(gk, o)); }
    const bool nomax = __builtin_amdgcn_readfirstlane((gq * gk * 14.136f * 1.05f <= 64.f) ? 1 : 0) != 0;
    for (int i = 0;; ++i) {
        int bh, qb;
        if (F.G == 256) { if (i >= 2) break; bh = (2 * (F.vcu >> 5) + i) * NH + ((F.vcu & 31) >> 2); qb = F.vcu & 3; }
        else { const int L = i * F.G + F.vcu; if (L >= BATCH * NH * 4) break; bh = L >> 2; qb = L & 3; }
        const int b = bh >> 3, h = bh & 7;
        const bf16* const Qk = Q + (size_t)(b >> 1) * (WS_QD / 2); const bf16* const Kk = K + (size_t)(b >> 1) * (WS_KD / 2);
        if (nomax) att::attn_unit64<true>(Qk + ((size_t)bh * SEQ + qb * 512) * 96, Kk + (size_t)bh * SEQ * 96, V + (size_t)bh * SEQ * 64, MIX + ((size_t)b * SEQ + qb * 512) * DM + 512 + h * 64, DM, SEQ, F.lds);
        else att::attn_unit64<false>(Qk + ((size_t)bh * SEQ + qb * 512) * 96, Kk + (size_t)bh * SEQ * 96, V + (size_t)bh * SEQ * 64, MIX + ((size_t)b * SEQ + qb * 512) * DM + 512 + h * 64, DM, SEQ, F.lds);
    }
}

typedef const __attribute__((address_space(4))) Args* KArgs;
#define KA() ({ KArgs p_ = (KArgs)__builtin_amdgcn_kernarg_segment_ptr(); asm volatile("" : "+s"(p_)); p_; })
__global__ void __launch_bounds__(NWAVES * 64, 2) mega_fwd(Args args) {
    extern __shared__ __attribute__((aligned(16))) unsigned char lds[];
    Frame F;
    F.lds = (char*)lds;
    F.MISC = (volatile LAS unsigned*)((LAS unsigned char*)lds + MISC_OFF);
    F.tid = threadIdx.x; F.lane = F.tid & 63; F.wave = __builtin_amdgcn_readfirstlane(F.tid >> 6);
    F.G = gridDim.x; { const int bx = blockIdx.x; F.vcu = (F.G % 8 == 0) ? (bx % 8) * (F.G / 8) + bx / 8 : bx; }
    if (F.tid < 64) F.MISC[F.tid] = 0u;
    __syncthreads();
    const int lo = args.ph_lo, hi = args.ph_hi;
    XcdBarrier bar; bar.bar = (unsigned*)((gu32*)(args.ws + WS_CTL) + CW_BAR) + args.li * XCD_BAR_WORDS; bar.x = 0; bar.st = nullptr;
    const bool full = (lo == 0 && hi == NPHASE);
    gu32* const ready = (gu32*)(args.ws + WS_CTL) + 64;
    if (full) {
        bar.x = xb_xcc_id(); bar.st = F.MISC + 8;
        if (blockIdx.x == 0 && F.tid < 64) {
            unsigned* bw = bar.bar;
            if (F.tid < 16) { __hip_atomic_store(&bw[XB_XCNT(F.tid)], 0u, RLX_AGENT); __hip_atomic_store(&bw[XB_XSUB(F.tid)], 0u, RLX_AGENT); __hip_atomic_store(&bw[XB_XGEN(F.tid)], 0u, RLX_AGENT);
                              __hip_atomic_store(&bw[XB_LSUB(F.tid)], 0u, RLX_AGENT); __hip_atomic_store(&bw[XB_LGEN(F.tid)], 0u, RLX_AGENT); }
            if (F.tid == 16) { __hip_atomic_store(&bw[XB_TMO], 0u, RLX_AGENT); __hip_atomic_store(&bw[XB_TOP], 0u, RLX_AGENT); __hip_atomic_store(&bw[XB_TOPGEN], 0u, RLX_AGENT);
                               __hip_atomic_store((gu32*)(args.ws + WS_CTL) + 16, 0u, RLX_AGENT); }
            asm volatile("s_waitcnt vmcnt(0)" ::: "memory");
            if (F.tid == 0) __hip_atomic_store(ready, READY_MAGIC, __ATOMIC_RELEASE, __HIP_MEMORY_SCOPE_AGENT);
        }
    } else if (hi - lo != 1) bar = xcd_barrier_post((unsigned*)((gu32*)(args.ws + WS_CTL) + CW_BAR) + args.li * XCD_BAR_WORDS, F.MISC + 8);
    gu32* const xtab = (gu32*)(args.ws + WS_CTL) + 1024; gu32* const xflag = (gu32*)(args.ws + WS_CTL) + 16;
    if (!full && F.tid == 0) __hip_atomic_store(xtab + blockIdx.x, bar.x + 1u, RLX_AGENT);
    bool use_local = false;
#ifndef PH_MASK
#define PH_MASK 0x1fff
#endif
#define IN(k) (((PH_MASK >> (k)) & 1) && lo <= (k) && (k) < hi)
#ifndef BAR_REP
#define BAR_REP 1
#endif
#define SEAM(k) do { if (IN(k) && (k) + 1 < hi) { for (int br_ = 0; br_ < BAR_REP; ++br_) xcd_barrier(bar); } } while (0)
#define SEAML(k) do { if (IN(k) && (k) + 1 < hi) { if (use_local) xcd_local_barrier(bar); else xcd_barrier(bar); } } while (0)
#ifndef PH_REP
#define PH_REP 0
#endif
#define REPS(k) for (int rep_ = 0; rep_ < 1 + ((PH_REP >> (k)) & 1); ++rep_)
#define WSB(off) (ws + (off))
#define INF(i) ((const float*)ka->in[i])
    LAS unsigned char* ring = (LAS unsigned char*)lds;

    if (IN(0)) REPS(0) { { KArgs ka = KA(); unsigned char* ws = ka->ws; ph_mod(F, INF(1), INF(3), INF(4), (float*)WSB(WS_MOD));
#ifdef MOD_REP
        for (int mr_ = 0; mr_ < MOD_REP; ++mr_) { __syncthreads(); ph_mod(F, INF(1), INF(3), INF(4), (float*)WSB(WS_MOD)); }
#endif
        } ph_weights(F, KA()); }
    if (full && F.tid == 0) {
        unsigned sp_ = 0u; while (__hip_atomic_load(ready, RLX_AGENT) != READY_MAGIC) { __builtin_amdgcn_s_sleep(2); if (++sp_ > (1u << 22)) break; }
        (void)xb_add(&bar.bar[XB_XCNT(bar.x)], 1u);
        __hip_atomic_store(xtab + blockIdx.x, bar.x + 1u, RLX_AGENT);
    }
    SEAM(0);
    if (full && blockIdx.x == 0 && F.tid == 0) __hip_atomic_store(ready, 0u, RLX_AGENT);
    if (lo == 0 && hi == NPHASE && F.G == 256 && F.tid == 0) { if (__hip_atomic_load(xtab + (blockIdx.x & 7), RLX_AGENT) != bar.x + 1u) __hip_atomic_store(xflag, 1u, RLX_AGENT); }
    if (IN(1)) REPS(1) { ph_prep(F, KA()); } SEAM(1);
#ifndef NO_LOCAL_SEAMS
    if (lo == 0 && hi == NPHASE && F.G == 256) use_local = __builtin_amdgcn_readfirstlane(__hip_atomic_load(xflag, RLX_AGENT) == 0u ? 1 : 0) != 0;
#endif
    if (IN(2)) REPS(2) { KArgs ka = KA(); unsigned char* ws = ka->ws;
        pg8::Gemm g{(const bf16*)WSB(WS_A1), (const bf16*)WSB(WS_W1T), M, 2 * DFF, DM}; pg8::StaticOrder S; S.init(M, 2 * DFF, F.G, (int)blockIdx.x);
        pg8::EpiSwigluN E{(bf16*)WSB(WS_ACT), DFF, (const float*)WSB(WS_SS0), (const float*)WSB(WS_BIAS1), 2 * DFF}; pg8::gemm_phase<pg8::EpiSwigluN, pg8::StaticOrder, true, true>(ring, g, S, E); } SEAML(2);
    if (IN(3)) REPS(3) { KArgs ka = KA(); unsigned char* ws = ka->ws;
        pg8::Gemm g{(const bf16*)WSB(WS_ACT), (const bf16*)WSB(WS_WD1T), M, DM, DFF}; pg8::StaticOrder S; S.init(M, DM, F.G, (int)blockIdx.x);
        pg8::EpiResidNorm<true, 2, true, false> E{WSB(WS_A1), nullptr, (const float*)WSB(WS_MOD) + 2 * DM, 2 * DM, -1 * DM, (bf16*)WSB(WS_A1), (float*)WSB(WS_SS1)};
        pg8::gemm_phase<pg8::EpiResidNorm<true, 2, true, false>, pg8::StaticOrder, true, true>(ring, g, S, E); } SEAML(3);
    if (IN(5)) REPS(5) { KArgs ka = KA(); unsigned char* ws = ka->ws;
        pg8::Gemm g{(const bf16*)WSB(WS_A1), (const bf16*)WSB(WS_WINT), M, WINP, DM}; pg8::StaticOrder S; S.init(M, WINP, F.G, (int)blockIdx.x);
        pg8::EpiG3N E{(bf16*)WSB(WS_ZG), (bf16*)WSB(WS_ZC), (const float*)WSB(WS_SS1), (const float*)WSB(WS_BIASM), WS_ZGD / 2, WS_ZCD / 2}; pg8::gemm_phase<pg8::EpiG3N, pg8::StaticOrder, true, true>(ring, g, S, E); } SEAML(5);
    if (IN(6)) {
        REPS(13) { KArgs ka = KA(); unsigned char* ws = ka->ws;
            ph_latent(F, (const bf16*)WSB(WS_ZC), (const bf16*)WSB(WS_WQT), (const bf16*)WSB(WS_WKVT), INF(13), INF(14), (const float*)WSB(WS_ROPE), (bf16*)WSB(WS_Q), (bf16*)WSB(WS_K), (bf16*)WSB(WS_V)); }
        REPS(14) { KArgs ka = KA(); unsigned char* ws = ka->ws; ph_conv(F, (const bf16*)WSB(WS_ZG), INF(15), INF(16), INF(17), INF(18), (bf16*)WSB(WS_MIX)); }
    } SEAML(6);
    if (IN(7)) REPS(7) { KArgs ka = KA(); unsigned char* ws = ka->ws; ph_attn(F, (const bf16*)WSB(WS_Q), (const bf16*)WSB(WS_K), (const bf16*)WSB(WS_V), (bf16*)WSB(WS_MIX), (bf16*)WSB(WS_A1), INF(13), INF(14)); } SEAML(7);
    if (IN(8)) REPS(8) { KArgs ka = KA(); unsigned char* ws = ka->ws;
        pg8::Gemm g{(const bf16*)WSB(WS_MIX), (const bf16*)WSB(WS_WOUTT), M, DM, DM}; pg8::StaticOrder S; S.init(M, DM, F.G, (int)blockIdx.x);
        pg8::EpiResidNorm<false, 2, true, false> E{WSB(WS_A1), nullptr, (const float*)WSB(WS_MOD) + 5 * DM, 2 * DM, -1 * DM, (bf16*)WSB(WS_A1), (float*)WSB(WS_SS2)};
        pg8::gemm_phase<pg8::EpiResidNorm<false, 2, true, false>, pg8::StaticOrder, true, true>(ring, g, S, E); } SEAML(8);
    if (IN(10)) REPS(10) { KArgs ka = KA(); unsigned char* ws = ka->ws;
        pg8::Gemm g{(const bf16*)WSB(WS_A1), (const bf16*)WSB(WS_W2T), M, 2 * DFF, DM}; pg8::StaticOrder S; S.init(M, 2 * DFF, F.G, (int)blockIdx.x);
        pg8::EpiSwigluN E{(bf16*)WSB(WS_ACT), DFF, (const float*)WSB(WS_SS2), (const float*)WSB(WS_BIAS2), 2 * DFF}; pg8::gemm_phase<pg8::EpiSwigluN, pg8::StaticOrder, true, true>(ring, g, S, E); } SEAML(10);
    if (IN(11)) REPS(11) { KArgs ka = KA(); unsigned char* ws = ka->ws;
        pg8::Gemm g{(const bf16*)WSB(WS_ACT), (const bf16*)WSB(WS_WD2T), M, DM, DFF}; pg8::StaticOrder S; S.init(M, DM, F.G, (int)blockIdx.x);
        pg8::EpiResidNorm<true, 2, false, true> E{WSB(WS_A1), (bf16*)WSB(WS_HB), (const float*)WSB(WS_MOD) + 8 * DM, 0, -1 * DM, nullptr, (float*)WSB(WS_SS3)};
        pg8::gemm_phase<pg8::EpiResidNorm<true, 2, false, true>, pg8::StaticOrder, true, true>(ring, g, S, E); } SEAML(11);
    if (IN(12)) REPS(12) { KArgs ka = KA(); unsigned char* ws = ka->ws; ph_final(F, (const bf16*)WSB(WS_HB), (const float*)WSB(WS_SS3), INF(23), ka->out); }
#undef IN
#undef SEAM
}

extern "C" void kernel_launch(void* const* d_in, const int* in_sizes, int n_in, void* d_out, int out_size, void* d_ws, size_t ws_size, hipStream_t stream) {
    static int grid = 0;
    if (grid == 0) {
        if (n_in != 24 || in_sizes[0] != M * DM || out_size != M * DM || ws_size < WS_END) { fprintf(stderr, "kernel_launch: unexpected shapes (n_in %d, in0 %d, out %d, ws %zu)\n", n_in, n_in > 0 ? in_sizes[0] : -1, out_size, ws_size); grid = -1; return; }
        int dev = 0, cus = 0, per_cu = 0;
        if (hipGetDevice(&dev) != hipSuccess || hipDeviceGetAttribute(&cus, hipDeviceAttributeMultiprocessorCount, dev) != hipSuccess) { grid = -1; return; }
        if (hipFuncSetAttribute((const void*)mega_fwd, hipFuncAttributeMaxDynamicSharedMemorySize, LDS_BYTES) != hipSuccess) { fprintf(stderr, "kernel_launch: hipFuncSetAttribute failed\n"); grid = -1; return; }
        if (hipOccupancyMaxActiveBlocksPerMultiprocessor(&per_cu, (const void*)mega_fwd, NWAVES * 64, LDS_BYTES) != hipSuccess || per_cu < 1) { fprintf(stderr, "kernel_launch: occupancy query says %d blocks per CU\n", per_cu); (void)hipGetLastError(); grid = -1; return; }
        grid = cus;
    }
    if (grid < 0) return;
    if (MK_N_LAUNCHES != 1) { if (hipMemsetAsync((char*)d_ws + WS_CTL, 0, CTL_ZERO_BYTES, stream) != hipSuccess) return; }
    Args a{};
    for (int i = 0; i < 24; ++i) a.in[i] = d_in[i];
    a.out = (float*)d_out; a.ws = (unsigned char*)d_ws;
    for (int i = 0; i < 16; ++i) a.invf[i] = 1.0 / pow(10000.0, (double)(2 * i) / 32.0);
    constexpr int NL = MK_N_LAUNCHES;
    for (int li = 0; li < NL; ++li) {
        a.ph_lo = (NL == NPHASE) ? li : (li * NPHASE) / NL; a.ph_hi = (NL == NPHASE) ? li + 1 : ((li + 1) * NPHASE) / NL; a.li = (NL == NPHASE) ? 0 : li;
        hipLaunchKernelGGL(mega_fwd, dim3(grid), dim3(NWAVES * 64), LDS_BYTES, stream, a);
        const hipError_t le = hipPeekAtLastError();
        if (le != hipSuccess) { fprintf(stderr, "kernel_launch: launch %d failed: %s\n", li, hipGetErrorName(le)); break; }
    }
}
```

```cpp
#include <hip/hip_runtime.h>
#include <hip/hip_bf16.h>
#include <cstdio>
#include <cstdint>
#include <cmath>
namespace pg8 {
#define PG8_LAS __attribute__((address_space(3)))
typedef unsigned short bf16_t;
typedef short bf16x8 __attribute__((ext_vector_type(8)));
typedef float f32x4 __attribute__((ext_vector_type(4)));
typedef unsigned u32x4 __attribute__((ext_vector_type(4)));
constexpr int BM = 256, BK = 64, HALF = 128, HTB = HALF * BK * 2  , STAGE_BYTES = 8 * HTB, NXCD = 8, WGM = 8;

__host__ __device__ __forceinline__ int lds_byte(int r, int c) { const int st = (r >> 4) * 2 + (c >> 5), rr = r & 15, cc = c & 31, ob = rr * 64 + cc * 2; return st * 1024 + (ob ^ (((ob >> 9) & 1) << 5)); }
__host__ __device__ __forceinline__ void stage_rc(int b, int& R, int& C) { const int st = b / 1024, sb = b % 1024, swz = sb ^ (((sb >> 9) & 1) << 5); R = (st >> 1) * 16 + swz / 64; C = (st & 1) * 32 + (swz % 64) / 2; }
__host__ __device__ __forceinline__ int perm32(int rho) { const int n = rho >> 4, i = rho & 15; return 8 * (i >> 2) + 4 * n + (i & 3); }

struct Unit { int pm, pn; };
struct Gemm { const bf16_t* A; const bf16_t* Bt; int M, N, K; };

struct StaticOrder {
    int nM, nN, nwg, G, c;
    __host__ __device__ void init(int M, int N, int G_, int c_) { nM = M / BM; nN = N / BM; nwg = nM * nN; G = G_; c = c_; }
    __host__ __device__ bool next(int i, Unit& u) const {
        const long L = (long)i * G + c; if (L >= nwg) return false;
        int wgid = (int)L; { const int q = nwg / NXCD, r = nwg % NXCD, xcd = wgid % NXCD, off = wgid / NXCD; wgid = (xcd < r ? xcd * (q + 1) : r * (q + 1) + (xcd - r) * q) + off; }
        const int nig = WGM * nN, gid = wgid / nig, fm = gid * WGM, gsz = (nM - fm) < WGM ? (nM - fm) : WGM;
        u.pm = fm + ((wgid % nig) % gsz); u.pn = (wgid % nig) / gsz; return true;
    }
    __device__ __forceinline__ void a_ready(const Unit&) const {}
    __device__ __forceinline__ void done(const Unit&) const {}
};

__device__ __forceinline__ unsigned cvt_pk_bf16(float lo, float hi) { unsigned r; asm volatile("v_cvt_pk_bf16_f32 %0, %1, %2" : "=v"(r) : "v"(lo), "v"(hi)); return r; }
__device__ __forceinline__ float sigm(float x) { return __builtin_amdgcn_rcpf(1.0f + __builtin_amdgcn_exp2f(-1.4426950408889634f * x)); }
typedef float f32x2 __attribute__((ext_vector_type(2)));
struct PkC { f32x2 nl, one;
    __device__ __forceinline__ PkC() { nl = (f32x2){-1.4426950408889634f, -1.4426950408889634f}; one = (f32x2){1.0f, 1.0f}; asm volatile("" : "+v"(nl), "+v"(one)); } };
__device__ __forceinline__ f32x2 pk_mul(f32x2 a, f32x2 b) { f32x2 d; asm("v_pk_mul_f32 %0, %1, %2" : "=v"(d) : "v"(a), "v"(b)); return d; }
__device__ __forceinline__ f32x2 pk_add(f32x2 a, f32x2 b) { f32x2 d; asm("v_pk_add_f32 %0, %1, %2" : "=v"(d) : "v"(a), "v"(b)); return d; }
__device__ __forceinline__ f32x4 sigm4(f32x4 x, const PkC& c) {
    const f32x2 m0 = pk_mul(__builtin_shufflevector(x, x, 0, 1), c.nl), m1 = pk_mul(__builtin_shufflevector(x, x, 2, 3), c.nl);
    f32x2 t0, t1; t0[0] = __builtin_amdgcn_exp2f(m0[0]); t0[1] = __builtin_amdgcn_exp2f(m0[1]); t1[0] = __builtin_amdgcn_exp2f(m1[0]); t1[1] = __builtin_amdgcn_exp2f(m1[1]);
    const f32x2 d0 = pk_add(t0, c.one), d1 = pk_add(t1, c.one);
    f32x4 r; r[0] = __builtin_amdgcn_rcpf(d0[0]); r[1] = __builtin_amdgcn_rcpf(d0[1]); r[2] = __builtin_amdgcn_rcpf(d1[0]); r[3] = __builtin_amdgcn_rcpf(d1[1]);
    return r; }
__device__ __forceinline__ f32x4 swiglu4(f32x4 g, f32x4 up, const PkC& c) { return (g * up) * sigm4(g, c); }
struct EpiSwiglu {
    static constexpr int ID = 20;
    static constexpr bool PERM = true, AFTER_DRAIN = false, PREF = false;
    bf16_t* O; int ldc;
    __device__ __forceinline__ void operator()(const f32x4 (&acc)[2][2][4][2], const Unit& u, int wr, int wc, int fr, int fq) const {
        const int row0 = u.pm * BM + wr * 64 + fr, col0 = u.pn * HALF + wc * 32 + 8 * fq;
        const PkC pkc;
#pragma unroll
        for (int ai = 0; ai < 2; ++ai)
#pragma unroll
            for (int m = 0; m < 4; ++m) { bf16_t* rowp = O + (size_t)(row0 + ai * HALF + m * 16) * ldc + col0;
                const f32x4 o0 = swiglu4(acc[ai][0][m][0], acc[ai][1][m][0], pkc), o1 = swiglu4(acc[ai][0][m][1], acc[ai][1][m][1], pkc);
                u32x4 w; w.x = cvt_pk_bf16(o0[0], o0[1]); w.y = cvt_pk_bf16(o0[2], o0[3]); w.z = cvt_pk_bf16(o1[0], o1[1]); w.w = cvt_pk_bf16(o1[2], o1[3]);
                *(u32x4*)rowp = w; }
    }
};
struct EpiG3 {
    static constexpr int ID = 21;
    static constexpr bool PERM = true, AFTER_DRAIN = false, PREF = false;
    bf16_t* ZG; bf16_t* ZC;
    __device__ __forceinline__ void operator()(const f32x4 (&acc)[2][2][4][2], const Unit& u, int wr, int wc, int fr, int fq) const {
        const int row0 = u.pm * BM + wr * 64 + fr;
        if (u.pn < 4) {
            const int col0 = u.pn * HALF + wc * 32 + 8 * fq;
#pragma unroll
            for (int ai = 0; ai < 2; ++ai)
#pragma unroll
                for (int m = 0; m < 4; ++m) { bf16_t* rowp = ZG + (size_t)(row0 + ai * HALF + m * 16) * 512 + col0;
                    float o[8];
#pragma unroll
                    for (int n = 0; n < 2; ++n)
#pragma unroll
                        for (int e = 0; e < 4; ++e) o[4 * n + e] = acc[ai][0][m][n][e] * sigm(acc[ai][1][m][n][e]);
                    u32x4 w; w.x = cvt_pk_bf16(o[0], o[1]); w.y = cvt_pk_bf16(o[2], o[3]); w.z = cvt_pk_bf16(o[4], o[5]); w.w = cvt_pk_bf16(o[6], o[7]);
                    *(u32x4*)rowp = w; }
        } else {
            const int col0 = (u.pn - 4) * BM + wc * 32 + 8 * fq;
#pragma unroll
            for (int ai = 0; ai < 2; ++ai)
#pragma unroll
                for (int m = 0; m < 4; ++m) { bf16_t* rowp = ZC + (size_t)(row0 + ai * HALF + m * 16) * 512 + col0;
#pragma unroll
                    for (int bj = 0; bj < 2; ++bj) { const f32x4 v0 = acc[ai][bj][m][0], v1 = acc[ai][bj][m][1];
                        u32x4 w; w.x = cvt_pk_bf16(v0[0], v0[1]); w.y = cvt_pk_bf16(v0[2], v0[3]); w.z = cvt_pk_bf16(v1[0], v1[1]); w.w = cvt_pk_bf16(v1[2], v1[3]);
                        *(u32x4*)(rowp + bj * HALF) = w; } }
        }
    }
};
struct EpiResid {
    static constexpr int ID = 22;
    static constexpr bool PERM = false, AFTER_DRAIN = false, PREF = false;
    const float* res; float* out; const float* gate; float coef;
    __device__ __forceinline__ void operator()(const f32x4 (&acc)[2][2][4][2], const Unit& u, int wr, int wc, int fr, int fq) const {
        const int row0 = u.pm * BM + wr * 64 + fr, col0 = u.pn * BM + wc * 32 + 4 * fq;
        const float* gp = gate + (size_t)(u.pm >> 3) * 9216 + col0;
        f32x4 gv[2][2];
#pragma unroll
        for (int bj = 0; bj < 2; ++bj)
#pragma unroll
            for (int n = 0; n < 2; ++n) gv[bj][n] = *(const f32x4*)(gp + bj * HALF + n * 16) * coef;
#pragma unroll
        for (int ai = 0; ai < 2; ++ai)
#pragma unroll
            for (int m = 0; m < 4; ++m) { const size_t off = (size_t)(row0 + ai * HALF + m * 16) * 1024 + col0;
                f32x4 r[2][2];
#pragma unroll
                for (int bj = 0; bj < 2; ++bj)
#pragma unroll
                    for (int n = 0; n < 2; ++n) r[bj][n] = *(const f32x4*)(res + off + bj * HALF + n * 16);
#pragma unroll
                for (int bj = 0; bj < 2; ++bj)
#pragma unroll
                    for (int n = 0; n < 2; ++n) *(f32x4*)(out + off + bj * HALF + n * 16) = r[bj][n] + gv[bj][n] * acc[ai][bj][m][n];
                if (m & 1) asm volatile("" ::: "memory"); }
    }
};

constexpr float PG_EPS = 1e-6f;
__device__ __forceinline__ f32x4 ada_scale(f32x4 v) { f32x4 r;
#pragma unroll
    for (int e = 0; e < 4; ++e) { const float x = 1.0f + v[e]; r[e] = fabsf(x) < 9.5367431640625e-07f ? (x < 0.f ? -9.5367431640625e-07f : 9.5367431640625e-07f) : x; }
    return r; }
template <bool HALFC, int RMODE, bool WAN, bool WH> struct EpiResidNorm {
    static constexpr int ID = HALFC ? 2 : 3;
    static constexpr bool PERM = true, AFTER_DRAIN = false, PREF = false;
    const void* res; bf16_t* hout; const float* gate; int sc_delta; int sp_delta; bf16_t* AN; float* ss;
    __device__ __forceinline__ void operator()(const f32x4 (&acc)[2][2][4][2], const Unit& u, int wr, int wc, int fr, int fq) const { run<true>(acc, u, wr, wc, fr, fq); }
    template <bool ATOM> __device__ __forceinline__ void run(const f32x4 (&acc)[2][2][4][2], const Unit& u, int wr, int wc, int fr, int fq) const {
        const int row0 = u.pm * BM + wr * 64 + fr, col0 = u.pn * BM + wc * 32 + 8 * fq;
        const float* gp = gate + (size_t)(u.pm >> 3) * 9216 + col0; constexpr float coef = HALFC ? 0.5f : 1.0f;
        f32x4 gv[2][2], sv[2][2], iv[2][2];
#pragma unroll
        for (int bj = 0; bj < 2; ++bj)
#pragma unroll
            for (int n = 0; n < 2; ++n) { gv[bj][n] = *(const f32x4*)(gp + bj * HALF + n * 4) * coef;
                if constexpr (WAN) sv[bj][n] = ada_scale(*(const f32x4*)(gp + sc_delta + bj * HALF + n * 4));
                if constexpr (RMODE == 2) { const f32x4 p = ada_scale(*(const f32x4*)(gp + sp_delta + bj * HALF + n * 4)); iv[bj][n] = (f32x4){__builtin_amdgcn_rcpf(p[0]), __builtin_amdgcn_rcpf(p[1]), __builtin_amdgcn_rcpf(p[2]), __builtin_amdgcn_rcpf(p[3])}; } }
        constexpr int PD = (RMODE == 2) ? 2 : 1;
        u32x4 rw[8][2]; f32x4 rf[8][2][2];
#define RES_LOAD(i) do { const size_t off_ = (size_t)(row0 + ((i) >> 2) * HALF + ((i) & 3) * 16) * 1024 + col0; \
            _Pragma("unroll") for (int bj = 0; bj < 2; ++bj) { \
                if constexpr (RMODE == 2) rw[i][bj] = *(const u32x4*)((const bf16_t*)res + off_ + bj * HALF); \
                else { rf[i][bj][0] = *(const f32x4*)((const float*)res + off_ + bj * HALF); rf[i][bj][1] = *(const f32x4*)((const float*)res + off_ + bj * HALF + 4); } } } while (0)
#pragma unroll
        for (int i = 0; i < PD; ++i) RES_LOAD(i);
#pragma unroll
        for (int i = 0; i < 8; ++i) {
            if (i + PD < 8) RES_LOAD(i + PD);
            const int ai = i >> 2, m = i & 3;
            const int row = row0 + ai * HALF + m * 16; const size_t off = (size_t)row * 1024 + col0;
            float q = 0.f;
#pragma unroll
            for (int bj = 0; bj < 2; ++bj) {
                f32x4 r0, r1;
                if constexpr (RMODE == 2) { const u32x4 w = rw[i][bj];
                    r0 = (f32x4){__uint_as_float(w.x << 16), __uint_as_float(w.x & 0xffff0000u), __uint_as_float(w.y << 16), __uint_as_float(w.y & 0xffff0000u)} * iv[bj][0];
                    r1 = (f32x4){__uint_as_float(w.z << 16), __uint_as_float(w.z & 0xffff0000u), __uint_as_float(w.w << 16), __uint_as_float(w.w & 0xffff0000u)} * iv[bj][1]; }
                else { r0 = rf[i][bj][0]; r1 = rf[i][bj][1]; }
                const f32x4 o0 = r0 + gv[bj][0] * acc[ai][bj][m][0], o1 = r1 + gv[bj][1] * acc[ai][bj][m][1];
                if constexpr (WH) { u32x4 hw; hw.x = cvt_pk_bf16(o0[0], o0[1]); hw.y = cvt_pk_bf16(o0[2], o0[3]); hw.z = cvt_pk_bf16(o1[0], o1[1]); hw.w = cvt_pk_bf16(o1[2], o1[3]);
                    *(u32x4*)(hout + off + bj * HALF) = hw; }
                q += (o0[0] * o0[0] + o0[1] * o0[1]) + (o0[2] * o0[2] + o0[3] * o0[3]) + (o1[0] * o1[0] + o1[1] * o1[1]) + (o1[2] * o1[2] + o1[3] * o1[3]);
                if constexpr (WAN) { const f32x4 a0 = o0 * sv[bj][0], a1 = o1 * sv[bj][1];
                    u32x4 w; w.x = cvt_pk_bf16(a0[0], a0[1]); w.y = cvt_pk_bf16(a0[2], a0[3]); w.z = cvt_pk_bf16(a1[0], a1[1]); w.w = cvt_pk_bf16(a1[2], a1[3]);
                    *(u32x4*)(AN + off + bj * HALF) = w; } }
            q += __shfl_xor(q, 16); q += __shfl_xor(q, 32);
            if (ATOM && fq == 0) (void)__hip_atomic_fetch_add((__attribute__((address_space(1))) float*)(ss + row), q, __ATOMIC_RELAXED, __HIP_MEMORY_SCOPE_AGENT);
            asm volatile("" ::: "memory");
        }
#undef RES_LOAD
    }
};
template <bool HALFC> struct EpiResidOut {
    static constexpr int ID = 26;
    static constexpr bool PERM = true, AFTER_DRAIN = false, PREF = false;
    const bf16_t* res; float* out; const float* gate;
    __device__ __forceinline__ void operator()(const f32x4 (&acc)[2][2][4][2], const Unit& u, int wr, int wc, int fr, int fq) const {
        const int row0 = u.pm * BM + wr * 64 + fr, col0 = u.pn * BM + wc * 32 + 8 * fq;
        const float* gp = gate + (size_t)(u.pm >> 3) * 9216 + col0; constexpr float coef = HALFC ? 0.5f : 1.0f;
        f32x4 gv[2][2];
#pragma unroll
        for (int bj = 0; bj < 2; ++bj)
#pragma unroll
            for (int n = 0; n < 2; ++n) gv[bj][n] = *(const f32x4*)(gp + bj * HALF + n * 4) * coef;
#pragma unroll
        for (int ai = 0; ai < 2; ++ai) {
            u32x4 rw[4][2];
#pragma unroll
            for (int m = 0; m < 4; ++m) { const size_t off = (size_t)(row0 + ai * HALF + m * 16) * 1024 + col0;
#pragma unroll
                for (int bj = 0; bj < 2; ++bj) rw[m][bj] = *(const u32x4*)(res + off + bj * HALF); }
#pragma unroll
            for (int m = 0; m < 4; ++m) { const size_t off = (size_t)(row0 + ai * HALF + m * 16) * 1024 + col0;
#pragma unroll
                for (int bj = 0; bj < 2; ++bj) { const u32x4 w = rw[m][bj];
                    const f32x4 r0 = {__uint_as_float(w.x << 16), __uint_as_float(w.x & 0xffff0000u), __uint_as_float(w.y << 16), __uint_as_float(w.y & 0xffff0000u)};
                    const f32x4 r1 = {__uint_as_float(w.z << 16), __uint_as_float(w.z & 0xffff0000u), __uint_as_float(w.w << 16), __uint_as_float(w.w & 0xffff0000u)};
                    *(f32x4*)(out + off + bj * HALF) = r0 + gv[bj][0] * acc[ai][bj][m][0]; *(f32x4*)(out + off + bj * HALF + 4) = r1 + gv[bj][1] * acc[ai][bj][m][1]; } }
            asm volatile("" ::: "memory"); }
    }
};
struct EpiSwigluN {
    static constexpr int ID = 1;
    static constexpr bool PERM = true, AFTER_DRAIN = false, PREF = true;
    bf16_t* O; int ldc; const float* ss; const float* bias; int nb;
    __device__ __forceinline__ float prefetch(const Unit& u, int tid) const {
        return tid < 256 ? ss[u.pm * BM + tid] : bias[(size_t)(u.pm >> 3) * nb + u.pn * BM + (tid - 256)]; }
    __device__ __forceinline__ void operator()(const f32x4 (&acc)[2][2][4][2], const Unit& u, int wr, int wc, int fr, int fq, float pre, PG8_LAS float* sp) const {
        const int tid = threadIdx.x;
        sp[tid] = tid < 256 ? __builtin_amdgcn_rsqf(pre * (1.0f / 1024.0f) + PG_EPS) : pre;
        asm volatile("s_waitcnt lgkmcnt(0)" ::: "memory"); __builtin_amdgcn_s_barrier(); asm volatile("" ::: "memory");
        const int row0 = u.pm * BM + wr * 64 + fr, col0 = u.pn * HALF + wc * 32 + 8 * fq;
        const PkC pkc;
        f32x4 bv[2][2];
#pragma unroll
        for (int bj = 0; bj < 2; ++bj)
#pragma unroll
            for (int n = 0; n < 2; ++n) bv[bj][n] = *(const PG8_LAS f32x4*)(sp + 256 + bj * HALF + wc * 32 + 8 * fq + n * 4);
#pragma unroll
        for (int ai = 0; ai < 2; ++ai)
#pragma unroll
            for (int m = 0; m < 4; ++m) { const int rl = ai * HALF + wr * 64 + m * 16 + fr; bf16_t* rowp = O + (size_t)(u.pm * BM + rl) * ldc + col0;
                const float rs = sp[rl];
                const f32x4 o0 = swiglu4(acc[ai][0][m][0] * rs + bv[0][0], acc[ai][1][m][0] * rs + bv[1][0], pkc), o1 = swiglu4(acc[ai][0][m][1] * rs + bv[0][1], acc[ai][1][m][1] * rs + bv[1][1], pkc);
                u32x4 w; w.x = cvt_pk_bf16(o0[0], o0[1]); w.y = cvt_pk_bf16(o0[2], o0[3]); w.z = cvt_pk_bf16(o1[0], o1[1]); w.w = cvt_pk_bf16(o1[2], o1[3]);
                *(u32x4*)rowp = w; }
        (void)row0;
    }
};
struct EpiG3N {
    static constexpr int ID = 23;
    static constexpr bool PERM = true, AFTER_DRAIN = false, PREF = true;
    bf16_t* ZGb; bf16_t* ZCb; const float* ss; const float* bias; size_t dzg, dzc;
    __device__ __forceinline__ float prefetch(const Unit& u, int tid) const {
        return tid < 256 ? ss[u.pm * BM + tid] : bias[(size_t)(u.pm >> 3) * 1536 + u.pn * BM + (tid - 256)]; }
    __device__ __forceinline__ void operator()(const f32x4 (&acc)[2][2][4][2], const Unit& u, int wr, int wc, int fr, int fq, float pre, PG8_LAS float* sp) const {
        { const int tid = threadIdx.x; sp[tid] = tid < 256 ? __builtin_amdgcn_rsqf(pre * (1.0f / 1024.0f) + PG_EPS) : pre; }
        asm volatile("s_waitcnt lgkmcnt(0)" ::: "memory"); __builtin_amdgcn_s_barrier(); asm volatile("" ::: "memory");
        const int row0 = u.pm * BM + wr * 64 + fr;
        bf16_t* const ZG = ZGb + (size_t)(u.pm >> 4) * dzg; bf16_t* const ZC = ZCb + (size_t)(u.pm >> 4) * dzc;
        f32x4 bv[2][2];
#pragma unroll
        for (int bj = 0; bj < 2; ++bj)
#pragma unroll
            for (int n = 0; n < 2; ++n) bv[bj][n] = *(const PG8_LAS f32x4*)(sp + 256 + bj * HALF + wc * 32 + 8 * fq + n * 4);
        if (u.pn < 4) {
            const PkC pkc;
            const int col0 = u.pn * HALF + wc * 32 + 8 * fq;
#pragma unroll
            for (int ai = 0; ai < 2; ++ai)
#pragma unroll
                for (int m = 0; m < 4; ++m) { const int row = row0 + ai * HALF + m * 16; bf16_t* rowp = ZG + (size_t)row * 512 + col0;
                    const float rs = sp[row - u.pm * BM];
                    const f32x4 o0 = (acc[ai][0][m][0] * rs + bv[0][0]) * sigm4(acc[ai][1][m][0] * rs + bv[1][0], pkc), o1 = (acc[ai][0][m][1] * rs + bv[0][1]) * sigm4(acc[ai][1][m][1] * rs + bv[1][1], pkc);
                    u32x4 w; w.x = cvt_pk_bf16(o0[0], o0[1]); w.y = cvt_pk_bf16(o0[2], o0[3]); w.z = cvt_pk_bf16(o1[0], o1[1]); w.w = cvt_pk_bf16(o1[2], o1[3]);
                    *(u32x4*)rowp = w; }
        } else {
            const int col0 = (u.pn - 4) * BM + wc * 32 + 8 * fq;
#pragma unroll
            for (int ai = 0; ai < 2; ++ai)
#pragma unroll
                for (int m = 0; m < 4; ++m) { const int row = row0 + ai * HALF + m * 16;
                    const float rs = sp[row - u.pm * BM];
#pragma unroll
                    for (int bj = 0; bj < 2; ++bj) { const f32x4 v0 = acc[ai][bj][m][0] * rs + bv[bj][0], v1 = acc[ai][bj][m][1] * rs + bv[bj][1];
                        u32x4 w; w.x = cvt_pk_bf16(v0[0], v0[1]); w.y = cvt_pk_bf16(v0[2], v0[3]); w.z = cvt_pk_bf16(v1[0], v1[1]); w.w = cvt_pk_bf16(v1[2], v1[3]);
                        const int c8 = col0 + bj * HALF, kb = c8 >> 4;
                        if (kb < 26) *(u32x4*)((char*)ZC + ((size_t)((row >> 5) * 26 + kb) * 1024 + ((c8 >> 3) & 1) * 512 + (row & 31) * 16)) = w; } }
        }
    }
};

__device__ __forceinline__ void prestage_b(PG8_LAS unsigned char* lds, const void* Bt, int Mrows, int N, int K, int G, int c) {
    StaticOrder S; S.init(Mrows, N, G, c); Unit u; if (!S.next(0, u)) return;
    const int tid = threadIdx.x, wid = __builtin_amdgcn_readfirstlane(tid >> 6);
    unsigned voffB[2];
#pragma unroll
    for (int i = 0; i < 2; ++i) { int R, C; stage_rc(tid * 16 + i * 8192, R, C); const int Rb = (R & ~31) + perm32(R & 31); voffB[i] = (unsigned)(Rb * K + C) * 2u; }
    const size_t hstep = (size_t)HALF * K * 2, tstep = 2 * hstep; const unsigned ldsw = (unsigned)wid * 1024u;
    const char* cB = (const char*)Bt + (size_t)u.pn * tstep;
#pragma unroll
    for (int h = 0; h < 2; ++h)
#pragma unroll
        for (int i = 0; i < 2; ++i)
            __builtin_amdgcn_global_load_lds((const unsigned*)(cB + h * hstep + voffB[i]), (PG8_LAS unsigned*)(lds + (4 + h) * HTB + ldsw + i * 8192), 16, 0, 0);
}
template <class Epi, class Sched, bool ALIGN_EPI = false, bool SP2 = false>
__device__ __forceinline__ void gemm_phase(PG8_LAS unsigned char* lds, const Gemm g, const Sched& S, const Epi& E, const bool bpre = false) {
    const int tid = threadIdx.x, wid = __builtin_amdgcn_readfirstlane(tid >> 6), lane = tid & 63, wr = wid >> 2, wc = wid & 3, fr = lane & 15, fq = lane >> 4;
    const int K = g.K, nt = K / BK;
    unsigned voffA[2], voffB[2];
#pragma unroll
    for (int i = 0; i < 2; ++i) { int R, C; stage_rc(tid * 16 + i * 8192, R, C); const int Rb = Epi::PERM ? ((R & ~31) + perm32(R & 31)) : R;
        voffA[i] = (unsigned)(R * K + C) * 2u; voffB[i] = (unsigned)(Rb * K + C) * 2u; }
    const size_t kstep = (size_t)(BK * 2);
    const size_t hstep = (size_t)HALF * K * 2;
    const size_t tstep = 2 * hstep;
    const unsigned ldsw = (unsigned)wid * 1024u;
    const int aoff = lds_byte(wr * 64 + fr, fq * 8), boff = lds_byte(wc * 32 + fr, fq * 8);
#define PG8_SA(b, h) (((b) * 2 + (h)) * HTB)
#define PG8_SB(b, h) ((4 + (b) * 2 + (h)) * HTB)
#define PG8_STAGE(bufoff, gbase, voff) do { _Pragma("unroll") for (int _i = 0; _i < 2; ++_i) \
        __builtin_amdgcn_global_load_lds((const unsigned*)((const char*)(gbase) + (voff)[_i]), (PG8_LAS unsigned*)(lds + (bufoff) + ldsw + _i * 8192), 16, 0, 0); } while (0)
#define PG8_LDA(dst, b, h) do { _Pragma("unroll") for (int m = 0; m < 4; ++m) _Pragma("unroll") for (int k = 0; k < 2; ++k) dst[m][k] = *(const PG8_LAS bf16x8*)(lds + PG8_SA(b, h) + aoff + m * 2048 + k * 1024); } while (0)
#define PG8_LDB(dst, b, h) do { _Pragma("unroll") for (int n = 0; n < 2; ++n) _Pragma("unroll") for (int k = 0; k < 2; ++k) dst[n][k] = *(const PG8_LAS bf16x8*)(lds + PG8_SB(b, h) + boff + n * 2048 + k * 1024); } while (0)
#define PG8_MMA(ai, bj, At, Bt) do { __builtin_amdgcn_s_setprio(1); _Pragma("unroll") for (int m = 0; m < 4; ++m) _Pragma("unroll") for (int n = 0; n < 2; ++n) _Pragma("unroll") for (int k = 0; k < 2; ++k) \
        acc[ai][bj][m][n] = __builtin_amdgcn_mfma_f32_16x16x32_bf16(Bt[n][k], At[m][k], acc[ai][bj][m][n], 0, 0, 0); __builtin_amdgcn_s_setprio(0); } while (0)
#define PG8_WAIT_V(n) asm volatile("s_waitcnt vmcnt(" #n ")" ::: "memory")
#define PG8_WAIT_L(n) asm volatile("s_waitcnt lgkmcnt(" #n ")" ::: "memory")
#define PG8_BAR __builtin_amdgcn_s_barrier()
#define PG8_SCHED __builtin_amdgcn_sched_barrier(0)
    Unit cur, nxt; int ui = 0;
    if (!S.next(0, cur)) return;
    float epre = 0.f; if constexpr (Epi::PREF) epre = E.prefetch(cur, tid);
    f32x4 acc[2][2][4][2];
#pragma unroll
    for (int a = 0; a < 2; ++a)
#pragma unroll
        for (int b = 0; b < 2; ++b)
#pragma unroll
            for (int m = 0; m < 4; ++m)
#pragma unroll
                for (int n = 0; n < 2; ++n) acc[a][b][m][n] = (f32x4){0.f, 0.f, 0.f, 0.f};
    bf16x8 At[4][2], B0[2][2], B1[2][2];
    const char* cA = (const char*)g.A + (size_t)cur.pm * tstep; const char* cB = (const char*)g.Bt + (size_t)cur.pn * tstep;
    S.a_ready(cur);
    if constexpr (SP2) {
        if (!bpre) { PG8_STAGE(PG8_SB(0, 0), cB, voffB); PG8_STAGE(PG8_SB(0, 1), cB + hstep, voffB); } PG8_STAGE(PG8_SA(0, 0), cA, voffA); PG8_STAGE(PG8_SA(0, 1), cA + hstep, voffA);
        if (wr == 1) PG8_BAR;
        PG8_WAIT_V(2); PG8_BAR;
        PG8_STAGE(PG8_SB(1, 0), cB + kstep, voffB); PG8_STAGE(PG8_SA(1, 0), cA + kstep, voffA); PG8_STAGE(PG8_SB(1, 1), cB + hstep + kstep, voffB);
        PG8_WAIT_V(6); PG8_BAR;
    } else {
        PG8_STAGE(PG8_SB(0, 0), cB, voffB); PG8_STAGE(PG8_SA(0, 0), cA, voffA); PG8_STAGE(PG8_SB(0, 1), cB + hstep, voffB); PG8_STAGE(PG8_SA(0, 1), cA + hstep, voffA);
        if (wr == 1) PG8_BAR;
        PG8_WAIT_V(4); PG8_BAR;
        PG8_STAGE(PG8_SB(1, 0), cB + kstep, voffB); PG8_STAGE(PG8_SA(1, 0), cA + kstep, voffA); PG8_STAGE(PG8_SB(1, 1), cB + hstep + kstep, voffB);
        PG8_WAIT_V(6); PG8_BAR;
    }
    for (;;) {
        const bool has_next = S.next(ui + 1, nxt);
        const char* nA = has_next ? (const char*)g.A + (size_t)nxt.pm * tstep : cA; const char* nB = has_next ? (const char*)g.Bt + (size_t)nxt.pn * tstep : cB;
        for (int t = 0; t < nt; t += 2) {
            const bool last = (t == nt - 2);
            const char* a1 = cA + (size_t)(t + 1) * kstep;
            const char* a2 = last ? nA : cA + (size_t)(t + 2) * kstep; const char* b2 = last ? nB : cB + (size_t)(t + 2) * kstep;
            const char* a3 = a2 + kstep; const char* b3 = b2 + kstep;
            if (last && has_next) S.a_ready(nxt);
            if constexpr (SP2) {
            PG8_LDB(B0, 0, 0); PG8_LDB(B1, 0, 1); PG8_SCHED; PG8_LDA(At, 0, 0); PG8_STAGE(PG8_SA(1, 1), a1 + hstep, voffA);
            PG8_WAIT_V(8); PG8_WAIT_L(0); PG8_BAR; PG8_MMA(0, 0, At, B0); PG8_MMA(0, 1, At, B1); PG8_BAR; PG8_SCHED;
            PG8_LDA(At, 0, 1); PG8_STAGE(PG8_SB(0, 0), b2, voffB); PG8_STAGE(PG8_SB(0, 1), b2 + hstep, voffB); PG8_STAGE(PG8_SA(0, 0), a2, voffA);
            PG8_WAIT_V(8); PG8_WAIT_L(0); PG8_BAR; PG8_MMA(1, 0, At, B0); PG8_MMA(1, 1, At, B1); PG8_BAR; PG8_SCHED;
            PG8_LDB(B0, 1, 0); PG8_LDB(B1, 1, 1); PG8_SCHED; PG8_LDA(At, 1, 0); PG8_STAGE(PG8_SA(0, 1), a2 + hstep, voffA);
            PG8_WAIT_V(8); PG8_WAIT_L(0); PG8_BAR; PG8_MMA(0, 0, At, B0); PG8_MMA(0, 1, At, B1); PG8_BAR; PG8_SCHED;
            PG8_LDA(At, 1, 1); PG8_STAGE(PG8_SB(1, 0), b3, voffB); PG8_STAGE(PG8_SB(1, 1), b3 + hstep, voffB); PG8_STAGE(PG8_SA(1, 0), a3, voffA);
            PG8_WAIT_V(8); PG8_WAIT_L(0); PG8_BAR; PG8_MMA(1, 0, At, B0); PG8_MMA(1, 1, At, B1); PG8_BAR; PG8_SCHED;
            } else {
            PG8_LDB(B0, 0, 0); PG8_SCHED; PG8_LDA(At, 0, 0); PG8_STAGE(PG8_SA(1, 1), a1 + hstep, voffA);
            PG8_WAIT_L(8); PG8_BAR; PG8_WAIT_L(0); PG8_MMA(0, 0, At, B0); PG8_BAR; PG8_SCHED;
            PG8_LDB(B1, 0, 1); PG8_STAGE(PG8_SB(0, 0), b2, voffB);
            PG8_BAR; PG8_WAIT_L(0); PG8_MMA(0, 1, At, B1); PG8_BAR;
            PG8_LDA(At, 0, 1); PG8_STAGE(PG8_SA(0, 0), a2, voffA);
            PG8_BAR; PG8_WAIT_L(0); PG8_MMA(1, 0, At, B0); PG8_BAR; PG8_SCHED;
            PG8_STAGE(PG8_SB(0, 1), b2 + hstep, voffB);
            PG8_WAIT_V(6); PG8_BAR; PG8_MMA(1, 1, At, B1); PG8_BAR;
            PG8_LDB(B0, 1, 0); PG8_SCHED; PG8_LDA(At, 1, 0); PG8_STAGE(PG8_SA(0, 1), a2 + hstep, voffA);
            PG8_WAIT_L(8); PG8_BAR; PG8_WAIT_L(0); PG8_MMA(0, 0, At, B0); PG8_BAR; PG8_SCHED;
            PG8_LDB(B1, 1, 1); PG8_STAGE(PG8_SB(1, 0), b3, voffB);
            PG8_BAR; PG8_WAIT_L(0); PG8_MMA(0, 1, At, B1); PG8_BAR;
            PG8_LDA(At, 1, 1); PG8_STAGE(PG8_SA(1, 0), a3, voffA);
            PG8_BAR; PG8_WAIT_L(0); PG8_MMA(1, 0, At, B0); PG8_BAR; PG8_SCHED;
            PG8_STAGE(PG8_SB(1, 1), b3 + hstep, voffB);
            PG8_WAIT_V(6); PG8_BAR; PG8_MMA(1, 1, At, B1); PG8_BAR;
            }
        }
        if constexpr (ALIGN_EPI) { if (wr == 0) PG8_BAR; }
        if constexpr (!Epi::AFTER_DRAIN) { if constexpr (Epi::PREF) E(acc, cur, wr, wc, fr, fq, epre, (PG8_LAS float*)(lds + STAGE_BYTES)); else E(acc, cur, wr, wc, fr, fq);
#ifdef EPI_REP_DISABLED
            if constexpr (((EPI_REP >> Epi::ID) & 1) != 0) { asm volatile("" ::: "memory"); if constexpr (Epi::ID == 2) E.template run<false>(acc, cur, wr, wc, fr, fq); else E(acc, cur, wr, wc, fr, fq); }
#endif
            S.done(cur); }
        if (!has_next) break;
#pragma unroll
        for (int a = 0; a < 2; ++a)
#pragma unroll
            for (int b = 0; b < 2; ++b)
#pragma unroll
                for (int m = 0; m < 4; ++m)
#pragma unroll
                    for (int n = 0; n < 2; ++n) acc[a][b][m][n] = (f32x4){0.f, 0.f, 0.f, 0.f};
        cur = nxt; cA = nA; cB = nB; ++ui;
        if constexpr (Epi::PREF) epre = E.prefetch(cur, tid);
        if constexpr (ALIGN_EPI) { if (wr == 1) PG8_BAR; }
    }
    PG8_WAIT_V(0);
    if constexpr (!ALIGN_EPI) { if (wr == 0) PG8_BAR; }
    PG8_BAR;
    if constexpr (Epi::AFTER_DRAIN) { E.fused(acc, cur, wr, wc, fr, fq, lds, wid, lane); S.done(cur); }
#undef PG8_SA
#undef PG8_SB
#undef PG8_STAGE
#undef PG8_LDA
#undef PG8_LDB
#undef PG8_MMA
#undef PG8_WAIT_V
#undef PG8_WAIT_L
#undef PG8_BAR
#undef PG8_SCHED
}
}
namespace att {
using bf16x8 = __attribute__((ext_vector_type(8))) short;
using s16x4  = __attribute__((ext_vector_type(4))) short;
using f32x16 = __attribute__((ext_vector_type(16))) float;
using u32x4  = __attribute__((ext_vector_type(4))) unsigned;
typedef unsigned short bf16_t;
constexpr int DQK = 96, DV = 64, NW = 8, QBLK = 32, KVBLK = 64;
constexpr float QSCALE = 0.10206207261596575f * 1.4426950408889634f;
constexpr float THRL = 11.5f;
constexpr int SHM_V = KVBLK * DV * 2, SHM_K = KVBLK * 256;
constexpr int OST_W = 32 * 144;
constexpr int OFF_V = 0, OFF_K = 2 * SHM_V, OFF_OST = OFF_K + 2 * SHM_K, SHM_ATTN = OFF_OST + NW * OST_W;
#define KSWZ(row, colB) ((row) * 256 + ((colB) ^ (((row) & 15) << 4)))
#define SBAR() __builtin_amdgcn_sched_barrier(0)
__device__ __forceinline__ int crow(int r, int hi) { return (r & 3) + 8 * (r >> 2) + 4 * hi; }
__device__ __forceinline__ unsigned cvtpk(float lo, float hi) { unsigned r; asm volatile("v_cvt_pk_bf16_f32 %0, %1, %2" : "=v"(r) : "v"(lo), "v"(hi)); return r; }
typedef __bf16 bf16n2 __attribute__((ext_vector_type(2)));
typedef float f32n2 __attribute__((ext_vector_type(2)));
__device__ __forceinline__ unsigned cvtpk_n(float lo, float hi) { const f32n2 v = {lo, hi}; return __builtin_bit_cast(unsigned, __builtin_convertvector(v, bf16n2)); }
__device__ __forceinline__ bf16x8 ld8(const bf16_t* p) { return *reinterpret_cast<const bf16x8*>(p); }
__device__ __forceinline__ float max3(float a, float b, float c) { return fmaxf(fmaxf(a, b), c); }

template <bool FIRST, int ABL = 0> __device__ __forceinline__ void partialSM(f32x16& p0, f32x16& p1, float& mref, float& alpha) {
  if constexpr (ABL & 1) { alpha = 1.f; return; }
  float a = max3(p0[0], p0[1], p0[2]), b = max3(p1[0], p1[1], p1[2]);
#pragma unroll
  for (int r = 3; r < 15; r += 2) { a = max3(a, p0[r], p0[r + 1]); b = max3(b, p1[r], p1[r + 1]); }
  float pmax = max3(a, b, fmaxf(p0[15], p1[15]));
  { auto rr = __builtin_amdgcn_permlane32_swap(__float_as_uint(pmax), __float_as_uint(pmax), false, false);
    pmax = fmaxf(__uint_as_float(rr[0]), __uint_as_float(rr[1])); }
  pmax -= mref;
  if (__builtin_expect(__all(FIRST ? (fabsf(pmax) <= THRL) : (pmax <= THRL)), 1)) { alpha = 1.f; }
  else { const float dl = FIRST ? pmax : fmaxf(pmax, 0.f); mref += dl; alpha = __builtin_amdgcn_exp2f(-dl); }
  if (__any(mref != 0.f)) {
#pragma unroll
    for (int r = 0; r < 16; ++r) { p0[r] -= mref; p1[r] -= mref; } }
#pragma unroll
  for (int r = 0; r < 16; ++r) p0[r] = __builtin_amdgcn_exp2f(p0[r]);
}
template <int ABL = 0> __device__ __forceinline__ void finishSM(f32x16& p0, f32x16& p1, float alpha, float& l_reg, bf16x8& pa0, bf16x8& pa1, bf16x8& pa2, bf16x8& pa3) {
  if constexpr (!(ABL & 1)) {
#pragma unroll
  for (int r = 0; r < 16; ++r) p1[r] = __builtin_amdgcn_exp2f(p1[r]);
  float ps0 = 0.f, ps1 = 0.f;
#pragma unroll
  for (int r = 0; r < 16; ++r) { ps0 += p0[r]; ps1 += p1[r]; }
  l_reg = l_reg * alpha + (ps0 + ps1); } else { l_reg = 1.f; }
#define PK8(P, BASE, OUT) do { u32x4 w = {cvtpk(P[BASE + 0], P[BASE + 1]), cvtpk(P[BASE + 2], P[BASE + 3]), cvtpk(P[BASE + 4], P[BASE + 5]), cvtpk(P[BASE + 6], P[BASE + 7])}; \
    OUT = *reinterpret_cast<bf16x8*>(&w); } while (0)
  PK8(p0, 0, pa0); PK8(p0, 8, pa1); PK8(p1, 0, pa2); PK8(p1, 8, pa3);
#undef PK8
}
template <int ABL = 0> __device__ __forceinline__ void qkt(f32x16& p0, f32x16& p1, const char* Ks, const bf16x8* qr, int r32, int hi) {
  p0 = f32x16{}; p1 = f32x16{};
  if constexpr (ABL & 4) {
#pragma unroll
    for (int d0 = 0; d0 < 6; ++d0) { int cb = (d0 * 16 + hi * 8) * 2;
      bf16x8 b0 = *reinterpret_cast<const bf16x8*>(Ks + KSWZ(r32, cb)); bf16x8 b1 = *reinterpret_cast<const bf16x8*>(Ks + KSWZ(32 + r32, cb));
      asm volatile("" :: "v"(b0), "v"(b1)); }
    return; }
#pragma unroll
  for (int d0 = 0; d0 < 6; ++d0) { int cb = (d0 * 16 + hi * 8) * 2;
    bf16x8 b0 = *reinterpret_cast<const bf16x8*>(Ks + KSWZ(r32, cb));
    bf16x8 b1 = *reinterpret_cast<const bf16x8*>(Ks + KSWZ(32 + r32, cb));
    p0 = __builtin_amdgcn_mfma_f32_32x32x16_bf16(b0, qr[d0], p0, 0, 0, 0); p1 = __builtin_amdgcn_mfma_f32_32x32x16_bf16(b1, qr[d0], p1, 0, 0, 0); }
}
__device__ __forceinline__ int v_st(int k, int c) { return ((k >> 3) * 2 + (c >> 5)) * 512 + ((k & 7) * 32 + (c & 31)) * 2; }
__device__ __forceinline__ int v_rd_base(int lane) { return ((lane & 3) << 3) | (((lane >> 2) & 3) << 6) | (((lane >> 4) & 1) << 5) | (((lane >> 5) & 1) << 8); }
constexpr int v_rd_off(int d0, int ks, int half) { return d0 * 512 + ks * 2048 + half * 1024; }
template <int OFF> __device__ __forceinline__ s16x4 tr_read(int vb) {
  s16x4 r; asm volatile("ds_read_b64_tr_b16 %0, %1 offset:%2" : "=&v"(r) : "v"(vb), "i"(OFF) : "memory"); return r;
}
template <int D0> __device__ __forceinline__ void pv_one(f32x16& od, int vb, bf16x8 pa0, bf16x8 pa1, bf16x8 pa2, bf16x8 pa3) {
  const s16x4 l0 = tr_read<v_rd_off(D0, 0, 0)>(vb), h0 = tr_read<v_rd_off(D0, 0, 1)>(vb), l1 = tr_read<v_rd_off(D0, 1, 0)>(vb), h1 = tr_read<v_rd_off(D0, 1, 1)>(vb);
  const s16x4 l2 = tr_read<v_rd_off(D0, 2, 0)>(vb), h2 = tr_read<v_rd_off(D0, 2, 1)>(vb), l3 = tr_read<v_rd_off(D0, 3, 0)>(vb), h3 = tr_read<v_rd_off(D0, 3, 1)>(vb);
  asm volatile("s_waitcnt lgkmcnt(0)" ::: "memory"); SBAR();
#define PK(L, H) (bf16x8){L[0], L[1], L[2], L[3], H[0], H[1], H[2], H[3]}
  od = __builtin_amdgcn_mfma_f32_32x32x16_bf16(PK(l0, h0), pa0, od, 0, 0, 0);
  od = __builtin_amdgcn_mfma_f32_32x32x16_bf16(PK(l1, h1), pa1, od, 0, 0, 0);
  od = __builtin_amdgcn_mfma_f32_32x32x16_bf16(PK(l2, h2), pa2, od, 0, 0, 0);
  od = __builtin_amdgcn_mfma_f32_32x32x16_bf16(PK(l3, h3), pa3, od, 0, 0, 0);
#undef PK
}
__device__ __forceinline__ void pv_d0(f32x16* o, int vb, bf16x8 pa0, bf16x8 pa1, bf16x8 pa2, bf16x8 pa3) {
  pv_one<0>(o[0], vb, pa0, pa1, pa2, pa3); pv_one<1>(o[1], vb, pa0, pa1, pa2, pa3);
}
__device__ __forceinline__ void glds16(const void* gsrc, unsigned lds_dst) { unsigned keep;
  asm volatile("s_mov_b32 %0, m0\n\ts_mov_b32 m0, %2\n\ts_nop 0\n\tglobal_load_lds_dwordx4 %1, off\n\ts_mov_b32 m0, %0" : "=&s"(keep) : "v"(gsrc), "s"(lds_dst) : "memory"); }
struct VFrag { s16x4 l[4], h[4]; };
template <int D0> __device__ __forceinline__ void v_read(VFrag& f, int vb) {
  f.l[0] = tr_read<v_rd_off(D0, 0, 0)>(vb); f.h[0] = tr_read<v_rd_off(D0, 0, 1)>(vb); f.l[1] = tr_read<v_rd_off(D0, 1, 0)>(vb); f.h[1] = tr_read<v_rd_off(D0, 1, 1)>(vb);
  f.l[2] = tr_read<v_rd_off(D0, 2, 0)>(vb); f.h[2] = tr_read<v_rd_off(D0, 2, 1)>(vb); f.l[3] = tr_read<v_rd_off(D0, 3, 0)>(vb); f.h[3] = tr_read<v_rd_off(D0, 3, 1)>(vb);
}
__device__ __forceinline__ void pv_blk(f32x16& od, const VFrag& f, bf16x8 pa0, bf16x8 pa1, bf16x8 pa2, bf16x8 pa3) {
#define PK(L, H) (bf16x8){L[0], L[1], L[2], L[3], H[0], H[1], H[2], H[3]}
  od = __builtin_amdgcn_mfma_f32_32x32x16_bf16(PK(f.l[0], f.h[0]), pa0, od, 0, 0, 0);
  od = __builtin_amdgcn_mfma_f32_32x32x16_bf16(PK(f.l[1], f.h[1]), pa1, od, 0, 0, 0);
  od = __builtin_amdgcn_mfma_f32_32x32x16_bf16(PK(f.l[2], f.h[2]), pa2, od, 0, 0, 0);
  od = __builtin_amdgcn_mfma_f32_32x32x16_bf16(PK(f.l[3], f.h[3]), pa3, od, 0, 0, 0);
#undef PK
}
constexpr int NSLOT = 3;
constexpr int RK = 0, RV = NSLOT * SHM_K, ROST = RV + NSLOT * SHM_V, SHM_ATTN2 = ROST + NW * OST_W;
template <int ABL = 0> __device__ __forceinline__ void attn_unit(const bf16_t* __restrict__ Qb, const bf16_t* __restrict__ Kh, const bf16_t* __restrict__ Vh, bf16_t* __restrict__ Ob, int ldo, int seq, char* lds) {
  const int tid = threadIdx.x, lane = tid & 63, r32 = lane & 31, hi = lane >> 5; const int wid = __builtin_amdgcn_readfirstlane(tid >> 6);
  const unsigned lds0 = (unsigned)(uintptr_t)lds;
  float mref = 0.f, l_reg = 0.f; f32x16 o[2] = {}; bf16x8 qr[6];
  const int krow = 4 * wid + (lane >> 4), kch = (lane & 15) ^ (krow & 15);
  const bf16_t* ksrc = Kh + (long)krow * DQK + (kch < 12 ? kch * 8 : 0);
  const bf16_t* vsrc = Vh + (long)(8 * wid + ((lane & 31) >> 2)) * DV + 32 * (lane >> 5) + 8 * (lane & 3);
  const unsigned kdst = lds0 + RK + wid * 1024, vdst = lds0 + RV + wid * 1024;
#define DMA_K(t, slot) do { if constexpr (ABL & 8) break; glds16(ksrc + (long)(t) * KVBLK * DQK, (unsigned)__builtin_amdgcn_readfirstlane(kdst + (slot) * SHM_K)); \
                            glds16(ksrc + (long)(t) * KVBLK * DQK + 32 * DQK, (unsigned)__builtin_amdgcn_readfirstlane(kdst + (slot) * SHM_K + 8192)); } while (0)
#define DMA_V(t, slot) do { if constexpr (!(ABL & 8)) glds16(vsrc + (long)(t) * KVBLK * DV, (unsigned)__builtin_amdgcn_readfirstlane(vdst + (slot) * SHM_V)); } while (0)
#define WAIT_BAR(N) asm volatile("s_waitcnt vmcnt(" #N ") lgkmcnt(0)\n\ts_barrier" ::: "memory")
  const int NT = seq / KVBLK;
  const bf16_t* Qw = Qb + (long)(wid * QBLK + r32) * DQK + hi * 8;
#pragma unroll
  for (int d0 = 0; d0 < 6; ++d0) qr[d0] = ld8(Qw + d0 * 16);
  asm volatile("" ::: "memory");
  DMA_K(0, 0); DMA_K(1, 1); DMA_V(0, 0);
  const int vb0 = (int)(lds0 + RV) + v_rd_base(lane);
#define RESC(a) do { if (__any((a) < 1.f)) { _Pragma("unroll") for (int d = 0; d < 2; ++d) _Pragma("unroll") for (int r = 0; r < 16; ++r) o[d][r] *= (a); } } while (0)
  f32x16 pA0, pA1, pB0, pB1; float alA, alB; bf16x8 pa0, pa1, pa2, pa3; VFrag vf, vg;
  int ks = 0, vs = 0;
#define ROTK() do { ks = (ks == NSLOT - 1) ? 0 : ks + 1; } while (0)
#define ROTV() do { vs = (vs == NSLOT - 1) ? 0 : vs + 1; } while (0)
#define TOP(t) do { if ((t) + 1 < NT) { WAIT_BAR(3); } else { WAIT_BAR(0); } \
    if ((t) + 2 < NT) { int kn = ks + 2; kn = kn >= NSLOT ? kn - NSLOT : kn; DMA_K((t) + 2, kn); } \
    if ((t) + 1 < NT) { int vn = vs + 2; vn = vn >= NSLOT ? vn - NSLOT : vn; DMA_V((t) + 1, vn); } SBAR(); } while (0)
#define C_QK(PC0, PC1) do { qkt<ABL>(PC0, PC1, lds + RK + ks * SHM_K, qr, r32, hi); SBAR(); } while (0)
#define C_FIN(PP0, PP1, ALP) do { v_read<0>(vf, vb0 + vs * SHM_V); finishSM<ABL>(PP0, PP1, ALP, l_reg, pa0, pa1, pa2, pa3); SBAR(); } while (0)
#define C_PV() do { asm volatile("s_waitcnt lgkmcnt(0)" ::: "memory"); SBAR(); v_read<1>(vg, vb0 + vs * SHM_V); SBAR(); \
    if constexpr (!(ABL & 2)) pv_blk(o[0], vf, pa0, pa1, pa2, pa3); else { asm volatile("" :: "v"(vf.l[0]), "v"(vf.h[3]), "v"(pa0), "v"(pa3)); } \
    asm volatile("s_waitcnt lgkmcnt(0)" ::: "memory"); SBAR(); \
    if constexpr (!(ABL & 2)) pv_blk(o[1], vg, pa0, pa1, pa2, pa3); else { asm volatile("" :: "v"(vg.l[0]), "v"(vg.h[3])); } SBAR(); } while (0)
#define C_PAR(FIRST_, PC0, PC1, ALC) do { partialSM<FIRST_, ABL>(PC0, PC1, mref, ALC); RESC(ALC); SBAR(); } while (0)
  if (wid < 4) {
    WAIT_BAR(3); DMA_K(2, 2); DMA_V(1, 1); SBAR(); C_QK(pA0, pA1); C_PAR(true, pA0, pA1, alA); ROTK();
    int t = 1;
    for (; t + 1 < NT; t += 2) {
      TOP(t);     C_QK(pB0, pB1); C_FIN(pA0, pA1, alA); C_PV(); C_PAR(false, pB0, pB1, alB); ROTK(); ROTV();
      TOP(t + 1); C_QK(pA0, pA1); C_FIN(pB0, pB1, alB); C_PV(); C_PAR(false, pA0, pA1, alA); ROTK(); ROTV();
    }
    TOP(NT - 1);  C_QK(pB0, pB1); C_FIN(pA0, pA1, alA); C_PV(); C_PAR(false, pB0, pB1, alB); ROTK(); ROTV();
    WAIT_BAR(0);
    C_FIN(pB0, pB1, alB); C_PV();
  } else {
    WAIT_BAR(3); DMA_K(2, 2); DMA_V(1, 1); SBAR(); C_QK(pA0, pA1); ROTK();
    TOP(1); C_PAR(true, pA0, pA1, alA); C_QK(pB0, pB1); C_FIN(pA0, pA1, alA); C_PV(); ROTK(); ROTV();
    int t = 2;
    for (; t + 1 < NT; t += 2) {
      TOP(t);     C_PAR(false, pB0, pB1, alB); C_QK(pA0, pA1); C_FIN(pB0, pB1, alB); C_PV(); ROTK(); ROTV();
      TOP(t + 1); C_PAR(false, pA0, pA1, alA); C_QK(pB0, pB1); C_FIN(pA0, pA1, alA); C_PV(); ROTK(); ROTV();
    }
    WAIT_BAR(0);
    C_PAR(false, pB0, pB1, alB); C_FIN(pB0, pB1, alB); C_PV();
  }
#undef TOP
#undef C_QK
#undef C_FIN
#undef C_PV
#undef C_PAR
  { auto rr = __builtin_amdgcn_permlane32_swap(__float_as_uint(l_reg), __float_as_uint(l_reg), false, false); l_reg = __uint_as_float(rr[0]) + __uint_as_float(rr[1]); }
  const float rl = __builtin_amdgcn_rcpf(l_reg);
  bf16_t* Ow = Ob + (long)(wid * QBLK) * ldo;
  { char* stg = lds + ROST + wid * OST_W;
#pragma unroll
    for (int d0 = 0; d0 < 2; ++d0)
#pragma unroll
      for (int g = 0; g < 4; ++g) { uint2 w; w.x = cvtpk(o[d0][4 * g] * rl, o[d0][4 * g + 1] * rl); w.y = cvtpk(o[d0][4 * g + 2] * rl, o[d0][4 * g + 3] * rl);
        *(uint2*)(stg + r32 * 144 + (32 * d0 + 8 * g + 4 * hi) * 2) = w; }
    asm volatile("s_waitcnt lgkmcnt(0)" ::: "memory");
#pragma unroll
    for (int i = 0; i < 4; ++i) { const int row = i * 8 + (lane >> 3), ch = lane & 7; const u32x4 v = *(const u32x4*)(stg + row * 144 + ch * 16); *(u32x4*)(Ow + (long)row * ldo + ch * 8) = v; } }
  asm volatile("s_waitcnt vmcnt(0) lgkmcnt(0)\n\ts_barrier" ::: "memory");
#undef DMA_K
#undef DMA_V
#undef WAIT_BAR
#undef RESC
#undef ROTK
#undef ROTV
}
template <bool NOMAX> __device__ __forceinline__ void softmax_blk(f32x16& p0, f32x16& p1, bool first, float& mref, float& l_reg, f32x16* o, bf16x8& pa0, bf16x8& pa1, bf16x8& pa2, bf16x8& pa3) {
  if constexpr (!NOMAX) {
  float a = max3(p0[0], p0[1], p0[2]), b = max3(p1[0], p1[1], p1[2]);
#pragma unroll
  for (int r = 3; r < 15; r += 2) { a = max3(a, p0[r], p0[r + 1]); b = max3(b, p1[r], p1[r + 1]); }
  float pmax = max3(a, b, fmaxf(p0[15], p1[15]));
  { auto rr = __builtin_amdgcn_permlane32_swap(__float_as_uint(pmax), __float_as_uint(pmax), false, false);
    pmax = fmaxf(__uint_as_float(rr[0]), __uint_as_float(rr[1])); }
  pmax -= mref;
  if (!__builtin_expect(__all(first ? (fabsf(pmax) <= THRL) : (pmax <= THRL)), 1)) {
    const float dl = first ? pmax : fmaxf(pmax, 0.f); mref += dl; const float alpha = __builtin_amdgcn_exp2f(-dl); l_reg *= alpha;
#pragma unroll
    for (int d = 0; d < 2; ++d)
#pragma unroll
      for (int r = 0; r < 16; ++r) o[d][r] *= alpha; }
  if (__any(mref != 0.f)) {
#pragma unroll
    for (int r = 0; r < 16; ++r) { p0[r] -= mref; p1[r] -= mref; } }
  }
#pragma unroll
  for (int r = 0; r < 16; ++r) { p0[r] = __builtin_amdgcn_exp2f(p0[r]); p1[r] = __builtin_amdgcn_exp2f(p1[r]); }
  float ps0 = 0.f, ps1 = 0.f;
#pragma unroll
  for (int r = 0; r < 16; ++r) { ps0 += p0[r]; ps1 += p1[r]; }
  l_reg += ps0 + ps1;
#define PK8(P, BASE, OUT) do { u32x4 w = {cvtpk(P[BASE + 0], P[BASE + 1]), cvtpk(P[BASE + 2], P[BASE + 3]), cvtpk(P[BASE + 4], P[BASE + 5]), cvtpk(P[BASE + 6], P[BASE + 7])}; \
    OUT = *reinterpret_cast<bf16x8*>(&w); } while (0)
  PK8(p0, 0, pa0); PK8(p0, 8, pa1); PK8(p1, 0, pa2); PK8(p1, 8, pa3);
#undef PK8
}
constexpr int NSV = 4;
constexpr int QB_W = 32 * 208;
constexpr int R2K = 0, R2V = NSLOT * SHM_K, R2Q = R2V + NSV * SHM_V, R2OST = R2K, SHM_ATTN3 = R2Q + NW * QB_W;
template <bool NOMAX> __device__ __forceinline__ void attn_unit64(const bf16_t* __restrict__ Qb, const bf16_t* __restrict__ Kh, const bf16_t* __restrict__ Vh, bf16_t* __restrict__ Ob, int ldo, int seq, char* lds) {
  const int tid = threadIdx.x, lane = tid & 63, r32 = lane & 31, hi = lane >> 5; const int wid = __builtin_amdgcn_readfirstlane(tid >> 6);
  const unsigned lds0 = (unsigned)(uintptr_t)lds;
  float mrefa = 0.f, la = 0.f, mrefb = 0.f, lb = 0.f; f32x16 oa[2] = {}, ob[2] = {}; bf16x8 qa[6];
  const int krow = 4 * wid + (lane >> 4), kch = (lane & 15) ^ (krow & 15);
  const bf16_t* ksrc = Kh + (long)krow * DQK + (kch < 12 ? kch * 8 : 0);
  const bf16_t* vsrc = Vh + (long)(8 * wid + ((lane & 31) >> 2)) * DV + 32 * (lane >> 5) + 8 * (lane & 3);
  const unsigned kdst = lds0 + R2K + wid * 1024, vdst = lds0 + R2V + wid * 1024;
#define DMA_K(t, slot) do { glds16(ksrc + (long)(t) * KVBLK * DQK, (unsigned)__builtin_amdgcn_readfirstlane(kdst + (slot) * SHM_K)); \
                            glds16(ksrc + (long)(t) * KVBLK * DQK + 32 * DQK, (unsigned)__builtin_amdgcn_readfirstlane(kdst + (slot) * SHM_K + 8192)); } while (0)
#define DMA_V(t, slot) glds16(vsrc + (long)(t) * KVBLK * DV, (unsigned)__builtin_amdgcn_readfirstlane(vdst + (slot) * SHM_V))
#define WAIT_BAR(N) asm volatile("s_waitcnt vmcnt(" #N ") lgkmcnt(0)\n\ts_barrier" ::: "memory")
  const int NT = seq / KVBLK;
  const bf16_t* Qw = Qb + (long)(wid * 64 + r32) * DQK + hi * 8;
  DMA_K(0, 0); DMA_V(0, 0); DMA_K(1, 1); DMA_V(1, 1);
  char* qbl = lds + R2Q + wid * QB_W + r32 * 208 + hi * 16;
  { bf16x8 qt[6];
#pragma unroll
    for (int d0 = 0; d0 < 6; ++d0) qt[d0] = ld8(Qw + 32 * DQK + d0 * 16);
#pragma unroll
    for (int d0 = 0; d0 < 6; ++d0) qa[d0] = ld8(Qw + d0 * 16);
#pragma unroll
    for (int d0 = 0; d0 < 6; ++d0) *(bf16x8*)(qbl + d0 * 32) = qt[d0]; }
  asm volatile("s_waitcnt vmcnt(0) lgkmcnt(0)" ::: "memory");
  const int vb0 = (int)(lds0 + R2V) + v_rd_base(lane);
  int ks = 0, vs = 0;
#define PK(L, H) (bf16x8){L[0], L[1], L[2], L[3], H[0], H[1], H[2], H[3]}
#define C_QK() do { pa0s = f32x16{}; pa1s = f32x16{}; pb0s = f32x16{}; pb1s = f32x16{}; const char* Ks = lds + R2K + ks * SHM_K; \
      _Pragma("unroll") for (int d0 = 0; d0 < 6; ++d0) { const int cb = (d0 * 16 + hi * 8) * 2; \
        const bf16x8 k0 = *reinterpret_cast<const bf16x8*>(Ks + KSWZ(r32, cb)), k1 = *reinterpret_cast<const bf16x8*>(Ks + KSWZ(32 + r32, cb)); \
        const bf16x8 qbf = *reinterpret_cast<const bf16x8*>(qbl + d0 * 32); \
        pa0s = __builtin_amdgcn_mfma_f32_32x32x16_bf16(k0, qa[d0], pa0s, 0, 0, 0); pb0s = __builtin_amdgcn_mfma_f32_32x32x16_bf16(k0, qbf, pb0s, 0, 0, 0); \
        pa1s = __builtin_amdgcn_mfma_f32_32x32x16_bf16(k1, qa[d0], pa1s, 0, 0, 0); pb1s = __builtin_amdgcn_mfma_f32_32x32x16_bf16(k1, qbf, pb1s, 0, 0, 0); } SBAR(); } while (0)
#define C_SM(first_) do { softmax_blk<NOMAX>(pa0s, pa1s, first_, mrefa, la, oa, a0, a1, a2, a3); softmax_blk<NOMAX>(pb0s, pb1s, first_, mrefb, lb, ob, b0, b1, b2, b3); SBAR(); } while (0)
#define C_PV(vslot) do { const int vb = vb0 + (vslot) * SHM_V; VFrag vf, vg; \
      v_read<0>(vf, vb); asm volatile("s_waitcnt lgkmcnt(0)" ::: "memory"); SBAR(); v_read<1>(vg, vb); SBAR(); \
      oa[0] = __builtin_amdgcn_mfma_f32_32x32x16_bf16(PK(vf.l[0], vf.h[0]), a0, oa[0], 0, 0, 0); ob[0] = __builtin_amdgcn_mfma_f32_32x32x16_bf16(PK(vf.l[0], vf.h[0]), b0, ob[0], 0, 0, 0); \
      oa[0] = __builtin_amdgcn_mfma_f32_32x32x16_bf16(PK(vf.l[1], vf.h[1]), a1, oa[0], 0, 0, 0); ob[0] = __builtin_amdgcn_mfma_f32_32x32x16_bf16(PK(vf.l[1], vf.h[1]), b1, ob[0], 0, 0, 0); \
      oa[0] = __builtin_amdgcn_mfma_f32_32x32x16_bf16(PK(vf.l[2], vf.h[2]), a2, oa[0], 0, 0, 0); ob[0] = __builtin_amdgcn_mfma_f32_32x32x16_bf16(PK(vf.l[2], vf.h[2]), b2, ob[0], 0, 0, 0); \
      oa[0] = __builtin_amdgcn_mfma_f32_32x32x16_bf16(PK(vf.l[3], vf.h[3]), a3, oa[0], 0, 0, 0); ob[0] = __builtin_amdgcn_mfma_f32_32x32x16_bf16(PK(vf.l[3], vf.h[3]), b3, ob[0], 0, 0, 0); \
      asm volatile("s_waitcnt lgkmcnt(0)" ::: "memory"); SBAR(); \
      oa[1] = __builtin_amdgcn_mfma_f32_32x32x16_bf16(PK(vg.l[0], vg.h[0]), a0, oa[1], 0, 0, 0); ob[1] = __builtin_amdgcn_mfma_f32_32x32x16_bf16(PK(vg.l[0], vg.h[0]), b0, ob[1], 0, 0, 0); \
      oa[1] = __builtin_amdgcn_mfma_f32_32x32x16_bf16(PK(vg.l[1], vg.h[1]), a1, oa[1], 0, 0, 0); ob[1] = __builtin_amdgcn_mfma_f32_32x32x16_bf16(PK(vg.l[1], vg.h[1]), b1, ob[1], 0, 0, 0); \
      oa[1] = __builtin_amdgcn_mfma_f32_32x32x16_bf16(PK(vg.l[2], vg.h[2]), a2, oa[1], 0, 0, 0); ob[1] = __builtin_amdgcn_mfma_f32_32x32x16_bf16(PK(vg.l[2], vg.h[2]), b2, ob[1], 0, 0, 0); \
      oa[1] = __builtin_amdgcn_mfma_f32_32x32x16_bf16(PK(vg.l[3], vg.h[3]), a3, oa[1], 0, 0, 0); ob[1] = __builtin_amdgcn_mfma_f32_32x32x16_bf16(PK(vg.l[3], vg.h[3]), b3, ob[1], 0, 0, 0); SBAR(); } while (0)
#define TOP(t) do { if ((t) + 1 < NT) { WAIT_BAR(3); } else { WAIT_BAR(0); } \
    if ((t) + 2 < NT) { int kn = ks + 2; kn = kn >= NSLOT ? kn - NSLOT : kn; int vn = vs + 2; vn = vn >= NSV ? vn - NSV : vn; DMA_K((t) + 2, kn); DMA_V((t) + 2, vn); } SBAR(); } while (0)
#define ROT() do { ks = (ks == NSLOT - 1) ? 0 : ks + 1; vs = (vs == NSV - 1) ? 0 : vs + 1; } while (0)
#define ATT_LOOP(late) do { \
    f32x16 pa0s, pa1s, pb0s, pb1s; bf16x8 a0 = {}, a1 = {}, a2 = {}, a3 = {}, b0 = {}, b1 = {}, b2 = {}, b3 = {}; \
    for (int t = 0; t < NT; ++t) { \
      TOP(t); \
      if (late && t > 0) C_PV(vs == 0 ? NSV - 1 : vs - 1); \
      C_QK(); C_SM(t == 0); \
      if (!late) C_PV(vs); \
      ROT(); \
    } \
    if (late) C_PV(vs == 0 ? NSV - 1 : vs - 1); } while (0)
  if constexpr (NOMAX) {
    f32x16 pa0s, pa1s, pb0s, pb1s; unsigned wa0[8], wb0[8], wa1[8], wb1[8];
#define HC(P, i, S, W) do { P[(i) & 15] = __builtin_amdgcn_exp2f(P[(i) & 15]); P[((i) + 1) & 15] = __builtin_amdgcn_exp2f(P[((i) + 1) & 15]); S += P[(i) & 15]; S += P[((i) + 1) & 15]; \
                            W = cvtpk_n(P[(i) & 15], P[((i) + 1) & 15]); } while (0)
#define HC0(h) do { if ((h) < 8) HC(pa0s, 2 * (h), la, wa0[(h) & 7]); else HC(pb0s, 2 * ((h) - 8), lb, wb0[(h) & 7]); } while (0)
#define MK8(W, o) __builtin_bit_cast(bf16x8, (u32x4){W[(o)], W[(o) + 1], W[(o) + 2], W[(o) + 3]})
#define LDSK(row, d) (*reinterpret_cast<const bf16x8*>(Ks + KSWZ((row), ((d) * 16 + hi * 8) * 2)))
#define LDSQ(d) (*reinterpret_cast<const bf16x8*>(qbl + (d) * 32))
#define MF(A, B, C) C = __builtin_amdgcn_mfma_f32_32x32x16_bf16(A, B, C, 0, 0, 0)
    VFrag vf, vg; bf16x8 kcarry, qcarry;
#define VRD(J, VB) do { vf.l[J] = tr_read<v_rd_off(0, J, 0)>(VB); vf.h[J] = tr_read<v_rd_off(0, J, 1)>(VB); vg.l[J] = tr_read<v_rd_off(1, J, 0)>(VB); vg.h[J] = tr_read<v_rd_off(1, J, 1)>(VB); } while (0)
#define HCB(k) HC(pb1s, 2 * (k), lb, wb1[(k) & 7])
#define STA(PREV) do { pa0s = f32x16{}; pb0s = f32x16{}; bf16x8 kc = LDSK(r32, 0), qc = LDSQ(0); \
      _Pragma("unroll") for (int d0 = 0; d0 < 6; ++d0) { bf16x8 kn, qn; if (d0 < 5) { kn = LDSK(r32, d0 + 1); qn = LDSQ(d0 + 1); } else { kn = LDSK(32 + r32, 0); qn = LDSQ(0); } \
        MF(kc, qa[d0], pa0s); if (PREV && d0 < 4) HCB(2 * d0); SBAR(); MF(kc, qc, pb0s); if (PREV && d0 < 4) HCB(2 * d0 + 1); SBAR(); kc = kn; qc = qn; } kcarry = kc; qcarry = qc; } while (0)
#define STB() do { const bf16x8 b2 = MK8(wb1, 0), b3 = MK8(wb1, 4); \
      MF(PK(vf.l[2], vf.h[2]), b2, ob[0]); HC0(0); SBAR(); MF(PK(vg.l[2], vg.h[2]), b2, ob[1]); HC0(1); SBAR(); \
      MF(PK(vf.l[3], vf.h[3]), b3, ob[0]); HC0(2); SBAR(); MF(PK(vg.l[3], vg.h[3]), b3, ob[1]); HC0(3); SBAR(); } while (0)
#define STC(VB) do { pa1s = f32x16{}; pb1s = f32x16{}; bf16x8 kc = kcarry, qc = qcarry; \
      _Pragma("unroll") for (int d0 = 0; d0 < 6; ++d0) { bf16x8 kn = kc, qn = qc; if (d0 < 5) { kn = LDSK(32 + r32, d0 + 1); qn = LDSQ(d0 + 1); } else { VRD(0, VB); VRD(1, VB); } \
        MF(kc, qa[d0], pa1s); HC0(4 + 2 * d0); SBAR(); MF(kc, qc, pb1s); HC0(5 + 2 * d0); SBAR(); kc = kn; qc = qn; } } while (0)
#define STD(VB) do { const bf16x8 a0 = MK8(wa0, 0), a1 = MK8(wa0, 4), b0 = MK8(wb0, 0), b1 = MK8(wb0, 4); \
      asm volatile("s_waitcnt lgkmcnt(0)" ::: "memory"); SBAR(); \
      MF(PK(vf.l[0], vf.h[0]), a0, oa[0]); HC(pa1s, 0, la, wa1[0]); SBAR(); \
      MF(PK(vf.l[0], vf.h[0]), b0, ob[0]); HC(pa1s, 2, la, wa1[1]); SBAR(); \
      MF(PK(vg.l[0], vg.h[0]), a0, oa[1]); HC(pa1s, 4, la, wa1[2]); SBAR(); \
      MF(PK(vg.l[0], vg.h[0]), b0, ob[1]); HC(pa1s, 6, la, wa1[3]); VRD(2, VB); VRD(3, VB); SBAR();        \
      MF(PK(vf.l[1], vf.h[1]), a1, oa[0]); HC(pa1s, 8, la, wa1[4]); SBAR(); \
      MF(PK(vf.l[1], vf.h[1]), b1, ob[0]); HC(pa1s, 10, la, wa1[5]); SBAR(); \
      MF(PK(vg.l[1], vg.h[1]), a1, oa[1]); HC(pa1s, 12, la, wa1[6]); SBAR(); \
      MF(PK(vg.l[1], vg.h[1]), b1, ob[1]); HC(pa1s, 14, la, wa1[7]); SBAR(); } while (0)
#define STE() do { const bf16x8 a2 = MK8(wa1, 0), a3 = MK8(wa1, 4); asm volatile("s_waitcnt lgkmcnt(0)" ::: "memory"); SBAR(); \
      MF(PK(vf.l[2], vf.h[2]), a2, oa[0]); MF(PK(vg.l[2], vg.h[2]), a2, oa[1]); MF(PK(vf.l[3], vf.h[3]), a3, oa[0]); MF(PK(vg.l[3], vg.h[3]), a3, oa[1]); SBAR(); } while (0)
    {
      TOP(0);
      const char* Ks = lds + R2K + ks * SHM_K; const int vb = vb0 + vs * SHM_V;
      STA(false); HC0(0); HC0(1); HC0(2); HC0(3); SBAR(); STC(vb); STD(vb); STE();
      ROT();
    }
    for (int t = 1; t < NT; ++t) {
      TOP(t);
      const char* Ks = lds + R2K + ks * SHM_K; const int vb = vb0 + vs * SHM_V;
      STA(true); STB(); STC(vb); STD(vb); STE();
      ROT();
    }
    {
#pragma unroll
      for (int k = 0; k < 8; ++k) HCB(k);
      const bf16x8 b2 = MK8(wb1, 0), b3 = MK8(wb1, 4);
      MF(PK(vf.l[2], vf.h[2]), b2, ob[0]); MF(PK(vg.l[2], vg.h[2]), b2, ob[1]); MF(PK(vf.l[3], vf.h[3]), b3, ob[0]); MF(PK(vg.l[3], vg.h[3]), b3, ob[1]); }
#undef VRD
#undef HCB
#undef STA
#undef STB
#undef STC
#undef STD
#undef STE
#undef HC
#undef HC0
#undef MK8
#undef LDSK
#undef LDSQ
#undef MF
  } else {
    if (wid < 4) { ATT_LOOP(false); } else { ATT_LOOP(true); }
  }
#undef ATT_LOOP
  WAIT_BAR(0);
#undef PK
#undef C_QK
#undef C_SM
#undef C_PV
#undef TOP
#undef ROT
  char* stg = lds + R2OST + wid * OST_W;
#pragma unroll
  for (int blk = 0; blk < 2; ++blk) {
    float l_reg = blk ? lb : la; f32x16* o = blk ? ob : oa;
    { auto rr = __builtin_amdgcn_permlane32_swap(__float_as_uint(l_reg), __float_as_uint(l_reg), false, false); l_reg = __uint_as_float(rr[0]) + __uint_as_float(rr[1]); }
    const float rl = __builtin_amdgcn_rcpf(l_reg);
    bf16_t* Ow = Ob + (long)(wid * 64 + blk * 32) * ldo;
#pragma unroll
    for (int d0 = 0; d0 < 2; ++d0)
#pragma unroll
      for (int g = 0; g < 4; ++g) { uint2 w; w.x = cvtpk(o[d0][4 * g] * rl, o[d0][4 * g + 1] * rl); w.y = cvtpk(o[d0][4 * g + 2] * rl, o[d0][4 * g + 3] * rl);
        *(uint2*)(stg + r32 * 144 + (32 * d0 + 8 * g + 4 * hi) * 2) = w; }
    asm volatile("s_waitcnt lgkmcnt(0)" ::: "memory");
#pragma unroll
    for (int i = 0; i < 4; ++i) { const int row = i * 8 + (lane >> 3), ch = lane & 7; const u32x4 v = *(const u32x4*)(stg + row * 144 + ch * 16); *(u32x4*)(Ow + (long)row * ldo + ch * 8) = v; }
    asm volatile("s_waitcnt lgkmcnt(0)" ::: "memory");
  }
  asm volatile("s_waitcnt vmcnt(0) lgkmcnt(0)\n\ts_barrier" ::: "memory");
#undef DMA_K
#undef DMA_V
#undef WAIT_BAR
}
#undef KSWZ
#undef SBAR
}

#define GAS __attribute__((address_space(1)))
#define LAS __attribute__((address_space(3)))
typedef unsigned short bf16;
typedef unsigned v4u __attribute__((ext_vector_type(4)));
typedef float f32x4 __attribute__((ext_vector_type(4)));
typedef short bf16x8 __attribute__((ext_vector_type(8)));
typedef GAS unsigned gu32;
typedef GAS unsigned long long gu64;
#define RLX_AGENT __ATOMIC_RELAXED, __HIP_MEMORY_SCOPE_AGENT
#define LDS_WAIT() asm volatile("s_waitcnt lgkmcnt(0)" ::: "memory")
#define VM_WAIT() asm volatile("s_waitcnt vmcnt(0)" ::: "memory")
__device__ __forceinline__ unsigned long long rt() { return __builtin_amdgcn_s_memrealtime(); }
__device__ __forceinline__ unsigned f2bf(float f) { unsigned u = __builtin_bit_cast(unsigned, f); return (u + 0x7fffu + ((u >> 16) & 1u)) >> 16; }
__device__ __forceinline__ unsigned pk2(float lo, float hi) { return f2bf(lo) | (f2bf(hi) << 16); }

#define XB_TMO      128
#define XB_XCNT(j)  (256  + 64 * (j))
#define XB_XSUB(j)  (1280 + 64 * (j))
#define XB_XGEN(j)  (2304 + 64 * (j))
#define XB_TOP      3328
#define XB_TOPGEN   3392
#define XB_LSUB(j)  (3456 + 64 * (j))
#define XB_LGEN(j)  (4480 + 64 * (j))
#define XCD_BAR_WORDS 5504
#define XB_SPIN_CAP (1u << 18)

__device__ __forceinline__ unsigned xb_ld(unsigned* p)              { return __hip_atomic_load(p, __ATOMIC_RELAXED, __HIP_MEMORY_SCOPE_AGENT); }
__device__ __forceinline__ unsigned xb_add(unsigned* p, unsigned v) { return __hip_atomic_fetch_add(p, v, __ATOMIC_RELAXED, __HIP_MEMORY_SCOPE_AGENT); }
__device__ __forceinline__ unsigned xb_xcc_id() { return (unsigned)__builtin_amdgcn_s_getreg((3 << 11) | 20) & 0xFu; }
#define XB_SPIN(cond, bar) do { unsigned _sp = 0; while (cond) { __builtin_amdgcn_s_sleep(1); \
    if ((++_sp & 255u) == 0u) { if (xb_ld(&(bar)[XB_TMO])) break; if (_sp > XB_SPIN_CAP) { atomicAdd(&(bar)[XB_TMO], 1u); break; } } } } while (0)

struct XcdBarrier {
    unsigned* bar; unsigned x;
    volatile LAS unsigned* st;
};

__device__ __forceinline__ XcdBarrier xcd_barrier_post(unsigned* bar, volatile LAS unsigned* st) {
    XcdBarrier b; b.bar = bar; b.x = xb_xcc_id(); b.st = st;
    if (threadIdx.x == 0) (void)xb_add(&bar[XB_XCNT(b.x)], 1u);
    return b;
}
__device__ __forceinline__ void xcd_barrier_complete(unsigned* bar, unsigned x, unsigned& nloc, unsigned& nx) {
    const unsigned G = gridDim.x * gridDim.y * gridDim.z;
    unsigned sum, cnt, mine, sp = 0u;
    for (;;) {
        sum = 0u; cnt = 0u; mine = 0u;
#pragma unroll
        for (unsigned j = 0; j < 16; ++j) { const unsigned c = xb_ld(&bar[XB_XCNT(j)]); sum += c; cnt += (c > 0u) ? 1u : 0u; mine = (j == x) ? c : mine; }
        if (sum == G) break;
        __builtin_amdgcn_s_sleep(1);
        if ((++sp & 255u) == 0u) { if (xb_ld(&bar[XB_TMO])) break; if (sp > XB_SPIN_CAP) { atomicAdd(&bar[XB_TMO], 1u); break; } }
    }
    nloc = mine > 0u ? mine : 1u; nx = cnt > 0u ? cnt : 1u;
}

__device__ __forceinline__ void xcd_barrier(const XcdBarrier& b) {
    asm volatile("s_waitcnt vmcnt(0)" ::: "memory");
    __syncthreads();
    if (threadIdx.x == 0) {
        unsigned* bar = b.bar;
        __builtin_amdgcn_s_waitcnt(0);
        unsigned nloc = b.st[0], nx = b.st[1];
        if (nloc == 0u) { xcd_barrier_complete(bar, b.x, nloc, nx); b.st[0] = nloc; b.st[1] = nx; }
        const unsigned old = xb_add(&bar[XB_XSUB(b.x)], 1u);
        const unsigned gen = old / nloc;
        if (old + 1u == (gen + 1u) * nloc) {
            __builtin_amdgcn_fence(__ATOMIC_RELEASE, "agent");
            asm volatile("s_waitcnt vmcnt(0)" ::: "memory");
            const unsigned og = xb_add(&bar[XB_TOP], 1u);
            const unsigned tg = og / nx;
            if (og + 1u == (tg + 1u) * nx) xb_add(&bar[XB_TOPGEN], 1u);
            else XB_SPIN(xb_ld(&bar[XB_TOPGEN]) == tg, bar);
            __builtin_amdgcn_fence(__ATOMIC_ACQUIRE, "agent");
            xb_add(&bar[XB_XGEN(b.x)], 1u);
            asm volatile("s_waitcnt vmcnt(0)" ::: "memory");
        } else {
            XB_SPIN(xb_ld(&bar[XB_XGEN(b.x)]) == gen, bar);
            __builtin_amdgcn_fence(__ATOMIC_ACQUIRE, "agent");
            asm volatile("s_waitcnt vmcnt(0)" ::: "memory");
        }
    }
    __syncthreads();
}

__device__ __forceinline__ void xcd_local_barrier(const XcdBarrier& b) {
    asm volatile("s_waitcnt vmcnt(0)" ::: "memory");
    __syncthreads();
    if (threadIdx.x == 0) {
        unsigned* bar = b.bar;
        __builtin_amdgcn_s_waitcnt(0);
        const unsigned nloc = b.st[0];
        const unsigned old = xb_add(&bar[XB_LSUB(b.x)], 1u);
        const unsigned gen = old / nloc;
        if (old + 1u == (gen + 1u) * nloc) xb_add(&bar[XB_LGEN(b.x)], 1u);
        else XB_SPIN(xb_ld(&bar[XB_LGEN(b.x)]) == gen, bar);
        __builtin_amdgcn_fence(__ATOMIC_ACQUIRE, "agent");
        asm volatile("s_waitcnt vmcnt(0)" ::: "memory");
    }
    __syncthreads();
}

template <class Hook> __device__ __forceinline__ void xcd_local_barrier_pf(const XcdBarrier& b, const Hook& hook) {
    asm volatile("s_waitcnt vmcnt(0)" ::: "memory");
    __syncthreads();
    unsigned old = 0u, nloc = 1u;
    if (threadIdx.x == 0) { __builtin_amdgcn_s_waitcnt(0); nloc = b.st[0]; old = xb_add(&b.bar[XB_LSUB(b.x)], 1u); }
    hook();
    if (threadIdx.x == 0) {
        unsigned* bar = b.bar;
        const unsigned gen = old / nloc;
        if (old + 1u == (gen + 1u) * nloc) xb_add(&bar[XB_LGEN(b.x)], 1u);
        else XB_SPIN(xb_ld(&bar[XB_LGEN(b.x)]) == gen, bar);
        __builtin_amdgcn_fence(__ATOMIC_ACQUIRE, "agent");
        asm volatile("s_waitcnt vmcnt(0)" ::: "memory");
    }
    __syncthreads();
}

constexpr int NWAVES = 8;
constexpr int BATCH = 16, SEQ = 2048, DM = 1024, M = BATCH * SEQ, DFF = 2816, NMOD = 9216, WIN = 1440, WINP = 1536, NH = 8;
constexpr float EPS = 1e-6f;
constexpr size_t MiB = 1u << 20;
constexpr size_t WS_CTL = 0, CTL_ZERO_BYTES = 64 * 1024;
constexpr size_t WS_MOD = 1 * MiB, WS_ROPE = 2 * MiB;
constexpr size_t WS_W1T = 6 * MiB, WS_WD1T = 17 * MiB, WS_W2T = 23 * MiB, WS_WD2T = 34 * MiB, WS_WINT = 40 * MiB, WS_WQT = 43 * MiB, WS_WKVT = 43 * MiB + 512 * 1024, WS_WOUTT = 44 * MiB;
constexpr size_t WS_A1 = 48 * MiB, WS_ACT = 112 * MiB, WS_V = 288 * MiB, WS_MIX = 320 * MiB, WS_HB = 384 * MiB, WS_END = 448 * MiB;
constexpr size_t WS_SLAB = 22 * MiB;
constexpr size_t WS_ZG = WS_ACT, WS_ZGD = WS_SLAB - 4 * MiB;
constexpr size_t WS_ZC = WS_ACT + 4 * MiB, WS_ZCD = WS_SLAB - (size_t)128 * 26 * 1024;
constexpr size_t WS_Q = WS_ACT + 8 * MiB, WS_QD = WS_SLAB - 6 * MiB;
constexpr size_t WS_K = WS_ACT + 14 * MiB, WS_KD = WS_SLAB - 6 * MiB;
static_assert((size_t)4096 * DFF * 2 == WS_SLAB && (size_t)4096 * 512 * 2 == 4 * MiB && (size_t)2 * 8 * 2048 * 96 * 2 == 6 * MiB && 4 * MiB + (size_t)128 * 26 * 1024 <= 8 * MiB, "class slabs");
static_assert(WS_W1T + (size_t)2 * DFF * DM * 2 <= WS_WD1T && WS_WD1T + (size_t)DM * DFF * 2 <= WS_W2T && WS_WD2T + (size_t)DM * DFF * 2 <= WS_WINT && WS_WINT + (size_t)WINP * DM * 2 <= WS_WQT, "weights map");
static_assert(WS_ACT + (size_t)M * DFF * 2 <= WS_V && WS_MIX + (size_t)M * DM * 2 <= WS_HB && WS_HB + (size_t)M * DM * 2 <= WS_END, "ws map");
constexpr size_t WS_SS1 = WS_CTL + 256 * 1024, WS_SS2 = WS_CTL + 512 * 1024, WS_SS3 = WS_CTL + 768 * 1024;
constexpr size_t WS_SS0 = WS_CTL + 128 * 1024;
constexpr size_t WS_BIAS1 = 46 * MiB + 512 * 1024;
constexpr size_t WS_BIASM = 46 * MiB, WS_BIAS2 = 46 * MiB + 128 * 1024;
constexpr int CW_TMO = 0, CW_BAR = 4096;
constexpr unsigned READY_MAGIC = 0x600DF00Du;
constexpr int LDS_BYTES = 147456, MISC_OFF = LDS_BYTES - 256;
constexpr int NPHASE = 13;
#ifndef MK_N_LAUNCHES
#define MK_N_LAUNCHES 1
#endif

__device__ __forceinline__ unsigned cvtpk(float lo, float hi) { unsigned r; asm volatile("v_cvt_pk_bf16_f32 %0, %1, %2" : "=v"(r) : "v"(lo), "v"(hi)); return r; }
__device__ __forceinline__ float bf_lo(unsigned w) { return __uint_as_float(w << 16); }
__device__ __forceinline__ float bf_hi(unsigned w) { return __uint_as_float(w & 0xffff0000u); }
__device__ __forceinline__ float sigm(float x) { return __builtin_amdgcn_rcpf(1.0f + __builtin_amdgcn_exp2f(-1.4426950408889634f * x)); }
__device__ __forceinline__ float wave_sum(float v) {
#pragma unroll
    for (int o = 1; o < 64; o <<= 1) v += __shfl_xor(v, o);
    return v;
}
__device__ __forceinline__ float swap_add(float v) { auto rr = __builtin_amdgcn_permlane32_swap(__float_as_uint(v), __float_as_uint(v), false, false); return __uint_as_float(rr[0]) + __uint_as_float(rr[1]); }

struct Args { const void* in[24]; float* out; unsigned char* ws; double invf[16]; int ph_lo, ph_hi, li, pad; };

struct Frame {
    char* lds;
    volatile LAS unsigned* MISC;
    int tid, lane, wave, vcu, G;
};

__device__ __forceinline__ void ph_final(Frame& F, const bf16* H, const float* ss, const float* g, float* out) {
    const int gw = F.vcu * NWAVES + F.wave, NGW = F.G * NWAVES, lane = F.lane;
    f32x4 g0[2], g1[2];
#pragma unroll
    for (int j = 0; j < 2; ++j) { g0[j] = *(const f32x4*)(g + 8 * lane + 512 * j); g1[j] = *(const f32x4*)(g + 8 * lane + 512 * j + 4); }
    for (int rb = gw; rb < M / 16; rb += NGW) {
        const int row0 = rb * 16;
        const float sv = ss[row0 + (lane & 15)];
#pragma unroll 4
        for (int r = 0; r < 16; ++r) {
            const float rs = __builtin_amdgcn_rsqf(__shfl(sv, r) * (1.0f / DM) + EPS);
            const v4u* hr = (const v4u*)(H + (size_t)(row0 + r) * DM) + lane; f32x4* o4 = (f32x4*)(out + (size_t)(row0 + r) * DM) + 2 * lane;
#pragma unroll
            for (int j = 0; j < 2; ++j) { const v4u w = __builtin_nontemporal_load(hr + 64 * j);
                const f32x4 a = {bf_lo(w.x), bf_hi(w.x), bf_lo(w.y), bf_hi(w.y)}, b = {bf_lo(w.z), bf_hi(w.z), bf_lo(w.w), bf_hi(w.w)};
                __builtin_nontemporal_store(a * rs * g0[j], o4 + 128 * j); __builtin_nontemporal_store(b * rs * g1[j], o4 + 128 * j + 1); }
        }
    }
}
__device__ __forceinline__ int drow_of(int kind, int n0) {
    if (kind == 0) return n0;
    if (kind == 1) return 256 * (n0 >> 7) + (n0 & 127);
    if (kind == 2) return 256 * (n0 >> 7) + 128 + (n0 & 127);
    if (n0 < 512) return 256 * (n0 >> 7) + (n0 & 127);
    if (n0 < 1024) return 256 * ((n0 - 512) >> 7) + 128 + (n0 & 127);
    return n0;
}
template <int NC> __device__ __forceinline__ void gemv16_unit(int tid, const float* vec, float* red, const float* W, int ldw, int c0, float* out, int ostride, int kind, const float* addv) {
    constexpr int KG = 512 / NC;
    const int kg = tid / NC, col = tid % NC;
    if (kg < KG) {
        f32x4 a0 = {0.f, 0.f, 0.f, 0.f}, a1 = a0, a2 = a0, a3 = a0;
        const float* wp = W + c0 + col;
        int k = kg;
        for (; k + 15 * KG < 1024; k += 16 * KG) {
            float w[16];
#pragma unroll
            for (int i = 0; i < 16; ++i) w[i] = wp[(size_t)(k + i * KG) * ldw];
#pragma unroll
            for (int i = 0; i < 16; ++i) { const f32x4* sv = (const f32x4*)(vec + (k + i * KG) * 16); a0 += sv[0] * w[i]; a1 += sv[1] * w[i]; a2 += sv[2] * w[i]; a3 += sv[3] * w[i]; }
        }
#pragma unroll 4
        for (; k < 1024; k += KG) {
            const float w = wp[(size_t)k * ldw];
            const f32x4* sv = (const f32x4*)(vec + k * 16);
            a0 += sv[0] * w; a1 += sv[1] * w; a2 += sv[2] * w; a3 += sv[3] * w;
        }
        f32x4* rp = (f32x4*)(red + (kg * NC + col) * 16);
        rp[0] = a0; rp[1] = a1; rp[2] = a2; rp[3] = a3;
    }
    __syncthreads();
    for (int idx = tid; idx < NC * 16; idx += 512) { const int cl = idx >> 4, b = idx & 15; float sum = 0.f;
#pragma unroll 8
        for (int g = 0; g < KG; ++g) sum += red[(g * NC + cl) * 16 + b];
        out[(size_t)b * ostride + drow_of(kind, c0 + cl)] = sum + (addv ? addv[c0 + cl] : 0.f); }
    __syncthreads();
}
__device__ __forceinline__ void ph_mod(Frame& F, const float* c, const float* w_ada, const float* b_ada, float* mod) {
    constexpr int SHP = 1032;
    bf16* sch = (bf16*)F.lds; bf16* scl = sch + 16 * SHP;
    float* red = (float*)(F.lds + 69632);
    for (int idx = F.tid; idx < 16384; idx += 512) { const int b = idx >> 10, k = idx & 1023; const float v = c[idx]; const float a = v * sigm(v);
        const unsigned h = f2bf(a); sch[b * SHP + k] = (bf16)h; scl[b * SHP + k] = (bf16)f2bf(a - __uint_as_float(h << 16)); }
    __syncthreads();
    const int j = F.lane & 15, kq = F.lane >> 4, w = F.wave, jc = j < 9 ? j : 8;
    for (int u = F.vcu; u < 256; u += F.G) {
        const int n0 = 36 * u;
        const float* wp = w_ada + (size_t)(128 * w + 8 * kq) * NMOD + n0 + 4 * jc;
        f32x4 wv[4][8];
#pragma unroll
        for (int ks = 0; ks < 4; ++ks)
#pragma unroll
            for (int i = 0; i < 8; ++i) wv[ks][i] = __builtin_nontemporal_load((const f32x4*)(wp + (size_t)(32 * ks + i) * NMOD));
        f32x4 acc[4];
#pragma unroll
        for (int cc = 0; cc < 4; ++cc) acc[cc] = (f32x4){0.f, 0.f, 0.f, 0.f};
#pragma unroll
        for (int ks = 0; ks < 4; ++ks) {
            const bf16x8 ah = *(const bf16x8*)(sch + j * SHP + 128 * w + 32 * ks + 8 * kq), al = *(const bf16x8*)(scl + j * SHP + 128 * w + 32 * ks + 8 * kq);
#pragma unroll
            for (int cc = 0; cc < 4; ++cc) {
                v4u bh, bl;
#pragma unroll
                for (int p = 0; p < 4; ++p) { const float x0 = wv[ks][2 * p][cc], x1 = wv[ks][2 * p + 1][cc]; const unsigned h = cvtpk(x0, x1);
                    bh[p] = h; bl[p] = cvtpk(x0 - __uint_as_float(h << 16), x1 - __uint_as_float(h & 0xffff0000u)); }
                const bf16x8 bhv = __builtin_bit_cast(bf16x8, bh), blv = __builtin_bit_cast(bf16x8, bl);
                acc[cc] = __builtin_amdgcn_mfma_f32_16x16x32_bf16(al, bhv, acc[cc], 0, 0, 0);
                acc[cc] = __builtin_amdgcn_mfma_f32_16x16x32_bf16(ah, blv, acc[cc], 0, 0, 0);
                acc[cc] = __builtin_amdgcn_mfma_f32_16x16x32_bf16(ah, bhv, acc[cc], 0, 0, 0); }
        }
#pragma unroll
        for (int cc = 0; cc < 4; ++cc) *(f32x4*)(red + ((w * 4 + cc) * 64 + F.lane) * 4) = acc[cc];
        __syncthreads();
        for (int idx = F.tid; idx < 576; idx += 512) { const int b = idx / 36, col = idx % 36, jj = col >> 2, cc = col & 3;
            float sum = b_ada[n0 + col];
#pragma unroll
            for (int w8 = 0; w8 < 8; ++w8) sum += red[((w8 * 4 + cc) * 64 + 16 * (b >> 2) + jj) * 4 + (b & 3)];
            mod[(size_t)b * NMOD + n0 + col] = sum; }
        __syncthreads();
    }
}

template <int MODE> __device__ __forceinline__ void ph_rownorm(Frame& F, const float* src, const float* sc, const float* sh, bf16* dstb, float* dstf) {
    const int gw = F.vcu * NWAVES + F.wave, NGW = F.G * NWAVES, lane = F.lane;
    for (int rb = gw; rb < M / 16; rb += NGW) {
        const int row0 = rb * 16, b = row0 >> 11;
        f32x4 s[4], t[4];
#pragma unroll
        for (int j = 0; j < 4; ++j) {
            if (MODE == 0) { s[j] = *(const f32x4*)(sc + (size_t)b * NMOD + 4 * lane + 256 * j) + 1.0f; t[j] = *(const f32x4*)(sh + (size_t)b * NMOD + 4 * lane + 256 * j); }
            else if (MODE == 2) { s[j] = pg8::ada_scale(*(const f32x4*)(sc + (size_t)b * NMOD + 4 * lane + 256 * j)); t[j] = (f32x4){0.f, 0.f, 0.f, 0.f}; }
            else { s[j] = *(const f32x4*)(sc + 4 * lane + 256 * j); t[j] = (f32x4){0.f, 0.f, 0.f, 0.f}; }
        }
#pragma unroll 2
        for (int r = 0; r < 16; ++r) {
            const f32x4* xr = (const f32x4*)(src + (size_t)(row0 + r) * DM) + lane;
            f32x4 v[4]; float ss = 0.f;
#pragma unroll
            for (int j = 0; j < 4; ++j) { v[j] = __builtin_nontemporal_load(xr + 64 * j); ss += (v[j].x * v[j].x + v[j].y * v[j].y) + (v[j].z * v[j].z + v[j].w * v[j].w); }
            if (MODE == 2) {
                unsigned long long* o8 = (unsigned long long*)(dstb + (size_t)(row0 + r) * DM) + lane;
#pragma unroll
                for (int j = 0; j < 4; ++j) { const f32x4 o = v[j] * s[j]; o8[64 * j] = (unsigned long long)cvtpk(o.x, o.y) | ((unsigned long long)cvtpk(o.z, o.w) << 32); }
                const float tot = wave_sum(ss); if (lane == 0) dstf[row0 + r] = tot;
                continue; }
            const float rs = __builtin_amdgcn_rsqf(wave_sum(ss) * (1.0f / DM) + EPS);
            if (MODE == 0) {
                unsigned long long* o8 = (unsigned long long*)(dstb + (size_t)(row0 + r) * DM) + lane;
#pragma unroll
                for (int j = 0; j < 4; ++j) { const f32x4 o = v[j] * rs * s[j] + t[j]; o8[64 * j] = (unsigned long long)cvtpk(o.x, o.y) | ((unsigned long long)cvtpk(o.z, o.w) << 32); }
            } else {
                f32x4* o4 = (f32x4*)(dstf + (size_t)(row0 + r) * DM) + lane;
#pragma unroll
                for (int j = 0; j < 4; ++j) o4[64 * j] = v[j] * rs * s[j];
            }
        }
    }
}

__device__ __forceinline__ void transpose_item(const float* W, int K, int N, bf16* WT, int k0, int n0, int drow0, const float* kscale, float* scr, int lane) {
#pragma unroll 8
    for (int i = 0; i < 32; ++i) { const int kk = 2 * i + (lane >> 5); float v = __builtin_nontemporal_load(W + (size_t)(k0 + kk) * N + n0 + (lane & 31)); if (kscale) v *= kscale[k0 + kk]; scr[kk * 33 + (lane & 31)] = v; }
    LDS_WAIT(); asm volatile("" ::: "memory");
    const int c = lane & 7;
#pragma unroll
    for (int j = 0; j < 4; ++j) { const int n = (lane >> 3) + 8 * j; const float* s = scr + (8 * c) * 33 + n;
        v4u o; o.x = cvtpk(s[0 * 33], s[1 * 33]); o.y = cvtpk(s[2 * 33], s[3 * 33]); o.z = cvtpk(s[4 * 33], s[5 * 33]); o.w = cvtpk(s[6 * 33], s[7 * 33]);
        { bf16* wp_ = WT + (size_t)(drow0 + n) * K + k0 + 8 * c; asm volatile("global_store_dwordx4 %0, %1, off sc1\n\ts_nop 1" :: "v"(wp_), "v"(o) : "memory"); } }
    LDS_WAIT(); asm volatile("" ::: "memory");
}
__device__ __forceinline__ void ph_weights(Frame& F, const __attribute__((address_space(4))) Args* ap) {
    const __attribute__((address_space(4))) Args& a = *ap;
    const float* in[24];
#pragma unroll
    for (int i = 0; i < 24; ++i) in[i] = (const float*)a.in[i];
    unsigned char* ws = a.ws;
    const int gw = F.vcu * NWAVES + F.wave, NGW = F.G * NWAVES;
    float* scr = (float*)(F.lds + F.wave * 16384);
    constexpr int I_GU = (DM / 64) * (DFF / 32), I_D = (DFF / 64) * (DM / 32), I_IN = (DM / 64) * (WIN / 32), I_Q = (256 / 64) * (768 / 32), I_KV = (128 / 64) * (1024 / 32), I_O = (DM / 64) * (DM / 32);
    constexpr int NITEMS = 4 * I_GU + 2 * I_D + I_IN + I_Q + I_KV + I_O;
    for (int it = gw; it < NITEMS; it += NGW) {
        int r = it; const float* W; int K, N, kind; bf16* WT; const float* ks = nullptr;
        if (r < I_GU) { W = in[5]; K = DM; N = DFF; kind = 1; WT = (bf16*)(ws + WS_W1T); }
        else if ((r -= I_GU) < I_GU) { W = in[6]; K = DM; N = DFF; kind = 2; WT = (bf16*)(ws + WS_W1T); }
        else if ((r -= I_GU) < I_D) { W = in[7]; K = DFF; N = DM; kind = 0; WT = (bf16*)(ws + WS_WD1T); }
        else if ((r -= I_D) < I_GU) { W = in[20]; K = DM; N = DFF; kind = 1; WT = (bf16*)(ws + WS_W2T); }
        else if ((r -= I_GU) < I_GU) { W = in[21]; K = DM; N = DFF; kind = 2; WT = (bf16*)(ws + WS_W2T); }
        else if ((r -= I_GU) < I_D) { W = in[22]; K = DFF; N = DM; kind = 0; WT = (bf16*)(ws + WS_WD2T); }
        else if ((r -= I_D) < I_IN) { W = in[8]; K = DM; N = WIN; kind = 3; WT = (bf16*)(ws + WS_WINT); }
        else if ((r -= I_IN) < I_Q) { W = in[11]; K = 256; N = 768; kind = 0; WT = (bf16*)(ws + WS_WQT); ks = in[9]; }
        else if ((r -= I_Q) < I_KV) { W = in[12]; K = 128; N = 1024; kind = 0; WT = (bf16*)(ws + WS_WKVT); ks = in[10]; }
        else { r -= I_KV; W = in[19]; K = DM; N = DM; kind = 0; WT = (bf16*)(ws + WS_WOUTT); }
        const int nblk = N / 32, kb = r / nblk, nb = r % nblk;
        transpose_item(W, K, N, WT, 64 * kb, 32 * nb, drow_of(kind, 32 * nb), ks, scr, F.lane);
    }
    { const int gt = F.vcu * 512 + F.tid, NT = F.G * 512; v4u z = {0u, 0u, 0u, 0u};
      for (int i = gt; i < 3 * (M / 4); i += NT) { const int a = i / (M / 4), j = i % (M / 4); *((v4u*)(ws + WS_SS1 + (size_t)a * 256 * 1024) + j) = z; } }
    { const int gt = F.vcu * 512 + F.tid, NT = F.G * 512; v4u z = {0u, 0u, 0u, 0u};
      for (int i = gt; i < 96 * 128; i += NT) *((v4u*)(ws + WS_WINT + (size_t)1440 * DM * 2) + i) = z; }
    { const int gt = F.vcu * 512 + F.tid, NT = F.G * 512; const int* pos = (const int*)a.in[2]; float* tab = (float*)(ws + WS_ROPE);
      for (int idx = gt; idx < M * 16; idx += NT) { const int m = idx >> 4, i = idx & 15; double f = 0.0;
#pragma unroll
          for (int k = 0; k < 16; ++k) f = (i == k) ? a.invf[k] : f;
          double rv = (double)pos[m] * f * 0.15915494309189535; rv -= __builtin_rint(rv); const float fr = (float)rv;
          tab[m * 32 + i] = __builtin_amdgcn_cosf(fr); tab[m * 32 + 16 + i] = __builtin_amdgcn_sinf(fr); } }
}
__device__ __forceinline__ void ph_prep(Frame& F, const __attribute__((address_space(4))) Args* ap) {
    const __attribute__((address_space(4))) Args& a = *ap;
    const float* in[24];
#pragma unroll
    for (int i = 0; i < 24; ++i) in[i] = (const float*)a.in[i];
    unsigned char* ws = a.ws;
    const int gw = F.vcu * NWAVES + F.wave, NGW = F.G * NWAVES;
    float* scr = (float*)(F.lds + F.wave * 16384);
    const float* mod = (const float*)(ws + WS_MOD);
    { constexpr int SHP = 1032;
      bf16* shl = (bf16*)F.lds;
      for (int idx = F.tid; idx < 3 * 16384; idx += 512) { const int ty = idx >> 14, b = (idx >> 10) & 15, k = idx & 1023; const int chunk = ty == 0 ? 0 : (ty == 1 ? 6 : 3);
          shl[(ty * 16 + b) * SHP + k] = (bf16)f2bf(mod[(size_t)b * NMOD + chunk * DM + k]); }
      __syncthreads();
      const int bl = F.lane & 15, kq = F.lane >> 4;
      for (int t = F.wave * F.G + F.vcu; t < 800; t += NGW) {
          int ty, r0, bs; const bf16* WT; float* bias;
          if (t < 352) { ty = 0; r0 = 16 * t; WT = (const bf16*)(ws + WS_W1T); bias = (float*)(ws + WS_BIAS1); bs = 2 * DFF; }
          else if (t < 704) { ty = 1; r0 = 16 * (t - 352); WT = (const bf16*)(ws + WS_W2T); bias = (float*)(ws + WS_BIAS2); bs = 2 * DFF; }
          else { ty = 2; r0 = 16 * (t - 704); WT = (const bf16*)(ws + WS_WINT); bias = (float*)(ws + WS_BIASM); bs = WINP; }
          const bf16* wrow = WT + (size_t)(r0 + bl) * DM + 8 * kq;
          const bf16* arow = shl + (ty * 16 + bl) * SHP + 8 * kq;
          f32x4 acc = {0.f, 0.f, 0.f, 0.f};
          bf16x8 bw[32];
#pragma unroll
          for (int ks = 0; ks < 32; ++ks) bw[ks] = *(const bf16x8*)(wrow + 32 * ks);
#pragma unroll
          for (int ks = 0; ks < 32; ++ks) {
              const bf16x8 av = *(const bf16x8*)(arow + 32 * ks);
              acc = __builtin_amdgcn_mfma_f32_16x16x32_bf16(av, bw[ks], acc, 0, 0, 0); }
#pragma unroll
          for (int e = 0; e < 4; ++e) bias[(size_t)(4 * kq + e) * bs + r0 + bl] = acc[e];
      }
      __syncthreads(); }
    ph_rownorm<2>(F, in[0], mod + 1 * DM, nullptr, (bf16*)(ws + WS_A1), (float*)(ws + WS_SS0));
}

typedef float cf32x2 __attribute__((ext_vector_type(2)));
template <int S> __device__ __forceinline__ void conv_row(cf32x2 (&a)[16], const cf32x2 (&w)[31], const char* base) {
    const unsigned v = *(const unsigned*)(base + S * 1024); const cf32x2 x = {bf_lo(v), bf_hi(v)};
#pragma unroll
    for (int t = 0; t < 16; ++t) { const int j = S - t; if (j >= 0 && j < 31) a[t] = __builtin_elementwise_fma(w[j], x, a[t]); }
}
template <int S0, int S1> __device__ __forceinline__ void conv_rows(cf32x2 (&a)[16], const cf32x2 (&w)[31], const char* base) {
    if constexpr (S0 < S1) { conv_row<S0>(a, w, base); conv_rows<S0 + 1, S1>(a, w, base); }
}
__device__ __forceinline__ void ph_conv(Frame& F, const bf16* ZG, const float* cw, const float* cb, const float* lg, const float* lb, bf16* MIX) {
    char* lds = F.lds; const int tid = F.tid, lane = F.lane, wave = F.wave;
    const int cp = tid & 255, th = tid >> 8;
    constexpr int NU = M / 32;
    const int per = (NU + F.G - 1) / F.G, u0 = F.vcu * per, u1 = (u0 + per < NU) ? u0 + per : NU;
    if (u0 >= u1) return;
    cf32x2 wv[31];
#pragma unroll
    for (int j = 0; j < 31; ++j) { const float2 w = *(const float2*)(cw + j * 512 + 2 * cp); wv[j] = (cf32x2){w.x, w.y}; }
    const float2 bias = *(const float2*)(cb + 2 * cp);
    const f32x4 g0 = *(const f32x4*)(lg + 8 * lane), g1 = *(const f32x4*)(lg + 8 * lane + 4), b0 = *(const f32x4*)(lb + 8 * lane), b1 = *(const f32x4*)(lb + 8 * lane + 4);
    v4u tv[8];
#define CONV_LOAD(uu) do { const int m0_ = (uu) * 32, t0_ = m0_ & (SEQ - 1); const bf16* ZGc = ZG + (size_t)(m0_ >> 12) * (WS_ZGD / 2); _Pragma("unroll") for (int i = 0; i < 8; ++i) { const int id = tid + 512 * i; const int row = id >> 6, c = id & 63, t = t0_ - 15 + row; \
        const int tc = t < 0 ? 0 : (t > SEQ - 1 ? SEQ - 1 : t); tv[i] = *(const v4u*)(ZGc + (size_t)(m0_ - t0_ + tc) * 512 + c * 8); } } while (0)
#define CONV_WRITE(uu) do { const int t0_ = ((uu) * 32) & (SEQ - 1); _Pragma("unroll") for (int i = 0; i < 8; ++i) { const int id = tid + 512 * i; const int row = id >> 6, c = id & 63, t = t0_ - 15 + row; const bool ok = (t >= 0 && t < SEQ); \
        v4u v = tv[i]; v.x = ok ? v.x : 0u; v.y = ok ? v.y : 0u; v.z = ok ? v.z : 0u; v.w = ok ? v.w : 0u; if (row < 62) *(v4u*)(lds + row * 1024 + c * 16) = v; } } while (0)
    CONV_LOAD(u0); CONV_WRITE(u0);
    __syncthreads();
    for (int u = u0; u < u1; ++u) {
        const int m0 = u * 32;
        if (u + 1 < u1) CONV_LOAD(u + 1);
        cf32x2 av[16];
#pragma unroll
        for (int t = 0; t < 16; ++t) av[t] = (cf32x2){bias.x, bias.y};
        conv_rows<0, 46>(av, wv, lds + th * 16 * 1024 + cp * 4);
#pragma unroll
        for (int t = 0; t < 16; ++t) *(cf32x2*)(lds + 65536 + (th * 16 + t) * 2048 + cp * 8) = av[t];
        __syncthreads();
        if (u + 1 < u1) CONV_WRITE(u + 1);
#pragma unroll
        for (int i = 0; i < 4; ++i) { const int t = wave * 4 + i;
            const f32x4 x0 = *(const f32x4*)(lds + 65536 + t * 2048 + lane * 32), x1 = *(const f32x4*)(lds + 65536 + t * 2048 + lane * 32 + 16);
            const float mu = wave_sum((x0.x + x0.y) + (x0.z + x0.w) + (x1.x + x1.y) + (x1.z + x1.w)) * (1.0f / 512.0f);
            const f32x4 d0 = x0 - mu, d1 = x1 - mu;
            const float var = wave_sum((d0.x * d0.x + d0.y * d0.y) + (d0.z * d0.z + d0.w * d0.w) + (d1.x * d1.x + d1.y * d1.y) + (d1.z * d1.z + d1.w * d1.w)) * (1.0f / 512.0f);
            const float rs = __builtin_amdgcn_rsqf(var + 1e-5f);
            f32x4 y0 = d0 * rs * g0 + b0, y1 = d1 * rs * g1 + b1;
            y0.x *= sigm(y0.x); y0.y *= sigm(y0.y); y0.z *= sigm(y0.z); y0.w *= sigm(y0.w); y1.x *= sigm(y1.x); y1.y *= sigm(y1.y); y1.z *= sigm(y1.z); y1.w *= sigm(y1.w);
            v4u o; o.x = cvtpk(y0.x, y0.y); o.y = cvtpk(y0.z, y0.w); o.z = cvtpk(y1.x, y1.y); o.w = cvtpk(y1.z, y1.w);
            *(v4u*)(MIX + (size_t)(m0 + t) * DM + 8 * lane) = o; }
        __syncthreads();
    }
#undef CONV_LOAD
#undef CONV_WRITE
}

namespace lat {
using f32x16 = __attribute__((ext_vector_type(16))) float;
constexpr int WQ_OFF = 0, WKV_OFF = 49152, SCR_OFF = 81920, SCR_W = 6656, G_OFF = SCR_OFF + 8 * SCR_W;
__device__ __forceinline__ int crow(int r, int hi) { return (r & 3) + 8 * (r >> 2) + 4 * hi; }
}
__device__ __forceinline__ void ph_latent(Frame& F, const bf16* ZC, const bf16* Wqt, const bf16* Wkvt, const float* gqh, const float* gkh, const float* tab, bf16* Qo, bf16* Ko, bf16* Vo) {
    using namespace lat;
    char* lds = F.lds; const int tid = F.tid, lane = F.lane, wave = F.wave, r32 = lane & 31, hi = lane >> 5;
    float* gl = (float*)(lds + G_OFF);
    if (tid < 96) gl[tid] = gqh[tid]; else if (tid < 192) gl[tid] = gkh[tid - 96];
    char* scr = lds + SCR_OFF + wave * SCR_W;
    const int sw = (r32 & 15) << 4;
    for (int u = F.vcu; u < 256; u += F.G) {
        const int h = u & 7, rng = u >> 3;
        const bf16* const ZCc = ZC + (size_t)(rng >> 2) * (WS_ZCD / 2); bf16* const Qc = Qo + (size_t)(rng >> 2) * (WS_QD / 2); bf16* const Kc = Ko + (size_t)(rng >> 2) * (WS_KD / 2);
        __syncthreads();
#pragma unroll
        for (int i = 0; i < 6; ++i) { const int id = tid + 512 * i, row = id >> 5, c = id & 31; const v4u v = *((const v4u*)(Wqt + (size_t)h * 96 * 256) + id);
            *(v4u*)(lds + WQ_OFF + row * 512 + ((c * 16) ^ ((row & 15) << 4))) = v; }
#pragma unroll
        for (int i = 0; i < 4; ++i) { const int id = tid + 512 * i, row = id >> 4, c = id & 15; const v4u v = *((const v4u*)(Wkvt + (size_t)h * 128 * 128) + id);
            *(v4u*)(lds + WKV_OFF + row * 256 + ((c * 16) ^ ((row & 15) << 4))) = v; }
        __syncthreads();
        for (int it = 0; it < 4; ++it) {
            const int mw = rng * 1024 + it * 256 + wave * 32;
            const int m = mw + r32, b = mw >> 11, s0 = mw & (SEQ - 1);
            const char* zt = (const char*)ZCc + (size_t)(mw >> 5) * 26 * 1024 + hi * 512 + r32 * 16;
            bf16x8 ql[16];
#pragma unroll
            for (int ks = 0; ks < 16; ++ks) ql[ks] = *(const bf16x8*)(zt + ks * 1024);
            float cs[8], sn[8];
#pragma unroll
            for (int g = 0; g < 2; ++g) { const f32x4 c4 = *(const f32x4*)(tab + (size_t)m * 32 + 8 * g + 4 * hi), s4 = *(const f32x4*)(tab + (size_t)m * 32 + 16 + 8 * g + 4 * hi);
#pragma unroll
                for (int e = 0; e < 4; ++e) { cs[4 * g + e] = c4[e]; sn[4 * g + e] = s4[e]; } }
            {
                float sq = 0.f;
#pragma unroll
                for (int ks = 0; ks < 16; ++ks)
#pragma unroll
                    for (int e = 0; e < 8; ++e) { const float v = __uint_as_float(((unsigned)(unsigned short)ql[ks][e]) << 16); sq = fmaf(v, v, sq); }
                const float rq = __builtin_amdgcn_rsqf(swap_add(sq) * (1.0f / 256.0f) + EPS);
                f32x16 q0 = {}, q1 = {}, q2 = {};
#pragma unroll
                for (int ks = 0; ks < 16; ++ks) { const int cb = (ks * 32 + hi * 16) ^ sw; const char* wp = lds + WQ_OFF + r32 * 512 + cb;
                    const bf16x8 a0 = *(const bf16x8*)(wp), a1 = *(const bf16x8*)(wp + 32 * 512), a2 = *(const bf16x8*)(wp + 64 * 512);
                    q0 = __builtin_amdgcn_mfma_f32_32x32x16_bf16(a0, ql[ks], q0, 0, 0, 0);
                    q1 = __builtin_amdgcn_mfma_f32_32x32x16_bf16(a1, ql[ks], q1, 0, 0, 0);
                    q2 = __builtin_amdgcn_mfma_f32_32x32x16_bf16(a2, ql[ks], q2, 0, 0, 0); }
                float ss = 0.f;
#pragma unroll
                for (int r = 0; r < 16; ++r) ss += q0[r] * q0[r] + q1[r] * q1[r] + q2[r] * q2[r];
                ss = swap_add(ss);
                const float f = att::QSCALE * rq * __builtin_amdgcn_rsqf(rq * rq * ss * (1.0f / 96.0f) + EPS);
#pragma unroll
                for (int g = 0; g < 4; ++g) { const f32x4 ga = *(const f32x4*)(gl + 8 * g + 4 * hi), gb = *(const f32x4*)(gl + 32 + 8 * g + 4 * hi), gc = *(const f32x4*)(gl + 64 + 8 * g + 4 * hi);
#pragma unroll
                    for (int e = 0; e < 4; ++e) { q0[4 * g + e] *= f * ga[e]; q1[4 * g + e] *= f * gb[e]; q2[4 * g + e] *= f * gc[e]; } }
#pragma unroll
                for (int r = 0; r < 8; ++r) { const float x1 = q2[r], x2 = q2[r + 8]; q2[r] = x1 * cs[r] - x2 * sn[r]; q2[r + 8] = x2 * cs[r] + x1 * sn[r]; }
#pragma unroll
                for (int g = 0; g < 4; ++g) {
                    *(uint2*)(scr + r32 * 208 + (8 * g + 4 * hi) * 2) = make_uint2(cvtpk(q0[4 * g], q0[4 * g + 1]), cvtpk(q0[4 * g + 2], q0[4 * g + 3]));
                    *(uint2*)(scr + r32 * 208 + (32 + 8 * g + 4 * hi) * 2) = make_uint2(cvtpk(q1[4 * g], q1[4 * g + 1]), cvtpk(q1[4 * g + 2], q1[4 * g + 3]));
                    *(uint2*)(scr + r32 * 208 + (64 + 8 * g + 4 * hi) * 2) = make_uint2(cvtpk(q2[4 * g], q2[4 * g + 1]), cvtpk(q2[4 * g + 2], q2[4 * g + 3])); }
                LDS_WAIT();
                bf16* dst = Qc + ((size_t)(b * NH + h) * SEQ + s0) * 96;
#pragma unroll
                for (int i = 0; i < 6; ++i) { const int id = lane + 64 * i, row = id / 12, c = id % 12; *((v4u*)dst + id) = *(const v4u*)(scr + row * 208 + c * 16); }
                LDS_WAIT();
            }
            {
                asm volatile("" ::: "memory");
                bf16x8 kl[8];
#pragma unroll
                for (int ks = 0; ks < 8; ++ks) kl[ks] = *(const bf16x8*)(zt + (16 + ks) * 1024);
                uint2 krw[4];
#pragma unroll
                for (int g = 0; g < 4; ++g) krw[g] = *(const uint2*)((const char*)ZCc + (size_t)(mw >> 5) * 26 * 1024 + (24 + (g >> 1)) * 1024 + (g & 1) * 512 + r32 * 16 + hi * 8);
                float skv = 0.f;
#pragma unroll
                for (int ks = 0; ks < 8; ++ks)
#pragma unroll
                    for (int e = 0; e < 8; ++e) { const float v = __uint_as_float(((unsigned)(unsigned short)kl[ks][e]) << 16); skv = fmaf(v, v, skv); }
                const float rkv = __builtin_amdgcn_rsqf(swap_add(skv) * (1.0f / 128.0f) + EPS);
                float kr[16];
#pragma unroll
                for (int g = 0; g < 4; ++g) { kr[4 * g] = bf_lo(krw[g].x); kr[4 * g + 1] = bf_hi(krw[g].x); kr[4 * g + 2] = bf_lo(krw[g].y); kr[4 * g + 3] = bf_hi(krw[g].y); }
                float skr = 0.f;
#pragma unroll
                for (int r = 0; r < 16; ++r) skr = fmaf(kr[r], kr[r], skr);
                skr = swap_add(skr);
                f32x16 k0 = {}, k1 = {}, v0 = {}, v1 = {};
#pragma unroll
                for (int ks = 0; ks < 8; ++ks) { const int cb = (ks * 32 + hi * 16) ^ sw; const char* wp = lds + WKV_OFF + r32 * 256 + cb;
                    const bf16x8 a0 = *(const bf16x8*)(wp), a1 = *(const bf16x8*)(wp + 32 * 256), a2 = *(const bf16x8*)(wp + 64 * 256), a3 = *(const bf16x8*)(wp + 96 * 256);
                    k0 = __builtin_amdgcn_mfma_f32_32x32x16_bf16(a0, kl[ks], k0, 0, 0, 0);
                    k1 = __builtin_amdgcn_mfma_f32_32x32x16_bf16(a1, kl[ks], k1, 0, 0, 0);
                    v0 = __builtin_amdgcn_mfma_f32_32x32x16_bf16(a2, kl[ks], v0, 0, 0, 0);
                    v1 = __builtin_amdgcn_mfma_f32_32x32x16_bf16(a3, kl[ks], v1, 0, 0, 0); }
#pragma unroll
                for (int g = 0; g < 4; ++g) {
                    *(uint2*)(scr + r32 * 144 + (8 * g + 4 * hi) * 2) = make_uint2(cvtpk(v0[4 * g] * rkv, v0[4 * g + 1] * rkv), cvtpk(v0[4 * g + 2] * rkv, v0[4 * g + 3] * rkv));
                    *(uint2*)(scr + r32 * 144 + (32 + 8 * g + 4 * hi) * 2) = make_uint2(cvtpk(v1[4 * g] * rkv, v1[4 * g + 1] * rkv), cvtpk(v1[4 * g + 2] * rkv, v1[4 * g + 3] * rkv)); }
                LDS_WAIT();
                bf16* dv = Vo + ((size_t)(b * NH + h) * SEQ + s0) * 64;
#pragma unroll
                for (int i = 0; i < 4; ++i) { const int id = lane + 64 * i, row = id >> 3, c = id & 7; *((v4u*)dv + id) = *(const v4u*)(scr + row * 144 + c * 16); }
                LDS_WAIT();
                float ss = 0.f;
#pragma unroll
                for (int r = 0; r < 16; ++r) ss += k0[r] * k0[r] + k1[r] * k1[r];
                ss = swap_add(ss);
                const float rn = __builtin_amdgcn_rsqf((rkv * rkv * ss + skr) * (1.0f / 96.0f) + EPS), f = rkv * rn;
                float kq[16];
#pragma unroll
                for (int g = 0; g < 4; ++g) { const f32x4 ga = *(const f32x4*)(gl + 96 + 8 * g + 4 * hi), gb = *(const f32x4*)(gl + 96 + 32 + 8 * g + 4 * hi), gc = *(const f32x4*)(gl + 96 + 64 + 8 * g + 4 * hi);
#pragma unroll
                    for (int e = 0; e < 4; ++e) { k0[4 * g + e] *= f * ga[e]; k1[4 * g + e] *= f * gb[e]; kq[4 * g + e] = kr[4 * g + e] * rn * gc[e]; } }
#pragma unroll
                for (int r = 0; r < 8; ++r) { const float x1 = kq[r], x2 = kq[r + 8]; kq[r] = x1 * cs[r] - x2 * sn[r]; kq[r + 8] = x2 * cs[r] + x1 * sn[r]; }
#pragma unroll
                for (int g = 0; g < 4; ++g) {
                    *(uint2*)(scr + r32 * 208 + (8 * g + 4 * hi) * 2) = make_uint2(cvtpk(k0[4 * g], k0[4 * g + 1]), cvtpk(k0[4 * g + 2], k0[4 * g + 3]));
                    *(uint2*)(scr + r32 * 208 + (32 + 8 * g + 4 * hi) * 2) = make_uint2(cvtpk(k1[4 * g], k1[4 * g + 1]), cvtpk(k1[4 * g + 2], k1[4 * g + 3]));
                    *(uint2*)(scr + r32 * 208 + (64 + 8 * g + 4 * hi) * 2) = make_uint2(cvtpk(kq[4 * g], kq[4 * g + 1]), cvtpk(kq[4 * g + 2], kq[4 * g + 3])); }
                LDS_WAIT();
                bf16* dk = Kc + ((size_t)(b * NH + h) * SEQ + s0) * 96;
#pragma unroll
                for (int i = 0; i < 6; ++i) { const int id = lane + 64 * i, row = id / 12, c = id % 12; *((v4u*)dk + id) = *(const v4u*)(scr + row * 208 + c * 16); }
                LDS_WAIT();
            }
        }
    }
    __syncthreads();
}

__device__ __forceinline__ void ph_attn(Frame& F, const bf16* Q, const bf16* K, const bf16* V, bf16* MIX, bf16* DUMMY, const float* gqh, const float* gkh) {
    float gq = 0.f, gk = 0.f;
    for (int i = F.lane; i < 96; i += 64) { gq = fmaxf(gq, fabsf(gqh[i])); gk = fmaxf(gk, fabsf(gkh[i])); }
#pragma unroll
    for (int o = 1; o < 64; o <<= 1) { gq = fmaxf(gq, __shfl_xor(gq, o)); gk = fmaxf(gk, __shfl_xor(gk, o)); }
    const bool nomax = __builtin_amdgcn_readfirstlane((gq * gk * 14.136f * 1.05f <= 64.f) ? 1 : 0) != 0;
    for (int i = 0;; ++i) {
        int bh, qb;
        if (F.G == 256) { if (i >= 2) break; bh = (2 * (F.vcu >> 5) + i) * NH + ((F.vcu & 31) >> 2); qb = F.vcu & 3; }
        else { const int L = i * F.G + F.vcu; if (L >= BATCH * NH * 4) break; bh = L >> 2; qb = L & 3; }
        const int b = bh >> 3, h = bh & 7;
        const bf16* const Qk = Q + (size_t)(b >> 1) * (WS_QD / 2); const bf16* const Kk = K + (size_t)(b >> 1) * (WS_KD / 2);
        if (nomax) att::attn_unit64<true>(Qk + ((size_t)bh * SEQ + qb * 512) * 96, Kk + (size_t)bh * SEQ * 96, V + (size_t)bh * SEQ * 64, MIX + ((size_t)b * SEQ + qb * 512) * DM + 512 + h * 64, DM, SEQ, F.lds);
        else att::attn_unit64<false>(Qk + ((size_t)bh * SEQ + qb * 512) * 96, Kk + (size_t)bh * SEQ * 96, V + (size_t)bh * SEQ * 64, MIX + ((size_t)b * SEQ + qb * 512) * DM + 512 + h * 64, DM, SEQ, F.lds);
    }
}

typedef const __attribute__((address_space(4))) Args* KArgs;
#define KA() ({ KArgs p_ = (KArgs)__builtin_amdgcn_kernarg_segment_ptr(); asm volatile("" : "+s"(p_)); p_; })
__global__ void __launch_bounds__(NWAVES * 64, 2) mega_fwd(Args args) {
    extern __shared__ __attribute__((aligned(16))) unsigned char lds[];
    Frame F;
    F.lds = (char*)lds;
    F.MISC = (volatile LAS unsigned*)((LAS unsigned char*)lds + MISC_OFF);
    F.tid = threadIdx.x; F.lane = F.tid & 63; F.wave = __builtin_amdgcn_readfirstlane(F.tid >> 6);
    F.G = gridDim.x; { const int bx = blockIdx.x; F.vcu = (F.G % 8 == 0) ? (bx % 8) * (F.G / 8) + bx / 8 : bx; }
    if (F.tid < 64) F.MISC[F.tid] = 0u;
    __syncthreads();
    const int lo = args.ph_lo, hi = args.ph_hi;
    XcdBarrier bar; bar.bar = (unsigned*)((gu32*)(args.ws + WS_CTL) + CW_BAR) + args.li * XCD_BAR_WORDS; bar.x = 0; bar.st = nullptr;
    const bool full = (lo == 0 && hi == NPHASE);
    gu32* const ready = (gu32*)(args.ws + WS_CTL) + 64;
    if (full) {
        bar.x = xb_xcc_id(); bar.st = F.MISC + 8;
        if (blockIdx.x == 0 && F.tid < 64) {
            unsigned* bw = bar.bar;
            if (F.tid < 16) { __hip_atomic_store(&bw[XB_XCNT(F.tid)], 0u, RLX_AGENT); __hip_atomic_store(&bw[XB_XSUB(F.tid)], 0u, RLX_AGENT); __hip_atomic_store(&bw[XB_XGEN(F.tid)], 0u, RLX_AGENT);
                              __hip_atomic_store(&bw[XB_LSUB(F.tid)], 0u, RLX_AGENT); __hip_atomic_store(&bw[XB_LGEN(F.tid)], 0u, RLX_AGENT); }
            if (F.tid == 16) { __hip_atomic_store(&bw[XB_TMO], 0u, RLX_AGENT); __hip_atomic_store(&bw[XB_TOP], 0u, RLX_AGENT); __hip_atomic_store(&bw[XB_TOPGEN], 0u, RLX_AGENT);
                               __hip_atomic_store((gu32*)(args.ws + WS_CTL) + 16, 0u, RLX_AGENT); }
            asm volatile("s_waitcnt vmcnt(0)" ::: "memory");
            if (F.tid == 0) __hip_atomic_store(ready, READY_MAGIC, __ATOMIC_RELEASE, __HIP_MEMORY_SCOPE_AGENT);
        }
    } else if (hi - lo != 1) bar = xcd_barrier_post((unsigned*)((gu32*)(args.ws + WS_CTL) + CW_BAR) + args.li * XCD_BAR_WORDS, F.MISC + 8);
    gu32* const xtab = (gu32*)(args.ws + WS_CTL) + 1024; gu32* const xflag = (gu32*)(args.ws + WS_CTL) + 16;
    if (!full && F.tid == 0) __hip_atomic_store(xtab + blockIdx.x, bar.x + 1u, RLX_AGENT);
    bool use_local = false;
#ifndef PH_MASK
#define PH_MASK 0x1fff
#endif
#define IN(k) (((PH_MASK >> (k)) & 1) && lo <= (k) && (k) < hi)
#ifndef BAR_REP
#define BAR_REP 1
#endif
#define SEAM(k) do { if (IN(k) && (k) + 1 < hi) { for (int br_ = 0; br_ < BAR_REP; ++br_) xcd_barrier(bar); } } while (0)
#define SEAML(k) do { if (IN(k) && (k) + 1 < hi) { if (use_local) xcd_local_barrier(bar); else xcd_barrier(bar); } } while (0)
#define SEAML_PF(k, flag, BTOFF, N_, K_) do { if (IN(k) && (k) + 1 < hi) { if (use_local) { flag = true; const unsigned char* bt_ = KA()->ws + (BTOFF); \
        xcd_local_barrier_pf(bar, [&]() { pg8::prestage_b(ring, bt_, M, N_, K_, F.G, (int)blockIdx.x); }); } else xcd_barrier(bar); } } while (0)
    bool bp3 = false, bp5 = false, bp8 = false, bp10 = false, bp11 = false;
#ifndef PH_REP
#define PH_REP 0
#endif
#define REPS(k) for (int rep_ = 0; rep_ < 1 + ((PH_REP >> (k)) & 1); ++rep_)
#define WSB(off) (ws + (off))
#define INF(i) ((const float*)ka->in[i])
    LAS unsigned char* ring = (LAS unsigned char*)lds;

    if (IN(0)) REPS(0) { { KArgs ka = KA(); unsigned char* ws = ka->ws; ph_mod(F, INF(1), INF(3), INF(4), (float*)WSB(WS_MOD));
#ifdef MOD_REP
        for (int mr_ = 0; mr_ < MOD_REP; ++mr_) { __syncthreads(); ph_mod(F, INF(1), INF(3), INF(4), (float*)WSB(WS_MOD)); }
#endif
        } ph_weights(F, KA()); }
    if (full && F.tid == 0) {
        unsigned sp_ = 0u; while (__hip_atomic_load(ready, RLX_AGENT) != READY_MAGIC) { __builtin_amdgcn_s_sleep(2); if (++sp_ > (1u << 22)) break; }
        (void)xb_add(&bar.bar[XB_XCNT(bar.x)], 1u);
        __hip_atomic_store(xtab + blockIdx.x, bar.x + 1u, RLX_AGENT);
    }
    SEAM(0);
    if (full && blockIdx.x == 0 && F.tid == 0) __hip_atomic_store(ready, 0u, RLX_AGENT);
    if (lo == 0 && hi == NPHASE && F.G == 256 && F.tid == 0) { if (__hip_atomic_load(xtab + (blockIdx.x & 7), RLX_AGENT) != bar.x + 1u) __hip_atomic_store(xflag, 1u, RLX_AGENT); }
    if (IN(1)) REPS(1) { ph_prep(F, KA()); } SEAM(1);
#ifndef NO_LOCAL_SEAMS
    if (lo == 0 && hi == NPHASE && F.G == 256) use_local = __builtin_amdgcn_readfirstlane(__hip_atomic_load(xflag, RLX_AGENT) == 0u ? 1 : 0) != 0;
#endif
    if (IN(2)) REPS(2) { KArgs ka = KA(); unsigned char* ws = ka->ws;
        pg8::Gemm g{(const bf16*)WSB(WS_A1), (const bf16*)WSB(WS_W1T), M, 2 * DFF, DM}; pg8::StaticOrder S; S.init(M, 2 * DFF, F.G, (int)blockIdx.x);
        pg8::EpiSwigluN E{(bf16*)WSB(WS_ACT), DFF, (const float*)WSB(WS_SS0), (const float*)WSB(WS_BIAS1), 2 * DFF}; pg8::gemm_phase<pg8::EpiSwigluN, pg8::StaticOrder, true, true>(ring, g, S, E); } SEAML_PF(2, bp3, WS_WD1T, DM, DFF);
    if (IN(3)) REPS(3) { KArgs ka = KA(); unsigned char* ws = ka->ws;
        pg8::Gemm g{(const bf16*)WSB(WS_ACT), (const bf16*)WSB(WS_WD1T), M, DM, DFF}; pg8::StaticOrder S; S.init(M, DM, F.G, (int)blockIdx.x);
        pg8::EpiResidNorm<true, 2, true, false> E{WSB(WS_A1), nullptr, (const float*)WSB(WS_MOD) + 2 * DM, 2 * DM, -1 * DM, (bf16*)WSB(WS_A1), (float*)WSB(WS_SS1)};
        pg8::gemm_phase<pg8::EpiResidNorm<true, 2, true, false>, pg8::StaticOrder, true, true>(ring, g, S, E, bp3); } SEAML_PF(3, bp5, WS_WINT, WINP, DM);
    if (IN(5)) REPS(5) { KArgs ka = KA(); unsigned char* ws = ka->ws;
        pg8::Gemm g{(const bf16*)WSB(WS_A1), (const bf16*)WSB(WS_WINT), M, WINP, DM}; pg8::StaticOrder S; S.init(M, WINP, F.G, (int)blockIdx.x);
        pg8::EpiG3N E{(bf16*)WSB(WS_ZG), (bf16*)WSB(WS_ZC), (const float*)WSB(WS_SS1), (const float*)WSB(WS_BIASM), WS_ZGD / 2, WS_ZCD / 2}; pg8::gemm_phase<pg8::EpiG3N, pg8::StaticOrder, true, true>(ring, g, S, E, bp5); } SEAML(5);
    if (IN(6)) {
        REPS(13) { KArgs ka = KA(); unsigned char* ws = ka->ws;
            ph_latent(F, (const bf16*)WSB(WS_ZC), (const bf16*)WSB(WS_WQT), (const bf16*)WSB(WS_WKVT), INF(13), INF(14), (const float*)WSB(WS_ROPE), (bf16*)WSB(WS_Q), (bf16*)WSB(WS_K), (bf16*)WSB(WS_V)); }
        REPS(14) { KArgs ka = KA(); unsigned char* ws = ka->ws; ph_conv(F, (const bf16*)WSB(WS_ZG), INF(15), INF(16), INF(17), INF(18), (bf16*)WSB(WS_MIX)); }
    } SEAML(6);
    if (IN(7)) REPS(7) { KArgs ka = KA(); unsigned char* ws = ka->ws; ph_attn(F, (const bf16*)WSB(WS_Q), (const bf16*)WSB(WS_K), (const bf16*)WSB(WS_V), (bf16*)WSB(WS_MIX), (bf16*)WSB(WS_A1), INF(13), INF(14)); } SEAML_PF(7, bp8, WS_WOUTT, DM, DM);
    if (IN(8)) REPS(8) { KArgs ka = KA(); unsigned char* ws = ka->ws;
        pg8::Gemm g{(const bf16*)WSB(WS_MIX), (const bf16*)WSB(WS_WOUTT), M, DM, DM}; pg8::StaticOrder S; S.init(M, DM, F.G, (int)blockIdx.x);
        pg8::EpiResidNorm<false, 2, true, false> E{WSB(WS_A1), nullptr, (const float*)WSB(WS_MOD) + 5 * DM, 2 * DM, -1 * DM, (bf16*)WSB(WS_A1), (float*)WSB(WS_SS2)};
        pg8::gemm_phase<pg8::EpiResidNorm<false, 2, true, false>, pg8::StaticOrder, true, true>(ring, g, S, E, bp8); } SEAML_PF(8, bp10, WS_W2T, 2 * DFF, DM);
    if (IN(10)) REPS(10) { KArgs ka = KA(); unsigned char* ws = ka->ws;
        pg8::Gemm g{(const bf16*)WSB(WS_A1), (const bf16*)WSB(WS_W2T), M, 2 * DFF, DM}; pg8::StaticOrder S; S.init(M, 2 * DFF, F.G, (int)blockIdx.x);
        pg8::EpiSwigluN E{(bf16*)WSB(WS_ACT), DFF, (const float*)WSB(WS_SS2), (const float*)WSB(WS_BIAS2), 2 * DFF}; pg8::gemm_phase<pg8::EpiSwigluN, pg8::StaticOrder, true, true>(ring, g, S, E, bp10); } SEAML_PF(10, bp11, WS_WD2T, DM, DFF);
    if (IN(11)) REPS(11) { KArgs ka = KA(); unsigned char* ws = ka->ws;
        pg8::Gemm g{(const bf16*)WSB(WS_ACT), (const bf16*)WSB(WS_WD2T), M, DM, DFF}; pg8::StaticOrder S; S.init(M, DM, F.G, (int)blockIdx.x);
        pg8::EpiResidNorm<true, 2, false, true> E{WSB(WS_A1), (bf16*)WSB(WS_HB), (const float*)WSB(WS_MOD) + 8 * DM, 0, -1 * DM, nullptr, (float*)WSB(WS_SS3)};
        pg8::gemm_phase<pg8::EpiResidNorm<true, 2, false, true>, pg8::StaticOrder, true, true>(ring, g, S, E, bp11); } SEAML(11);
    if (IN(12)) REPS(12) { KArgs ka = KA(); unsigned char* ws = ka->ws; ph_final(F, (const bf16*)WSB(WS_HB), (const float*)WSB(WS_SS3), INF(23), ka->out); }
#undef IN
#undef SEAM
}

extern "C" void kernel_launch(void* const* d_in, const int* in_sizes, int n_in, void* d_out, int out_size, void* d_ws, size_t ws_size, hipStream_t stream) {
    static int grid = 0;
    if (grid == 0) {
        if (n_in != 24 || in_sizes[0] != M * DM || out_size != M * DM || ws_size < WS_END) { fprintf(stderr, "kernel_launch: unexpected shapes (n_in %d, in0 %d, out %d, ws %zu)\n", n_in, n_in > 0 ? in_sizes[0] : -1, out_size, ws_size); grid = -1; return; }
        int dev = 0, cus = 0, per_cu = 0;
        if (hipGetDevice(&dev) != hipSuccess || hipDeviceGetAttribute(&cus, hipDeviceAttributeMultiprocessorCount, dev) != hipSuccess) { grid = -1; return; }
        if (hipFuncSetAttribute((const void*)mega_fwd, hipFuncAttributeMaxDynamicSharedMemorySize, LDS_BYTES) != hipSuccess) { fprintf(stderr, "kernel_launch: hipFuncSetAttribute failed\n"); grid = -1; return; }
        if (hipOccupancyMaxActiveBlocksPerMultiprocessor(&per_cu, (const void*)mega_fwd, NWAVES * 64, LDS_BYTES) != hipSuccess || per_cu < 1) { fprintf(stderr, "kernel_launch: occupancy query says %d blocks per CU\n", per_cu); (void)hipGetLastError(); grid = -1; return; }
        grid = cus;
    }
    if (grid < 0) return;
    if (MK_N_LAUNCHES != 1) { if (hipMemsetAsync((char*)d_ws + WS_CTL, 0, CTL_ZERO_BYTES, stream) != hipSuccess) return; }
    Args a{};
    for (int i = 0; i < 24; ++i) a.in[i] = d_in[i];
    a.out = (float*)d_out; a.ws = (unsigned char*)d_ws;
    for (int i = 0; i < 16; ++i) a.invf[i] = 1.0 / pow(10000.0, (double)(2 * i) / 32.0);
    constexpr int NL = MK_N_LAUNCHES;
    for (int li = 0; li < NL; ++li) {
        a.ph_lo = (NL == NPHASE) ? li : (li * NPHASE) / NL; a.ph_hi = (NL == NPHASE) ? li + 1 : ((li + 1) * NPHASE) / NL; a.li = (NL == NPHASE) ? 0 : li;
        hipLaunchKernelGGL(mega_fwd, dim3(grid), dim3(NWAVES * 64), LDS_BYTES, stream, a);
        const hipError_t le = hipPeekAtLastError();
        if (le != hipSuccess) { fprintf(stderr, "kernel_launch: launch %d failed: %s\n", li, hipGetErrorName(le)); break; }
    }
}
```

```cpp
#include <hip/hip_runtime.h>
#include <hip/hip_bf16.h>
#include <cstdio>
#include <cstdint>
#include <cmath>
namespace pg8 {
#define PG8_LAS __attribute__((address_space(3)))
typedef unsigned short bf16_t;
typedef short bf16x8 __attribute__((ext_vector_type(8)));
typedef float f32x4 __attribute__((ext_vector_type(4)));
typedef unsigned u32x4 __attribute__((ext_vector_type(4)));
constexpr int BM = 256, BK = 64, HALF = 128, HTB = HALF * BK * 2  , STAGE_BYTES = 8 * HTB, NXCD = 8, WGM = 8;

__host__ __device__ __forceinline__ int lds_byte(int r, int c) { const int st = (r >> 4) * 2 + (c >> 5), rr = r & 15, cc = c & 31, ob = rr * 64 + cc * 2; return st * 1024 + (ob ^ (((ob >> 9) & 1) << 5)); }
__host__ __device__ __forceinline__ void stage_rc(int b, int& R, int& C) { const int st = b / 1024, sb = b % 1024, swz = sb ^ (((sb >> 9) & 1) << 5); R = (st >> 1) * 16 + swz / 64; C = (st & 1) * 32 + (swz % 64) / 2; }
__host__ __device__ __forceinline__ int perm32(int rho) { const int n = rho >> 4, i = rho & 15; return 8 * (i >> 2) + 4 * n + (i & 3); }

struct Unit { int pm, pn; };
struct Gemm { const bf16_t* A; const bf16_t* Bt; int M, N, K; };

struct StaticOrder {
    int nM, nN, nwg, G, c;
    __host__ __device__ void init(int M, int N, int G_, int c_) { nM = M / BM; nN = N / BM; nwg = nM * nN; G = G_; c = c_; }
    __host__ __device__ bool next(int i, Unit& u) const {
        const long L = (long)i * G + c; if (L >= nwg) return false;
        int wgid = (int)L; { const int q = nwg / NXCD, r = nwg % NXCD, xcd = wgid % NXCD, off = wgid / NXCD; wgid = (xcd < r ? xcd * (q + 1) : r * (q + 1) + (xcd - r) * q) + off; }
        const int nig = WGM * nN, gid = wgid / nig, fm = gid * WGM, gsz = (nM - fm) < WGM ? (nM - fm) : WGM;
        u.pm = fm + ((wgid % nig) % gsz); u.pn = (wgid % nig) / gsz; return true;
    }
    __device__ __forceinline__ void a_ready(const Unit&) const {}
    __device__ __forceinline__ void done(const Unit&) const {}
};

__device__ __forceinline__ unsigned cvt_pk_bf16(float lo, float hi) { unsigned r; asm volatile("v_cvt_pk_bf16_f32 %0, %1, %2" : "=v"(r) : "v"(lo), "v"(hi)); return r; }
__device__ __forceinline__ float sigm(float x) { return __builtin_amdgcn_rcpf(1.0f + __builtin_amdgcn_exp2f(-1.4426950408889634f * x)); }
typedef float f32x2 __attribute__((ext_vector_type(2)));
struct PkC { f32x2 nl, one;
    __device__ __forceinline__ PkC() { nl = (f32x2){-1.4426950408889634f, -1.4426950408889634f}; one = (f32x2){1.0f, 1.0f}; asm volatile("" : "+v"(nl), "+v"(one)); } };
__device__ __forceinline__ f32x2 pk_mul(f32x2 a, f32x2 b) { f32x2 d; asm("v_pk_mul_f32 %0, %1, %2" : "=v"(d) : "v"(a), "v"(b)); return d; }
__device__ __forceinline__ f32x2 pk_add(f32x2 a, f32x2 b) { f32x2 d; asm("v_pk_add_f32 %0, %1, %2" : "=v"(d) : "v"(a), "v"(b)); return d; }
__device__ __forceinline__ f32x4 sigm4(f32x4 x, const PkC& c) {
    const f32x2 m0 = pk_mul(__builtin_shufflevector(x, x, 0, 1), c.nl), m1 = pk_mul(__builtin_shufflevector(x, x, 2, 3), c.nl);
    f32x2 t0, t1; t0[0] = __builtin_amdgcn_exp2f(m0[0]); t0[1] = __builtin_amdgcn_exp2f(m0[1]); t1[0] = __builtin_amdgcn_exp2f(m1[0]); t1[1] = __builtin_amdgcn_exp2f(m1[1]);
    const f32x2 d0 = pk_add(t0, c.one), d1 = pk_add(t1, c.one);
    f32x4 r; r[0] = __builtin_amdgcn_rcpf(d0[0]); r[1] = __builtin_amdgcn_rcpf(d0[1]); r[2] = __builtin_amdgcn_rcpf(d1[0]); r[3] = __builtin_amdgcn_rcpf(d1[1]);
    return r; }
__device__ __forceinline__ f32x4 swiglu4(f32x4 g, f32x4 up, const PkC& c) { return (g * up) * sigm4(g, c); }
struct EpiSwiglu {
    static constexpr int ID = 20;
    static constexpr int RELAX = 0;
    static constexpr bool PERM = true, AFTER_DRAIN = false, PREF = false;
    bf16_t* O; int ldc;
    __device__ __forceinline__ void operator()(const f32x4 (&acc)[2][2][4][2], const Unit& u, int wr, int wc, int fr, int fq) const {
        const int row0 = u.pm * BM + wr * 64 + fr, col0 = u.pn * HALF + wc * 32 + 8 * fq;
        const PkC pkc;
#pragma unroll
        for (int ai = 0; ai < 2; ++ai)
#pragma unroll
            for (int m = 0; m < 4; ++m) { bf16_t* rowp = O + (size_t)(row0 + ai * HALF + m * 16) * ldc + col0;
                const f32x4 o0 = swiglu4(acc[ai][0][m][0], acc[ai][1][m][0], pkc), o1 = swiglu4(acc[ai][0][m][1], acc[ai][1][m][1], pkc);
                u32x4 w; w.x = cvt_pk_bf16(o0[0], o0[1]); w.y = cvt_pk_bf16(o0[2], o0[3]); w.z = cvt_pk_bf16(o1[0], o1[1]); w.w = cvt_pk_bf16(o1[2], o1[3]);
                *(u32x4*)rowp = w; }
    }
};
struct EpiG3 {
    static constexpr int ID = 21;
    static constexpr int RELAX = 0;
    static constexpr bool PERM = true, AFTER_DRAIN = false, PREF = false;
    bf16_t* ZG; bf16_t* ZC;
    __device__ __forceinline__ void operator()(const f32x4 (&acc)[2][2][4][2], const Unit& u, int wr, int wc, int fr, int fq) const {
        const int row0 = u.pm * BM + wr * 64 + fr;
        if (u.pn < 4) {
            const int col0 = u.pn * HALF + wc * 32 + 8 * fq;
#pragma unroll
            for (int ai = 0; ai < 2; ++ai)
#pragma unroll
                for (int m = 0; m < 4; ++m) { bf16_t* rowp = ZG + (size_t)(row0 + ai * HALF + m * 16) * 512 + col0;
                    float o[8];
#pragma unroll
                    for (int n = 0; n < 2; ++n)
#pragma unroll
                        for (int e = 0; e < 4; ++e) o[4 * n + e] = acc[ai][0][m][n][e] * sigm(acc[ai][1][m][n][e]);
                    u32x4 w; w.x = cvt_pk_bf16(o[0], o[1]); w.y = cvt_pk_bf16(o[2], o[3]); w.z = cvt_pk_bf16(o[4], o[5]); w.w = cvt_pk_bf16(o[6], o[7]);
                    *(u32x4*)rowp = w; }
        } else {
            const int col0 = (u.pn - 4) * BM + wc * 32 + 8 * fq;
#pragma unroll
            for (int ai = 0; ai < 2; ++ai)
#pragma unroll
                for (int m = 0; m < 4; ++m) { bf16_t* rowp = ZC + (size_t)(row0 + ai * HALF + m * 16) * 512 + col0;
#pragma unroll
                    for (int bj = 0; bj < 2; ++bj) { const f32x4 v0 = acc[ai][bj][m][0], v1 = acc[ai][bj][m][1];
                        u32x4 w; w.x = cvt_pk_bf16(v0[0], v0[1]); w.y = cvt_pk_bf16(v0[2], v0[3]); w.z = cvt_pk_bf16(v1[0], v1[1]); w.w = cvt_pk_bf16(v1[2], v1[3]);
                        *(u32x4*)(rowp + bj * HALF) = w; } }
        }
    }
};
struct EpiResid {
    static constexpr int ID = 22;
    static constexpr int RELAX = 0;
    static constexpr bool PERM = false, AFTER_DRAIN = false, PREF = false;
    const float* res; float* out; const float* gate; float coef;
    __device__ __forceinline__ void operator()(const f32x4 (&acc)[2][2][4][2], const Unit& u, int wr, int wc, int fr, int fq) const {
        const int row0 = u.pm * BM + wr * 64 + fr, col0 = u.pn * BM + wc * 32 + 4 * fq;
        const float* gp = gate + (size_t)(u.pm >> 3) * 9216 + col0;
        f32x4 gv[2][2];
#pragma unroll
        for (int bj = 0; bj < 2; ++bj)
#pragma unroll
            for (int n = 0; n < 2; ++n) gv[bj][n] = *(const f32x4*)(gp + bj * HALF + n * 16) * coef;
#pragma unroll
        for (int ai = 0; ai < 2; ++ai)
#pragma unroll
            for (int m = 0; m < 4; ++m) { const size_t off = (size_t)(row0 + ai * HALF + m * 16) * 1024 + col0;
                f32x4 r[2][2];
#pragma unroll
                for (int bj = 0; bj < 2; ++bj)
#pragma unroll
                    for (int n = 0; n < 2; ++n) r[bj][n] = *(const f32x4*)(res + off + bj * HALF + n * 16);
#pragma unroll
                for (int bj = 0; bj < 2; ++bj)
#pragma unroll
                    for (int n = 0; n < 2; ++n) *(f32x4*)(out + off + bj * HALF + n * 16) = r[bj][n] + gv[bj][n] * acc[ai][bj][m][n];
                if (m & 1) asm volatile("" ::: "memory"); }
    }
};

constexpr float PG_EPS = 1e-6f;
__device__ __forceinline__ f32x4 ada_scale(f32x4 v) { f32x4 r;
#pragma unroll
    for (int e = 0; e < 4; ++e) { const float x = 1.0f + v[e]; r[e] = fabsf(x) < 9.5367431640625e-07f ? (x < 0.f ? -9.5367431640625e-07f : 9.5367431640625e-07f) : x; }
    return r; }
template <bool HALFC, int RMODE, bool WAN, bool WH> struct EpiResidNorm {
    static constexpr int ID = HALFC ? 2 : 3;
    static constexpr int RELAX = 16 * ((WAN ? 1 : 0) + (WH ? 1 : 0));
    static constexpr bool PERM = true, AFTER_DRAIN = false, PREF = false;
    const void* res; bf16_t* hout; const float* gate; int sc_delta; int sp_delta; bf16_t* AN; float* ss;
    __device__ __forceinline__ void operator()(const f32x4 (&acc)[2][2][4][2], const Unit& u, int wr, int wc, int fr, int fq) const { run<true>(acc, u, wr, wc, fr, fq); }
    template <bool ATOM> __device__ __forceinline__ void run(const f32x4 (&acc)[2][2][4][2], const Unit& u, int wr, int wc, int fr, int fq) const {
        const int row0 = u.pm * BM + wr * 64 + fr, col0 = u.pn * BM + wc * 32 + 8 * fq;
        const float* gp = gate + (size_t)(u.pm >> 3) * 9216 + col0; constexpr float coef = HALFC ? 0.5f : 1.0f;
        f32x4 gv[2][2], sv[2][2], iv[2][2];
#pragma unroll
        for (int bj = 0; bj < 2; ++bj)
#pragma unroll
            for (int n = 0; n < 2; ++n) { gv[bj][n] = *(const f32x4*)(gp + bj * HALF + n * 4) * coef;
                if constexpr (WAN) sv[bj][n] = ada_scale(*(const f32x4*)(gp + sc_delta + bj * HALF + n * 4));
                if constexpr (RMODE == 2) { const f32x4 p = ada_scale(*(const f32x4*)(gp + sp_delta + bj * HALF + n * 4)); iv[bj][n] = (f32x4){__builtin_amdgcn_rcpf(p[0]), __builtin_amdgcn_rcpf(p[1]), __builtin_amdgcn_rcpf(p[2]), __builtin_amdgcn_rcpf(p[3])}; } }
        constexpr int PD = (RMODE == 2) ? 2 : 1;
        u32x4 rw[8][2]; f32x4 rf[8][2][2];
#define RES_LOAD(i) do { const size_t off_ = (size_t)(row0 + ((i) >> 2) * HALF + ((i) & 3) * 16) * 1024 + col0; \
            _Pragma("unroll") for (int bj = 0; bj < 2; ++bj) { \
                if constexpr (RMODE == 2) rw[i][bj] = *(const u32x4*)((const bf16_t*)res + off_ + bj * HALF); \
                else { rf[i][bj][0] = *(const f32x4*)((const float*)res + off_ + bj * HALF); rf[i][bj][1] = *(const f32x4*)((const float*)res + off_ + bj * HALF + 4); } } } while (0)
#pragma unroll
        for (int i = 0; i < PD; ++i) RES_LOAD(i);
#pragma unroll
        for (int i = 0; i < 8; ++i) {
            if (i + PD < 8) RES_LOAD(i + PD);
            const int ai = i >> 2, m = i & 3;
            const int row = row0 + ai * HALF + m * 16; const size_t off = (size_t)row * 1024 + col0;
            float q = 0.f;
#pragma unroll
            for (int bj = 0; bj < 2; ++bj) {
                f32x4 r0, r1;
                if constexpr (RMODE == 2) { const u32x4 w = rw[i][bj];
                    r0 = (f32x4){__uint_as_float(w.x << 16), __uint_as_float(w.x & 0xffff0000u), __uint_as_float(w.y << 16), __uint_as_float(w.y & 0xffff0000u)} * iv[bj][0];
                    r1 = (f32x4){__uint_as_float(w.z << 16), __uint_as_float(w.z & 0xffff0000u), __uint_as_float(w.w << 16), __uint_as_float(w.w & 0xffff0000u)} * iv[bj][1]; }
                else { r0 = rf[i][bj][0]; r1 = rf[i][bj][1]; }
                const f32x4 o0 = r0 + gv[bj][0] * acc[ai][bj][m][0], o1 = r1 + gv[bj][1] * acc[ai][bj][m][1];
                if constexpr (WH) { u32x4 hw; hw.x = cvt_pk_bf16(o0[0], o0[1]); hw.y = cvt_pk_bf16(o0[2], o0[3]); hw.z = cvt_pk_bf16(o1[0], o1[1]); hw.w = cvt_pk_bf16(o1[2], o1[3]);
                    *(u32x4*)(hout + off + bj * HALF) = hw; }
                q += (o0[0] * o0[0] + o0[1] * o0[1]) + (o0[2] * o0[2] + o0[3] * o0[3]) + (o1[0] * o1[0] + o1[1] * o1[1]) + (o1[2] * o1[2] + o1[3] * o1[3]);
                if constexpr (WAN) { const f32x4 a0 = o0 * sv[bj][0], a1 = o1 * sv[bj][1];
                    u32x4 w; w.x = cvt_pk_bf16(a0[0], a0[1]); w.y = cvt_pk_bf16(a0[2], a0[3]); w.z = cvt_pk_bf16(a1[0], a1[1]); w.w = cvt_pk_bf16(a1[2], a1[3]);
                    *(u32x4*)(AN + off + bj * HALF) = w; } }
            { auto r16 = __builtin_amdgcn_permlane16_swap(__float_as_uint(q), __float_as_uint(q), false, false); q = __uint_as_float(r16[0]) + __uint_as_float(r16[1]); }
            { auto r32 = __builtin_amdgcn_permlane32_swap(__float_as_uint(q), __float_as_uint(q), false, false); q = __uint_as_float(r32[0]) + __uint_as_float(r32[1]); }
            if (ATOM && fq == 0) (void)__hip_atomic_fetch_add((__attribute__((address_space(1))) float*)(ss + row), q, __ATOMIC_RELAXED, __HIP_MEMORY_SCOPE_AGENT);
            asm volatile("" ::: "memory");
        }
#undef RES_LOAD
    }
};
template <bool HALFC> struct EpiResidOut {
    static constexpr int ID = 26;
    static constexpr int RELAX = 0;
    static constexpr bool PERM = true, AFTER_DRAIN = false, PREF = false;
    const bf16_t* res; float* out; const float* gate;
    __device__ __forceinline__ void operator()(const f32x4 (&acc)[2][2][4][2], const Unit& u, int wr, int wc, int fr, int fq) const {
        const int row0 = u.pm * BM + wr * 64 + fr, col0 = u.pn * BM + wc * 32 + 8 * fq;
        const float* gp = gate + (size_t)(u.pm >> 3) * 9216 + col0; constexpr float coef = HALFC ? 0.5f : 1.0f;
        f32x4 gv[2][2];
#pragma unroll
        for (int bj = 0; bj < 2; ++bj)
#pragma unroll
            for (int n = 0; n < 2; ++n) gv[bj][n] = *(const f32x4*)(gp + bj * HALF + n * 4) * coef;
#pragma unroll
        for (int ai = 0; ai < 2; ++ai) {
            u32x4 rw[4][2];
#pragma unroll
            for (int m = 0; m < 4; ++m) { const size_t off = (size_t)(row0 + ai * HALF + m * 16) * 1024 + col0;
#pragma unroll
                for (int bj = 0; bj < 2; ++bj) rw[m][bj] = *(const u32x4*)(res + off + bj * HALF); }
#pragma unroll
            for (int m = 0; m < 4; ++m) { const size_t off = (size_t)(row0 + ai * HALF + m * 16) * 1024 + col0;
#pragma unroll
                for (int bj = 0; bj < 2; ++bj) { const u32x4 w = rw[m][bj];
                    const f32x4 r0 = {__uint_as_float(w.x << 16), __uint_as_float(w.x & 0xffff0000u), __uint_as_float(w.y << 16), __uint_as_float(w.y & 0xffff0000u)};
                    const f32x4 r1 = {__uint_as_float(w.z << 16), __uint_as_float(w.z & 0xffff0000u), __uint_as_float(w.w << 16), __uint_as_float(w.w & 0xffff0000u)};
                    *(f32x4*)(out + off + bj * HALF) = r0 + gv[bj][0] * acc[ai][bj][m][0]; *(f32x4*)(out + off + bj * HALF + 4) = r1 + gv[bj][1] * acc[ai][bj][m][1]; } }
            asm volatile("" ::: "memory"); }
    }
};
struct EpiSwigluN {
    static constexpr int ID = 1;
    static constexpr int RELAX = 8;
    static constexpr bool PERM = true, AFTER_DRAIN = false, PREF = true;
    bf16_t* O; int ldc; const float* ss; const float* bias; int nb;
    __device__ __forceinline__ float prefetch(const Unit& u, int tid) const {
        return tid < 256 ? ss[u.pm * BM + tid] : bias[(size_t)(u.pm >> 3) * nb + u.pn * BM + (tid - 256)]; }
    __device__ __forceinline__ void operator()(const f32x4 (&acc)[2][2][4][2], const Unit& u, int wr, int wc, int fr, int fq, float pre, PG8_LAS float* sp) const {
        const int tid = threadIdx.x;
        sp[tid] = tid < 256 ? __builtin_amdgcn_rsqf(pre * (1.0f / 1024.0f) + PG_EPS) : pre;
        asm volatile("s_waitcnt lgkmcnt(0)" ::: "memory"); __builtin_amdgcn_s_barrier(); asm volatile("" ::: "memory");
        const int row0 = u.pm * BM + wr * 64 + fr, col0 = u.pn * HALF + wc * 32 + 8 * fq;
        const PkC pkc;
        f32x4 bv[2][2];
#pragma unroll
        for (int bj = 0; bj < 2; ++bj)
#pragma unroll
            for (int n = 0; n < 2; ++n) bv[bj][n] = *(const PG8_LAS f32x4*)(sp + 256 + bj * HALF + wc * 32 + 8 * fq + n * 4);
#pragma unroll
        for (int ai = 0; ai < 2; ++ai)
#pragma unroll
            for (int m = 0; m < 4; ++m) { const int rl = ai * HALF + wr * 64 + m * 16 + fr; bf16_t* rowp = O + (size_t)(u.pm * BM + rl) * ldc + col0;
                const float rs = sp[rl];
                const f32x4 o0 = swiglu4(acc[ai][0][m][0] * rs + bv[0][0], acc[ai][1][m][0] * rs + bv[1][0], pkc), o1 = swiglu4(acc[ai][0][m][1] * rs + bv[0][1], acc[ai][1][m][1] * rs + bv[1][1], pkc);
                u32x4 w; w.x = cvt_pk_bf16(o0[0], o0[1]); w.y = cvt_pk_bf16(o0[2], o0[3]); w.z = cvt_pk_bf16(o1[0], o1[1]); w.w = cvt_pk_bf16(o1[2], o1[3]);
                *(u32x4*)rowp = w; }
        (void)row0;
    }
};
struct EpiG3N {
    static constexpr int ID = 23;
    static constexpr int RELAX = 0;
    static constexpr bool PERM = true, AFTER_DRAIN = false, PREF = true;
    bf16_t* ZGb; bf16_t* ZCb; const float* ss; const float* bias; size_t dzg, dzc;
    __device__ __forceinline__ float prefetch(const Unit& u, int tid) const {
        return tid < 256 ? ss[u.pm * BM + tid] : bias[(size_t)(u.pm >> 3) * 1536 + u.pn * BM + (tid - 256)]; }
    __device__ __forceinline__ void operator()(const f32x4 (&acc)[2][2][4][2], const Unit& u, int wr, int wc, int fr, int fq, float pre, PG8_LAS float* sp) const {
        { const int tid = threadIdx.x; sp[tid] = tid < 256 ? __builtin_amdgcn_rsqf(pre * (1.0f / 1024.0f) + PG_EPS) : pre; }
        asm volatile("s_waitcnt lgkmcnt(0)" ::: "memory"); __builtin_amdgcn_s_barrier(); asm volatile("" ::: "memory");
        const int row0 = u.pm * BM + wr * 64 + fr;
        bf16_t* const ZG = ZGb + (size_t)(u.pm >> 4) * dzg; bf16_t* const ZC = ZCb + (size_t)(u.pm >> 4) * dzc;
        f32x4 bv[2][2];
#pragma unroll
        for (int bj = 0; bj < 2; ++bj)
#pragma unroll
            for (int n = 0; n < 2; ++n) bv[bj][n] = *(const PG8_LAS f32x4*)(sp + 256 + bj * HALF + wc * 32 + 8 * fq + n * 4);
        if (u.pn < 4) {
            const PkC pkc;
            const int col0 = u.pn * HALF + wc * 32 + 8 * fq;
#pragma unroll
            for (int ai = 0; ai < 2; ++ai)
#pragma unroll
                for (int m = 0; m < 4; ++m) { const int row = row0 + ai * HALF + m * 16; bf16_t* rowp = ZG + (size_t)row * 512 + col0;
                    const float rs = sp[row - u.pm * BM];
                    const f32x4 o0 = (acc[ai][0][m][0] * rs + bv[0][0]) * sigm4(acc[ai][1][m][0] * rs + bv[1][0], pkc), o1 = (acc[ai][0][m][1] * rs + bv[0][1]) * sigm4(acc[ai][1][m][1] * rs + bv[1][1], pkc);
                    u32x4 w; w.x = cvt_pk_bf16(o0[0], o0[1]); w.y = cvt_pk_bf16(o0[2], o0[3]); w.z = cvt_pk_bf16(o1[0], o1[1]); w.w = cvt_pk_bf16(o1[2], o1[3]);
                    *(u32x4*)rowp = w; }
        } else {
            const int col0 = (u.pn - 4) * BM + wc * 32 + 8 * fq;
#pragma unroll
            for (int ai = 0; ai < 2; ++ai)
#pragma unroll
                for (int m = 0; m < 4; ++m) { const int row = row0 + ai * HALF + m * 16;
                    const float rs = sp[row - u.pm * BM];
#pragma unroll
                    for (int bj = 0; bj < 2; ++bj) { const f32x4 v0 = acc[ai][bj][m][0] * rs + bv[bj][0], v1 = acc[ai][bj][m][1] * rs + bv[bj][1];
                        u32x4 w; w.x = cvt_pk_bf16(v0[0], v0[1]); w.y = cvt_pk_bf16(v0[2], v0[3]); w.z = cvt_pk_bf16(v1[0], v1[1]); w.w = cvt_pk_bf16(v1[2], v1[3]);
                        const int c8 = col0 + bj * HALF, kb = c8 >> 4;
                        if (kb < 26) *(u32x4*)((char*)ZC + ((size_t)((row >> 5) * 26 + kb) * 1024 + ((c8 >> 3) & 1) * 512 + (row & 31) * 16)) = w; } }
        }
    }
};

template <class Epi, class Sched, bool ALIGN_EPI = false, bool SP2 = false>
__device__ __forceinline__ void gemm_phase(PG8_LAS unsigned char* lds, const Gemm g, const Sched& S, const Epi& E) {
    const int tid = threadIdx.x, wid = __builtin_amdgcn_readfirstlane(tid >> 6), lane = tid & 63, wr = wid >> 2, wc = wid & 3, fr = lane & 15, fq = lane >> 4;
    const int K = g.K, nt = K / BK;
    unsigned voffA[2], voffB[2];
#pragma unroll
    for (int i = 0; i < 2; ++i) { int R, C; stage_rc(tid * 16 + i * 8192, R, C); const int Rb = Epi::PERM ? ((R & ~31) + perm32(R & 31)) : R;
        voffA[i] = (unsigned)(R * K + C) * 2u; voffB[i] = (unsigned)(Rb * K + C) * 2u; }
    const size_t kstep = (size_t)(BK * 2);
    const size_t hstep = (size_t)HALF * K * 2;
    const size_t tstep = 2 * hstep;
    const unsigned ldsw = (unsigned)wid * 1024u;
    const int aoff = lds_byte(wr * 64 + fr, fq * 8), boff = lds_byte(wc * 32 + fr, fq * 8);
#define PG8_SA(b, h) (((b) * 2 + (h)) * HTB)
#define PG8_SB(b, h) ((4 + (b) * 2 + (h)) * HTB)
#define PG8_STAGE(bufoff, gbase, voff) do { _Pragma("unroll") for (int _i = 0; _i < 2; ++_i) \
        __builtin_amdgcn_global_load_lds((const unsigned*)((const char*)(gbase) + (voff)[_i]), (PG8_LAS unsigned*)(lds + (bufoff) + ldsw + _i * 8192), 16, 0, 0); } while (0)
#define PG8_LDA(dst, b, h) do { _Pragma("unroll") for (int m = 0; m < 4; ++m) _Pragma("unroll") for (int k = 0; k < 2; ++k) dst[m][k] = *(const PG8_LAS bf16x8*)(lds + PG8_SA(b, h) + aoff + m * 2048 + k * 1024); } while (0)
#define PG8_LDB(dst, b, h) do { _Pragma("unroll") for (int n = 0; n < 2; ++n) _Pragma("unroll") for (int k = 0; k < 2; ++k) dst[n][k] = *(const PG8_LAS bf16x8*)(lds + PG8_SB(b, h) + boff + n * 2048 + k * 1024); } while (0)
#define PG8_MMA(ai, bj, At, Bt) do { __builtin_amdgcn_s_setprio(1); _Pragma("unroll") for (int m = 0; m < 4; ++m) _Pragma("unroll") for (int n = 0; n < 2; ++n) _Pragma("unroll") for (int k = 0; k < 2; ++k) \
        acc[ai][bj][m][n] = __builtin_amdgcn_mfma_f32_16x16x32_bf16(Bt[n][k], At[m][k], acc[ai][bj][m][n], 0, 0, 0); __builtin_amdgcn_s_setprio(0); } while (0)
#define PG8_WAIT_V(n) asm volatile("s_waitcnt vmcnt(" #n ")" ::: "memory")
#define PG8_WAIT_L(n) asm volatile("s_waitcnt lgkmcnt(" #n ")" ::: "memory")
#define PG8_WAIT_VR(f) do { if constexpr (Epi::RELAX > 0) asm volatile("s_cmp_lg_u32 %0, 0\n\ts_cbranch_scc1 1f\n\ts_waitcnt vmcnt(8)\n\ts_branch 2f\n1:\n\ts_waitcnt vmcnt(%1)\n2:" :: "s"(f), "n"(8 + Epi::RELAX) : "memory", "scc"); else PG8_WAIT_V(8); } while (0)
#define PG8_BAR __builtin_amdgcn_s_barrier()
#define PG8_SCHED __builtin_amdgcn_sched_barrier(0)
    Unit cur, nxt; int ui = 0;
    if (!S.next(0, cur)) return;
    float epre = 0.f; if constexpr (Epi::PREF) epre = E.prefetch(cur, tid);
    f32x4 acc[2][2][4][2];
#pragma unroll
    for (int a = 0; a < 2; ++a)
#pragma unroll
        for (int b = 0; b < 2; ++b)
#pragma unroll
            for (int m = 0; m < 4; ++m)
#pragma unroll
                for (int n = 0; n < 2; ++n) acc[a][b][m][n] = (f32x4){0.f, 0.f, 0.f, 0.f};
    bf16x8 At[4][2], B0[2][2], B1[2][2];
    const char* cA = (const char*)g.A + (size_t)cur.pm * tstep; const char* cB = (const char*)g.Bt + (size_t)cur.pn * tstep;
    S.a_ready(cur);
    if constexpr (SP2) {
        PG8_STAGE(PG8_SB(0, 0), cB, voffB); PG8_STAGE(PG8_SB(0, 1), cB + hstep, voffB); PG8_STAGE(PG8_SA(0, 0), cA, voffA); PG8_STAGE(PG8_SA(0, 1), cA + hstep, voffA);
        if (wr == 1) PG8_BAR;
        PG8_WAIT_V(2); PG8_BAR;
        PG8_STAGE(PG8_SB(1, 0), cB + kstep, voffB); PG8_STAGE(PG8_SA(1, 0), cA + kstep, voffA); PG8_STAGE(PG8_SB(1, 1), cB + hstep + kstep, voffB);
        PG8_WAIT_V(6); PG8_BAR;
    } else {
        PG8_STAGE(PG8_SB(0, 0), cB, voffB); PG8_STAGE(PG8_SA(0, 0), cA, voffA); PG8_STAGE(PG8_SB(0, 1), cB + hstep, voffB); PG8_STAGE(PG8_SA(0, 1), cA + hstep, voffA);
        if (wr == 1) PG8_BAR;
        PG8_WAIT_V(4); PG8_BAR;
        PG8_STAGE(PG8_SB(1, 0), cB + kstep, voffB); PG8_STAGE(PG8_SA(1, 0), cA + kstep, voffA); PG8_STAGE(PG8_SB(1, 1), cB + hstep + kstep, voffB);
        PG8_WAIT_V(6); PG8_BAR;
    }
    for (;;) {
        const bool has_next = S.next(ui + 1, nxt);
        const char* nA = has_next ? (const char*)g.A + (size_t)nxt.pm * tstep : cA; const char* nB = has_next ? (const char*)g.Bt + (size_t)nxt.pn * tstep : cB;
        for (int t = 0; t < nt; t += 2) {
            const bool last = (t == nt - 2);
            const int rlx = __builtin_amdgcn_readfirstlane((t == 0 && ui > 0) ? 1 : 0);
            const char* a1 = cA + (size_t)(t + 1) * kstep;
            const char* a2 = last ? nA : cA + (size_t)(t + 2) * kstep; const char* b2 = last ? nB : cB + (size_t)(t + 2) * kstep;
            const char* a3 = a2 + kstep; const char* b3 = b2 + kstep;
            if (last && has_next) S.a_ready(nxt);
            if constexpr (SP2) {
            PG8_LDB(B0, 0, 0); PG8_LDB(B1, 0, 1); PG8_SCHED; PG8_LDA(At, 0, 0); PG8_STAGE(PG8_SA(1, 1), a1 + hstep, voffA);
            PG8_WAIT_VR(rlx); PG8_WAIT_L(0); PG8_BAR; PG8_MMA(0, 0, At, B0); PG8_MMA(0, 1, At, B1); PG8_BAR; PG8_SCHED;
            PG8_LDA(At, 0, 1); PG8_STAGE(PG8_SB(0, 0), b2, voffB); PG8_STAGE(PG8_SB(0, 1), b2 + hstep, voffB); PG8_STAGE(PG8_SA(0, 0), a2, voffA);
            PG8_WAIT_VR(rlx); PG8_WAIT_L(0); PG8_BAR; PG8_MMA(1, 0, At, B0); PG8_MMA(1, 1, At, B1); PG8_BAR; PG8_SCHED;
            PG8_LDB(B0, 1, 0); PG8_LDB(B1, 1, 1); PG8_SCHED; PG8_LDA(At, 1, 0); PG8_STAGE(PG8_SA(0, 1), a2 + hstep, voffA);
            PG8_WAIT_V(8); PG8_WAIT_L(0); PG8_BAR; PG8_MMA(0, 0, At, B0); PG8_MMA(0, 1, At, B1); PG8_BAR; PG8_SCHED;
            PG8_LDA(At, 1, 1); PG8_STAGE(PG8_SB(1, 0), b3, voffB); PG8_STAGE(PG8_SB(1, 1), b3 + hstep, voffB); PG8_STAGE(PG8_SA(1, 0), a3, voffA);
            PG8_WAIT_V(8); PG8_WAIT_L(0); PG8_BAR; PG8_MMA(1, 0, At, B0); PG8_MMA(1, 1, At, B1); PG8_BAR; PG8_SCHED;
            } else {
            PG8_LDB(B0, 0, 0); PG8_SCHED; PG8_LDA(At, 0, 0); PG8_STAGE(PG8_SA(1, 1), a1 + hstep, voffA);
            PG8_WAIT_L(8); PG8_BAR; PG8_WAIT_L(0); PG8_MMA(0, 0, At, B0); PG8_BAR; PG8_SCHED;
            PG8_LDB(B1, 0, 1); PG8_STAGE(PG8_SB(0, 0), b2, voffB);
            PG8_BAR; PG8_WAIT_L(0); PG8_MMA(0, 1, At, B1); PG8_BAR;
            PG8_LDA(At, 0, 1); PG8_STAGE(PG8_SA(0, 0), a2, voffA);
            PG8_BAR; PG8_WAIT_L(0); PG8_MMA(1, 0, At, B0); PG8_BAR; PG8_SCHED;
            PG8_STAGE(PG8_SB(0, 1), b2 + hstep, voffB);
            PG8_WAIT_V(6); PG8_BAR; PG8_MMA(1, 1, At, B1); PG8_BAR;
            PG8_LDB(B0, 1, 0); PG8_SCHED; PG8_LDA(At, 1, 0); PG8_STAGE(PG8_SA(0, 1), a2 + hstep, voffA);
            PG8_WAIT_L(8); PG8_BAR; PG8_WAIT_L(0); PG8_MMA(0, 0, At, B0); PG8_BAR; PG8_SCHED;
            PG8_LDB(B1, 1, 1); PG8_STAGE(PG8_SB(1, 0), b3, voffB);
            PG8_BAR; PG8_WAIT_L(0); PG8_MMA(0, 1, At, B1); PG8_BAR;
            PG8_LDA(At, 1, 1); PG8_STAGE(PG8_SA(1, 0), a3, voffA);
            PG8_BAR; PG8_WAIT_L(0); PG8_MMA(1, 0, At, B0); PG8_BAR; PG8_SCHED;
            PG8_STAGE(PG8_SB(1, 1), b3 + hstep, voffB);
            PG8_WAIT_V(6); PG8_BAR; PG8_MMA(1, 1, At, B1); PG8_BAR;
            }
        }
        if constexpr (ALIGN_EPI) { if (wr == 0) PG8_BAR; }
        if constexpr (!Epi::AFTER_DRAIN) { if constexpr (Epi::PREF) E(acc, cur, wr, wc, fr, fq, epre, (PG8_LAS float*)(lds + STAGE_BYTES)); else E(acc, cur, wr, wc, fr, fq);
#ifdef EPI_REP_DISABLED
            if constexpr (((EPI_REP >> Epi::ID) & 1) != 0) { asm volatile("" ::: "memory"); if constexpr (Epi::ID == 2) E.template run<false>(acc, cur, wr, wc, fr, fq); else E(acc, cur, wr, wc, fr, fq); }
#endif
            S.done(cur); }
        if (!has_next) break;
#pragma unroll
        for (int a = 0; a < 2; ++a)
#pragma unroll
            for (int b = 0; b < 2; ++b)
#pragma unroll
                for (int m = 0; m < 4; ++m)
#pragma unroll
                    for (int n = 0; n < 2; ++n) acc[a][b][m][n] = (f32x4){0.f, 0.f, 0.f, 0.f};
        cur = nxt; cA = nA; cB = nB; ++ui;
        if constexpr (Epi::PREF) epre = E.prefetch(cur, tid);
        if constexpr (ALIGN_EPI) { if (wr == 1) PG8_BAR; }
    }
    PG8_WAIT_V(0);
    if constexpr (!ALIGN_EPI) { if (wr == 0) PG8_BAR; }
    PG8_BAR;
    if constexpr (Epi::AFTER_DRAIN) { E.fused(acc, cur, wr, wc, fr, fq, lds, wid, lane); S.done(cur); }
#undef PG8_SA
#undef PG8_SB
#undef PG8_STAGE
#undef PG8_LDA
#undef PG8_LDB
#undef PG8_MMA
#undef PG8_WAIT_V
#undef PG8_WAIT_VR
#undef PG8_WAIT_L
#undef PG8_BAR
#undef PG8_SCHED
}
}
namespace att {
using bf16x8 = __attribute__((ext_vector_type(8))) short;
using s16x4  = __attribute__((ext_vector_type(4))) short;
using f32x16 = __attribute__((ext_vector_type(16))) float;
using u32x4  = __attribute__((ext_vector_type(4))) unsigned;
typedef unsigned short bf16_t;
constexpr int DQK = 96, DV = 64, NW = 8, QBLK = 32, KVBLK = 64;
constexpr float QSCALE = 0.10206207261596575f * 1.4426950408889634f;
constexpr float THRL = 11.5f;
constexpr int SHM_V = KVBLK * DV * 2, SHM_K = KVBLK * 256;
constexpr int OST_W = 32 * 144;
constexpr int OFF_V = 0, OFF_K = 2 * SHM_V, OFF_OST = OFF_K + 2 * SHM_K, SHM_ATTN = OFF_OST + NW * OST_W;
#define KSWZ(row, colB) ((row) * 256 + ((colB) ^ (((row) & 15) << 4)))
#define SBAR() __builtin_amdgcn_sched_barrier(0)
__device__ __forceinline__ int crow(int r, int hi) { return (r & 3) + 8 * (r >> 2) + 4 * hi; }
__device__ __forceinline__ unsigned cvtpk(float lo, float hi) { unsigned r; asm volatile("v_cvt_pk_bf16_f32 %0, %1, %2" : "=v"(r) : "v"(lo), "v"(hi)); return r; }
typedef __bf16 bf16n2 __attribute__((ext_vector_type(2)));
typedef float f32n2 __attribute__((ext_vector_type(2)));
__device__ __forceinline__ unsigned cvtpk_n(float lo, float hi) { const f32n2 v = {lo, hi}; return __builtin_bit_cast(unsigned, __builtin_convertvector(v, bf16n2)); }
__device__ __forceinline__ bf16x8 ld8(const bf16_t* p) { return *reinterpret_cast<const bf16x8*>(p); }
__device__ __forceinline__ float max3(float a, float b, float c) { return fmaxf(fmaxf(a, b), c); }

template <bool FIRST, int ABL = 0> __device__ __forceinline__ void partialSM(f32x16& p0, f32x16& p1, float& mref, float& alpha) {
  if constexpr (ABL & 1) { alpha = 1.f; return; }
  float a = max3(p0[0], p0[1], p0[2]), b = max3(p1[0], p1[1], p1[2]);
#pragma unroll
  for (int r = 3; r < 15; r += 2) { a = max3(a, p0[r], p0[r + 1]); b = max3(b, p1[r], p1[r + 1]); }
  float pmax = max3(a, b, fmaxf(p0[15], p1[15]));
  { auto rr = __builtin_amdgcn_permlane32_swap(__float_as_uint(pmax), __float_as_uint(pmax), false, false);
    pmax = fmaxf(__uint_as_float(rr[0]), __uint_as_float(rr[1])); }
  pmax -= mref;
  if (__builtin_expect(__all(FIRST ? (fabsf(pmax) <= THRL) : (pmax <= THRL)), 1)) { alpha = 1.f; }
  else { const float dl = FIRST ? pmax : fmaxf(pmax, 0.f); mref += dl; alpha = __builtin_amdgcn_exp2f(-dl); }
  if (__any(mref != 0.f)) {
#pragma unroll
    for (int r = 0; r < 16; ++r) { p0[r] -= mref; p1[r] -= mref; } }
#pragma unroll
  for (int r = 0; r < 16; ++r) p0[r] = __builtin_amdgcn_exp2f(p0[r]);
}
template <int ABL = 0> __device__ __forceinline__ void finishSM(f32x16& p0, f32x16& p1, float alpha, float& l_reg, bf16x8& pa0, bf16x8& pa1, bf16x8& pa2, bf16x8& pa3) {
  if constexpr (!(ABL & 1)) {
#pragma unroll
  for (int r = 0; r < 16; ++r) p1[r] = __builtin_amdgcn_exp2f(p1[r]);
  float ps0 = 0.f, ps1 = 0.f;
#pragma unroll
  for (int r = 0; r < 16; ++r) { ps0 += p0[r]; ps1 += p1[r]; }
  l_reg = l_reg * alpha + (ps0 + ps1); } else { l_reg = 1.f; }
#define PK8(P, BASE, OUT) do { u32x4 w = {cvtpk(P[BASE + 0], P[BASE + 1]), cvtpk(P[BASE + 2], P[BASE + 3]), cvtpk(P[BASE + 4], P[BASE + 5]), cvtpk(P[BASE + 6], P[BASE + 7])}; \
    OUT = *reinterpret_cast<bf16x8*>(&w); } while (0)
  PK8(p0, 0, pa0); PK8(p0, 8, pa1); PK8(p1, 0, pa2); PK8(p1, 8, pa3);
#undef PK8
}
template <int ABL = 0> __device__ __forceinline__ void qkt(f32x16& p0, f32x16& p1, const char* Ks, const bf16x8* qr, int r32, int hi) {
  p0 = f32x16{}; p1 = f32x16{};
  if constexpr (ABL & 4) {
#pragma unroll
    for (int d0 = 0; d0 < 6; ++d0) { int cb = (d0 * 16 + hi * 8) * 2;
      bf16x8 b0 = *reinterpret_cast<const bf16x8*>(Ks + KSWZ(r32, cb)); bf16x8 b1 = *reinterpret_cast<const bf16x8*>(Ks + KSWZ(32 + r32, cb));
      asm volatile("" :: "v"(b0), "v"(b1)); }
    return; }
#pragma unroll
  for (int d0 = 0; d0 < 6; ++d0) { int cb = (d0 * 16 + hi * 8) * 2;
    bf16x8 b0 = *reinterpret_cast<const bf16x8*>(Ks + KSWZ(r32, cb));
    bf16x8 b1 = *reinterpret_cast<const bf16x8*>(Ks + KSWZ(32 + r32, cb));
    p0 = __builtin_amdgcn_mfma_f32_32x32x16_bf16(b0, qr[d0], p0, 0, 0, 0); p1 = __builtin_amdgcn_mfma_f32_32x32x16_bf16(b1, qr[d0], p1, 0, 0, 0); }
}
__device__ __forceinline__ int v_st(int k, int c) { return ((k >> 3) * 2 + (c >> 5)) * 512 + ((k & 7) * 32 + (c & 31)) * 2; }
__device__ __forceinline__ int v_rd_base(int lane) { return ((lane & 3) << 3) | (((lane >> 2) & 3) << 6) | (((lane >> 4) & 1) << 5) | (((lane >> 5) & 1) << 8); }
constexpr int v_rd_off(int d0, int ks, int half) { return d0 * 512 + ks * 2048 + half * 1024; }
template <int OFF> __device__ __forceinline__ s16x4 tr_read(int vb) {
  s16x4 r; asm volatile("ds_read_b64_tr_b16 %0, %1 offset:%2" : "=&v"(r) : "v"(vb), "i"(OFF) : "memory"); return r;
}
template <int D0> __device__ __forceinline__ void pv_one(f32x16& od, int vb, bf16x8 pa0, bf16x8 pa1, bf16x8 pa2, bf16x8 pa3) {
  const s16x4 l0 = tr_read<v_rd_off(D0, 0, 0)>(vb), h0 = tr_read<v_rd_off(D0, 0, 1)>(vb), l1 = tr_read<v_rd_off(D0, 1, 0)>(vb), h1 = tr_read<v_rd_off(D0, 1, 1)>(vb);
  const s16x4 l2 = tr_read<v_rd_off(D0, 2, 0)>(vb), h2 = tr_read<v_rd_off(D0, 2, 1)>(vb), l3 = tr_read<v_rd_off(D0, 3, 0)>(vb), h3 = tr_read<v_rd_off(D0, 3, 1)>(vb);
  asm volatile("s_waitcnt lgkmcnt(0)" ::: "memory"); SBAR();
#define PK(L, H) (bf16x8){L[0], L[1], L[2], L[3], H[0], H[1], H[2], H[3]}
  od = __builtin_amdgcn_mfma_f32_32x32x16_bf16(PK(l0, h0), pa0, od, 0, 0, 0);
  od = __builtin_amdgcn_mfma_f32_32x32x16_bf16(PK(l1, h1), pa1, od, 0, 0, 0);
  od = __builtin_amdgcn_mfma_f32_32x32x16_bf16(PK(l2, h2), pa2, od, 0, 0, 0);
  od = __builtin_amdgcn_mfma_f32_32x32x16_bf16(PK(l3, h3), pa3, od, 0, 0, 0);
#undef PK
}
__device__ __forceinline__ void pv_d0(f32x16* o, int vb, bf16x8 pa0, bf16x8 pa1, bf16x8 pa2, bf16x8 pa3) {
  pv_one<0>(o[0], vb, pa0, pa1, pa2, pa3); pv_one<1>(o[1], vb, pa0, pa1, pa2, pa3);
}
__device__ __forceinline__ void glds16(const void* gsrc, unsigned lds_dst) { unsigned keep;
  asm volatile("s_mov_b32 %0, m0\n\ts_mov_b32 m0, %2\n\ts_nop 0\n\tglobal_load_lds_dwordx4 %1, off\n\ts_mov_b32 m0, %0" : "=&s"(keep) : "v"(gsrc), "s"(lds_dst) : "memory"); }
struct VFrag { s16x4 l[4], h[4]; };
template <int D0> __device__ __forceinline__ void v_read(VFrag& f, int vb) {
  f.l[0] = tr_read<v_rd_off(D0, 0, 0)>(vb); f.h[0] = tr_read<v_rd_off(D0, 0, 1)>(vb); f.l[1] = tr_read<v_rd_off(D0, 1, 0)>(vb); f.h[1] = tr_read<v_rd_off(D0, 1, 1)>(vb);
  f.l[2] = tr_read<v_rd_off(D0, 2, 0)>(vb); f.h[2] = tr_read<v_rd_off(D0, 2, 1)>(vb); f.l[3] = tr_read<v_rd_off(D0, 3, 0)>(vb); f.h[3] = tr_read<v_rd_off(D0, 3, 1)>(vb);
}
__device__ __forceinline__ void pv_blk(f32x16& od, const VFrag& f, bf16x8 pa0, bf16x8 pa1, bf16x8 pa2, bf16x8 pa3) {
#define PK(L, H) (bf16x8){L[0], L[1], L[2], L[3], H[0], H[1], H[2], H[3]}
  od = __builtin_amdgcn_mfma_f32_32x32x16_bf16(PK(f.l[0], f.h[0]), pa0, od, 0, 0, 0);
  od = __builtin_amdgcn_mfma_f32_32x32x16_bf16(PK(f.l[1], f.h[1]), pa1, od, 0, 0, 0);
  od = __builtin_amdgcn_mfma_f32_32x32x16_bf16(PK(f.l[2], f.h[2]), pa2, od, 0, 0, 0);
  od = __builtin_amdgcn_mfma_f32_32x32x16_bf16(PK(f.l[3], f.h[3]), pa3, od, 0, 0, 0);
#undef PK
}
constexpr int NSLOT = 3;
constexpr int RK = 0, RV = NSLOT * SHM_K, ROST = RV + NSLOT * SHM_V, SHM_ATTN2 = ROST + NW * OST_W;
template <int ABL = 0> __device__ __forceinline__ void attn_unit(const bf16_t* __restrict__ Qb, const bf16_t* __restrict__ Kh, const bf16_t* __restrict__ Vh, bf16_t* __restrict__ Ob, int ldo, int seq, char* lds) {
  const int tid = threadIdx.x, lane = tid & 63, r32 = lane & 31, hi = lane >> 5; const int wid = __builtin_amdgcn_readfirstlane(tid >> 6);
  const unsigned lds0 = (unsigned)(uintptr_t)lds;
  float mref = 0.f, l_reg = 0.f; f32x16 o[2] = {}; bf16x8 qr[6];
  const int krow = 4 * wid + (lane >> 4), kch = (lane & 15) ^ (krow & 15);
  const bf16_t* ksrc = Kh + (long)krow * DQK + (kch < 12 ? kch * 8 : 0);
  const bf16_t* vsrc = Vh + (long)(8 * wid + ((lane & 31) >> 2)) * DV + 32 * (lane >> 5) + 8 * (lane & 3);
  const unsigned kdst = lds0 + RK + wid * 1024, vdst = lds0 + RV + wid * 1024;
#define DMA_K(t, slot) do { if constexpr (ABL & 8) break; glds16(ksrc + (long)(t) * KVBLK * DQK, (unsigned)__builtin_amdgcn_readfirstlane(kdst + (slot) * SHM_K)); \
                            glds16(ksrc + (long)(t) * KVBLK * DQK + 32 * DQK, (unsigned)__builtin_amdgcn_readfirstlane(kdst + (slot) * SHM_K + 8192)); } while (0)
#define DMA_V(t, slot) do { if constexpr (!(ABL & 8)) glds16(vsrc + (long)(t) * KVBLK * DV, (unsigned)__builtin_amdgcn_readfirstlane(vdst + (slot) * SHM_V)); } while (0)
#define WAIT_BAR(N) asm volatile("s_waitcnt vmcnt(" #N ") lgkmcnt(0)\n\ts_barrier" ::: "memory")
  const int NT = seq / KVBLK;
  const bf16_t* Qw = Qb + (long)(wid * QBLK + r32) * DQK + hi * 8;
#pragma unroll
  for (int d0 = 0; d0 < 6; ++d0) qr[d0] = ld8(Qw + d0 * 16);
  asm volatile("" ::: "memory");
  DMA_K(0, 0); DMA_K(1, 1); DMA_V(0, 0);
  const int vb0 = (int)(lds0 + RV) + v_rd_base(lane);
#define RESC(a) do { if (__any((a) < 1.f)) { _Pragma("unroll") for (int d = 0; d < 2; ++d) _Pragma("unroll") for (int r = 0; r < 16; ++r) o[d][r] *= (a); } } while (0)
  f32x16 pA0, pA1, pB0, pB1; float alA, alB; bf16x8 pa0, pa1, pa2, pa3; VFrag vf, vg;
  int ks = 0, vs = 0;
#define ROTK() do { ks = (ks == NSLOT - 1) ? 0 : ks + 1; } while (0)
#define ROTV() do { vs = (vs == NSLOT - 1) ? 0 : vs + 1; } while (0)
#define TOP(t) do { if ((t) + 1 < NT) { WAIT_BAR(3); } else { WAIT_BAR(0); } \
    if ((t) + 2 < NT) { int kn = ks + 2; kn = kn >= NSLOT ? kn - NSLOT : kn; DMA_K((t) + 2, kn); } \
    if ((t) + 1 < NT) { int vn = vs + 2; vn = vn >= NSLOT ? vn - NSLOT : vn; DMA_V((t) + 1, vn); } SBAR(); } while (0)
#define C_QK(PC0, PC1) do { qkt<ABL>(PC0, PC1, lds + RK + ks * SHM_K, qr, r32, hi); SBAR(); } while (0)
#define C_FIN(PP0, PP1, ALP) do { v_read<0>(vf, vb0 + vs * SHM_V); finishSM<ABL>(PP0, PP1, ALP, l_reg, pa0, pa1, pa2, pa3); SBAR(); } while (0)
#define C_PV() do { asm volatile("s_waitcnt lgkmcnt(0)" ::: "memory"); SBAR(); v_read<1>(vg, vb0 + vs * SHM_V); SBAR(); \
    if constexpr (!(ABL & 2)) pv_blk(o[0], vf, pa0, pa1, pa2, pa3); else { asm volatile("" :: "v"(vf.l[0]), "v"(vf.h[3]), "v"(pa0), "v"(pa3)); } \
    asm volatile("s_waitcnt lgkmcnt(0)" ::: "memory"); SBAR(); \
    if constexpr (!(ABL & 2)) pv_blk(o[1], vg, pa0, pa1, pa2, pa3); else { asm volatile("" :: "v"(vg.l[0]), "v"(vg.h[3])); } SBAR(); } while (0)
#define C_PAR(FIRST_, PC0, PC1, ALC) do { partialSM<FIRST_, ABL>(PC0, PC1, mref, ALC); RESC(ALC); SBAR(); } while (0)
  if (wid < 4) {
    WAIT_BAR(3); DMA_K(2, 2); DMA_V(1, 1); SBAR(); C_QK(pA0, pA1); C_PAR(true, pA0, pA1, alA); ROTK();
    int t = 1;
    for (; t + 1 < NT; t += 2) {
      TOP(t);     C_QK(pB0, pB1); C_FIN(pA0, pA1, alA); C_PV(); C_PAR(false, pB0, pB1, alB); ROTK(); ROTV();
      TOP(t + 1); C_QK(pA0, pA1); C_FIN(pB0, pB1, alB); C_PV(); C_PAR(false, pA0, pA1, alA); ROTK(); ROTV();
    }
    TOP(NT - 1);  C_QK(pB0, pB1); C_FIN(pA0, pA1, alA); C_PV(); C_PAR(false, pB0, pB1, alB); ROTK(); ROTV();
    WAIT_BAR(0);
    C_FIN(pB0, pB1, alB); C_PV();
  } else {
    WAIT_BAR(3); DMA_K(2, 2); DMA_V(1, 1); SBAR(); C_QK(pA0, pA1); ROTK();
    TOP(1); C_PAR(true, pA0, pA1, alA); C_QK(pB0, pB1); C_FIN(pA0, pA1, alA); C_PV(); ROTK(); ROTV();
    int t = 2;
    for (; t + 1 < NT; t += 2) {
      TOP(t);     C_PAR(false, pB0, pB1, alB); C_QK(pA0, pA1); C_FIN(pB0, pB1, alB); C_PV(); ROTK(); ROTV();
      TOP(t + 1); C_PAR(false, pA0, pA1, alA); C_QK(pB0, pB1); C_FIN(pA0, pA1, alA); C_PV(); ROTK(); ROTV();
    }
    WAIT_BAR(0);
    C_PAR(false, pB0, pB1, alB); C_FIN(pB0, pB1, alB); C_PV();
  }
#undef TOP
#undef C_QK
#undef C_FIN
#undef C_PV
#undef C_PAR
  { auto rr = __builtin_amdgcn_permlane32_swap(__float_as_uint(l_reg), __float_as_uint(l_reg), false, false); l_reg = __uint_as_float(rr[0]) + __uint_as_float(rr[1]); }
  const float rl = __builtin_amdgcn_rcpf(l_reg);
  bf16_t* Ow = Ob + (long)(wid * QBLK) * ldo;
  { char* stg = lds + ROST + wid * OST_W;
#pragma unroll
    for (int d0 = 0; d0 < 2; ++d0)
#pragma unroll
      for (int g = 0; g < 4; ++g) { uint2 w; w.x = cvtpk(o[d0][4 * g] * rl, o[d0][4 * g + 1] * rl); w.y = cvtpk(o[d0][4 * g + 2] * rl, o[d0][4 * g + 3] * rl);
        *(uint2*)(stg + r32 * 144 + (32 * d0 + 8 * g + 4 * hi) * 2) = w; }
    asm volatile("s_waitcnt lgkmcnt(0)" ::: "memory");
#pragma unroll
    for (int i = 0; i < 4; ++i) { const int row = i * 8 + (lane >> 3), ch = lane & 7; const u32x4 v = *(const u32x4*)(stg + row * 144 + ch * 16); *(u32x4*)(Ow + (long)row * ldo + ch * 8) = v; } }
  asm volatile("s_waitcnt vmcnt(0) lgkmcnt(0)\n\ts_barrier" ::: "memory");
#undef DMA_K
#undef DMA_V
#undef WAIT_BAR
#undef RESC
#undef ROTK
#undef ROTV
}
template <bool NOMAX> __device__ __forceinline__ void softmax_blk(f32x16& p0, f32x16& p1, bool first, float& mref, float& l_reg, f32x16* o, bf16x8& pa0, bf16x8& pa1, bf16x8& pa2, bf16x8& pa3) {
  if constexpr (!NOMAX) {
  float a = max3(p0[0], p0[1], p0[2]), b = max3(p1[0], p1[1], p1[2]);
#pragma unroll
  for (int r = 3; r < 15; r += 2) { a = max3(a, p0[r], p0[r + 1]); b = max3(b, p1[r], p1[r + 1]); }
  float pmax = max3(a, b, fmaxf(p0[15], p1[15]));
  { auto rr = __builtin_amdgcn_permlane32_swap(__float_as_uint(pmax), __float_as_uint(pmax), false, false);
    pmax = fmaxf(__uint_as_float(rr[0]), __uint_as_float(rr[1])); }
  pmax -= mref;
  if (!__builtin_expect(__all(first ? (fabsf(pmax) <= THRL) : (pmax <= THRL)), 1)) {
    const float dl = first ? pmax : fmaxf(pmax, 0.f); mref += dl; const float alpha = __builtin_amdgcn_exp2f(-dl); l_reg *= alpha;
#pragma unroll
    for (int d = 0; d < 2; ++d)
#pragma unroll
      for (int r = 0; r < 16; ++r) o[d][r] *= alpha; }
  if (__any(mref != 0.f)) {
#pragma unroll
    for (int r = 0; r < 16; ++r) { p0[r] -= mref; p1[r] -= mref; } }
  }
#pragma unroll
  for (int r = 0; r < 16; ++r) { p0[r] = __builtin_amdgcn_exp2f(p0[r]); p1[r] = __builtin_amdgcn_exp2f(p1[r]); }
  float ps0 = 0.f, ps1 = 0.f;
#pragma unroll
  for (int r = 0; r < 16; ++r) { ps0 += p0[r]; ps1 += p1[r]; }
  l_reg += ps0 + ps1;
#define PK8(P, BASE, OUT) do { u32x4 w = {cvtpk(P[BASE + 0], P[BASE + 1]), cvtpk(P[BASE + 2], P[BASE + 3]), cvtpk(P[BASE + 4], P[BASE + 5]), cvtpk(P[BASE + 6], P[BASE + 7])}; \
    OUT = *reinterpret_cast<bf16x8*>(&w); } while (0)
  PK8(p0, 0, pa0); PK8(p0, 8, pa1); PK8(p1, 0, pa2); PK8(p1, 8, pa3);
#undef PK8
}
constexpr int NSV = 4;
constexpr int QB_W = 32 * 208;
constexpr int R2K = 0, R2V = NSLOT * SHM_K, R2Q = R2V + NSV * SHM_V, R2OST = R2K, SHM_ATTN3 = R2Q + NW * QB_W;
template <bool NOMAX> __device__ __forceinline__ void attn_unit64(const bf16_t* __restrict__ Qb, const bf16_t* __restrict__ Kh, const bf16_t* __restrict__ Vh, bf16_t* __restrict__ Ob, int ldo, int seq, char* lds) {
  const int tid = threadIdx.x, lane = tid & 63, r32 = lane & 31, hi = lane >> 5; const int wid = __builtin_amdgcn_readfirstlane(tid >> 6);
  const unsigned lds0 = (unsigned)(uintptr_t)lds;
  float mrefa = 0.f, la = 0.f, mrefb = 0.f, lb = 0.f; f32x16 oa[2] = {}, ob[2] = {}; bf16x8 qa[6];
  const int krow = 4 * wid + (lane >> 4), kch = (lane & 15) ^ (krow & 15);
  const bf16_t* ksrc = Kh + (long)krow * DQK + (kch < 12 ? kch * 8 : 0);
  const bf16_t* vsrc = Vh + (long)(8 * wid + ((lane & 31) >> 2)) * DV + 32 * (lane >> 5) + 8 * (lane & 3);
  const unsigned kdst = lds0 + R2K + wid * 1024, vdst = lds0 + R2V + wid * 1024;
#define DMA_K(t, slot) do { glds16(ksrc + (long)(t) * KVBLK * DQK, (unsigned)__builtin_amdgcn_readfirstlane(kdst + (slot) * SHM_K)); \
                            glds16(ksrc + (long)(t) * KVBLK * DQK + 32 * DQK, (unsigned)__builtin_amdgcn_readfirstlane(kdst + (slot) * SHM_K + 8192)); } while (0)
#define DMA_V(t, slot) glds16(vsrc + (long)(t) * KVBLK * DV, (unsigned)__builtin_amdgcn_readfirstlane(vdst + (slot) * SHM_V))
#define WAIT_BAR(N) asm volatile("s_waitcnt vmcnt(" #N ") lgkmcnt(0)\n\ts_barrier" ::: "memory")
  const int NT = seq / KVBLK;
  const bf16_t* Qw = Qb + (long)(wid * 64 + r32) * DQK + hi * 8;
  DMA_K(0, 0); DMA_V(0, 0); DMA_K(1, 1); DMA_V(1, 1);
  char* qbl = lds + R2Q + wid * QB_W + r32 * 208 + hi * 16;
  { bf16x8 qt[6];
#pragma unroll
    for (int d0 = 0; d0 < 6; ++d0) qt[d0] = ld8(Qw + 32 * DQK + d0 * 16);
#pragma unroll
    for (int d0 = 0; d0 < 6; ++d0) qa[d0] = ld8(Qw + d0 * 16);
#pragma unroll
    for (int d0 = 0; d0 < 6; ++d0) *(bf16x8*)(qbl + d0 * 32) = qt[d0]; }
  asm volatile("s_waitcnt vmcnt(0) lgkmcnt(0)" ::: "memory");
  const int vb0 = (int)(lds0 + R2V) + v_rd_base(lane);
  int ks = 0, vs = 0;
#define PK(L, H) (bf16x8){L[0], L[1], L[2], L[3], H[0], H[1], H[2], H[3]}
#define C_QK() do { pa0s = f32x16{}; pa1s = f32x16{}; pb0s = f32x16{}; pb1s = f32x16{}; const char* Ks = lds + R2K + ks * SHM_K; \
      _Pragma("unroll") for (int d0 = 0; d0 < 6; ++d0) { const int cb = (d0 * 16 + hi * 8) * 2; \
        const bf16x8 k0 = *reinterpret_cast<const bf16x8*>(Ks + KSWZ(r32, cb)), k1 = *reinterpret_cast<const bf16x8*>(Ks + KSWZ(32 + r32, cb)); \
        const bf16x8 qbf = *reinterpret_cast<const bf16x8*>(qbl + d0 * 32); \
        pa0s = __builtin_amdgcn_mfma_f32_32x32x16_bf16(k0, qa[d0], pa0s, 0, 0, 0); pb0s = __builtin_amdgcn_mfma_f32_32x32x16_bf16(k0, qbf, pb0s, 0, 0, 0); \
        pa1s = __builtin_amdgcn_mfma_f32_32x32x16_bf16(k1, qa[d0], pa1s, 0, 0, 0); pb1s = __builtin_amdgcn_mfma_f32_32x32x16_bf16(k1, qbf, pb1s, 0, 0, 0); } SBAR(); } while (0)
#define C_SM(first_) do { softmax_blk<NOMAX>(pa0s, pa1s, first_, mrefa, la, oa, a0, a1, a2, a3); softmax_blk<NOMAX>(pb0s, pb1s, first_, mrefb, lb, ob, b0, b1, b2, b3); SBAR(); } while (0)
#define C_PV(vslot) do { const int vb = vb0 + (vslot) * SHM_V; VFrag vf, vg; \
      v_read<0>(vf, vb); asm volatile("s_waitcnt lgkmcnt(0)" ::: "memory"); SBAR(); v_read<1>(vg, vb); SBAR(); \
      oa[0] = __builtin_amdgcn_mfma_f32_32x32x16_bf16(PK(vf.l[0], vf.h[0]), a0, oa[0], 0, 0, 0); ob[0] = __builtin_amdgcn_mfma_f32_32x32x16_bf16(PK(vf.l[0], vf.h[0]), b0, ob[0], 0, 0, 0); \
      oa[0] = __builtin_amdgcn_mfma_f32_32x32x16_bf16(PK(vf.l[1], vf.h[1]), a1, oa[0], 0, 0, 0); ob[0] = __builtin_amdgcn_mfma_f32_32x32x16_bf16(PK(vf.l[1], vf.h[1]), b1, ob[0], 0, 0, 0); \
      oa[0] = __builtin_amdgcn_mfma_f32_32x32x16_bf16(PK(vf.l[2], vf.h[2]), a2, oa[0], 0, 0, 0); ob[0] = __builtin_amdgcn_mfma_f32_32x32x16_bf16(PK(vf.l[2], vf.h[2]), b2, ob[0], 0, 0, 0); \
      oa[0] = __builtin_amdgcn_mfma_f32_32x32x16_bf16(PK(vf.l[3], vf.h[3]), a3, oa[0], 0, 0, 0); ob[0] = __builtin_amdgcn_mfma_f32_32x32x16_bf16(PK(vf.l[3], vf.h[3]), b3, ob[0], 0, 0, 0); \
      asm volatile("s_waitcnt lgkmcnt(0)" ::: "memory"); SBAR(); \
      oa[1] = __builtin_amdgcn_mfma_f32_32x32x16_bf16(PK(vg.l[0], vg.h[0]), a0, oa[1], 0, 0, 0); ob[1] = __builtin_amdgcn_mfma_f32_32x32x16_bf16(PK(vg.l[0], vg.h[0]), b0, ob[1], 0, 0, 0); \
      oa[1] = __builtin_amdgcn_mfma_f32_32x32x16_bf16(PK(vg.l[1], vg.h[1]), a1, oa[1], 0, 0, 0); ob[1] = __builtin_amdgcn_mfma_f32_32x32x16_bf16(PK(vg.l[1], vg.h[1]), b1, ob[1], 0, 0, 0); \
      oa[1] = __builtin_amdgcn_mfma_f32_32x32x16_bf16(PK(vg.l[2], vg.h[2]), a2, oa[1], 0, 0, 0); ob[1] = __builtin_amdgcn_mfma_f32_32x32x16_bf16(PK(vg.l[2], vg.h[2]), b2, ob[1], 0, 0, 0); \
      oa[1] = __builtin_amdgcn_mfma_f32_32x32x16_bf16(PK(vg.l[3], vg.h[3]), a3, oa[1], 0, 0, 0); ob[1] = __builtin_amdgcn_mfma_f32_32x32x16_bf16(PK(vg.l[3], vg.h[3]), b3, ob[1], 0, 0, 0); SBAR(); } while (0)
#define TOP(t) do { if ((t) + 1 < NT) { WAIT_BAR(3); } else { WAIT_BAR(0); } \
    if ((t) + 2 < NT) { int kn = ks + 2; kn = kn >= NSLOT ? kn - NSLOT : kn; int vn = vs + 2; vn = vn >= NSV ? vn - NSV : vn; DMA_K((t) + 2, kn); DMA_V((t) + 2, vn); } SBAR(); } while (0)
#define ROT() do { ks = (ks == NSLOT - 1) ? 0 : ks + 1; vs = (vs == NSV - 1) ? 0 : vs + 1; } while (0)
#define ATT_LOOP(late) do { \
    f32x16 pa0s, pa1s, pb0s, pb1s; bf16x8 a0 = {}, a1 = {}, a2 = {}, a3 = {}, b0 = {}, b1 = {}, b2 = {}, b3 = {}; \
    for (int t = 0; t < NT; ++t) { \
      TOP(t); \
      if (late && t > 0) C_PV(vs == 0 ? NSV - 1 : vs - 1); \
      C_QK(); C_SM(t == 0); \
      if (!late) C_PV(vs); \
      ROT(); \
    } \
    if (late) C_PV(vs == 0 ? NSV - 1 : vs - 1); } while (0)
  if constexpr (NOMAX) {
    f32x16 pa0s, pa1s, pb0s, pb1s; unsigned wa0[8], wb0[8], wa1[8], wb1[8];
#define HC(P, i, S, W) do { P[(i) & 15] = __builtin_amdgcn_exp2f(P[(i) & 15]); P[((i) + 1) & 15] = __builtin_amdgcn_exp2f(P[((i) + 1) & 15]); S += P[(i) & 15]; S += P[((i) + 1) & 15]; \
                            W = cvtpk_n(P[(i) & 15], P[((i) + 1) & 15]); } while (0)
#define HC0(h) do { if ((h) < 8) HC(pa0s, 2 * (h), la, wa0[(h) & 7]); else HC(pb0s, 2 * ((h) - 8), lb, wb0[(h) & 7]); } while (0)
#define MK8(W, o) __builtin_bit_cast(bf16x8, (u32x4){W[(o)], W[(o) + 1], W[(o) + 2], W[(o) + 3]})
#define LDSK(row, d) (*reinterpret_cast<const bf16x8*>(Ks + KSWZ((row), ((d) * 16 + hi * 8) * 2)))
#define LDSQ(d) (*reinterpret_cast<const bf16x8*>(qbl + (d) * 32))
#define MF(A, B, C) C = __builtin_amdgcn_mfma_f32_32x32x16_bf16(A, B, C, 0, 0, 0)
    VFrag vf, vg; bf16x8 kcarry, qcarry;
#define VRD(J, VB) do { vf.l[J] = tr_read<v_rd_off(0, J, 0)>(VB); vf.h[J] = tr_read<v_rd_off(0, J, 1)>(VB); vg.l[J] = tr_read<v_rd_off(1, J, 0)>(VB); vg.h[J] = tr_read<v_rd_off(1, J, 1)>(VB); } while (0)
#define HCB(k) HC(pb1s, 2 * (k), lb, wb1[(k) & 7])
#define STA(PREV) do { pa0s = f32x16{}; pb0s = f32x16{}; bf16x8 kc = LDSK(r32, 0), qc = LDSQ(0); \
      _Pragma("unroll") for (int d0 = 0; d0 < 6; ++d0) { bf16x8 kn, qn; if (d0 < 5) { kn = LDSK(r32, d0 + 1); qn = LDSQ(d0 + 1); } else { kn = LDSK(32 + r32, 0); qn = LDSQ(0); } \
        MF(kc, qa[d0], pa0s); if (PREV && d0 < 4) HCB(2 * d0); SBAR(); MF(kc, qc, pb0s); if (PREV && d0 < 4) HCB(2 * d0 + 1); SBAR(); kc = kn; qc = qn; } kcarry = kc; qcarry = qc; } while (0)
#define STB() do { const bf16x8 b2 = MK8(wb1, 0), b3 = MK8(wb1, 4); \
      MF(PK(vf.l[2], vf.h[2]), b2, ob[0]); HC0(0); SBAR(); MF(PK(vg.l[2], vg.h[2]), b2, ob[1]); HC0(1); SBAR(); \
      MF(PK(vf.l[3], vf.h[3]), b3, ob[0]); HC0(2); SBAR(); MF(PK(vg.l[3], vg.h[3]), b3, ob[1]); HC0(3); SBAR(); } while (0)
#define STC(VB) do { pa1s = f32x16{}; pb1s = f32x16{}; bf16x8 kc = kcarry, qc = qcarry; \
      _Pragma("unroll") for (int d0 = 0; d0 < 6; ++d0) { bf16x8 kn = kc, qn = qc; if (d0 < 5) { kn = LDSK(32 + r32, d0 + 1); qn = LDSQ(d0 + 1); } else { VRD(0, VB); VRD(1, VB); } \
        MF(kc, qa[d0], pa1s); HC0(4 + 2 * d0); SBAR(); MF(kc, qc, pb1s); HC0(5 + 2 * d0); SBAR(); kc = kn; qc = qn; } } while (0)
#define STD(VB) do { const bf16x8 a0 = MK8(wa0, 0), a1 = MK8(wa0, 4), b0 = MK8(wb0, 0), b1 = MK8(wb0, 4); \
      asm volatile("s_waitcnt lgkmcnt(0)" ::: "memory"); SBAR(); \
      MF(PK(vf.l[0], vf.h[0]), a0, oa[0]); HC(pa1s, 0, la, wa1[0]); SBAR(); \
      MF(PK(vf.l[0], vf.h[0]), b0, ob[0]); HC(pa1s, 2, la, wa1[1]); SBAR(); \
      MF(PK(vg.l[0], vg.h[0]), a0, oa[1]); HC(pa1s, 4, la, wa1[2]); SBAR(); \
      MF(PK(vg.l[0], vg.h[0]), b0, ob[1]); HC(pa1s, 6, la, wa1[3]); VRD(2, VB); VRD(3, VB); SBAR();        \
      MF(PK(vf.l[1], vf.h[1]), a1, oa[0]); HC(pa1s, 8, la, wa1[4]); SBAR(); \
      MF(PK(vf.l[1], vf.h[1]), b1, ob[0]); HC(pa1s, 10, la, wa1[5]); SBAR(); \
      MF(PK(vg.l[1], vg.h[1]), a1, oa[1]); HC(pa1s, 12, la, wa1[6]); SBAR(); \
      MF(PK(vg.l[1], vg.h[1]), b1, ob[1]); HC(pa1s, 14, la, wa1[7]); SBAR(); } while (0)
#define STE() do { const bf16x8 a2 = MK8(wa1, 0), a3 = MK8(wa1, 4); asm volatile("s_waitcnt lgkmcnt(0)" ::: "memory"); SBAR(); \
      MF(PK(vf.l[2], vf.h[2]), a2, oa[0]); MF(PK(vg.l[2], vg.h[2]), a2, oa[1]); MF(PK(vf.l[3], vf.h[3]), a3, oa[0]); MF(PK(vg.l[3], vg.h[3]), a3, oa[1]); SBAR(); } while (0)
    {
      TOP(0);
      const char* Ks = lds + R2K + ks * SHM_K; const int vb = vb0 + vs * SHM_V;
      STA(false); HC0(0); HC0(1); HC0(2); HC0(3); SBAR(); STC(vb); STD(vb); STE();
      ROT();
    }
    for (int t = 1; t < NT; ++t) {
      TOP(t);
      const char* Ks = lds + R2K + ks * SHM_K; const int vb = vb0 + vs * SHM_V;
      STA(true); STB(); STC(vb); STD(vb); STE();
      ROT();
    }
    {
#pragma unroll
      for (int k = 0; k < 8; ++k) HCB(k);
      const bf16x8 b2 = MK8(wb1, 0), b3 = MK8(wb1, 4);
      MF(PK(vf.l[2], vf.h[2]), b2, ob[0]); MF(PK(vg.l[2], vg.h[2]), b2, ob[1]); MF(PK(vf.l[3], vf.h[3]), b3, ob[0]); MF(PK(vg.l[3], vg.h[3]), b3, ob[1]); }
#undef VRD
#undef HCB
#undef STA
#undef STB
#undef STC
#undef STD
#undef STE
#undef HC
#undef HC0
#undef MK8
#undef LDSK
#undef LDSQ
#undef MF
  } else {
    if (wid < 4) { ATT_LOOP(false); } else { ATT_LOOP(true); }
  }
#undef ATT_LOOP
  WAIT_BAR(0);
#undef PK
#undef C_QK
#undef C_SM
#undef C_PV
#undef TOP
#undef ROT
  char* stg = lds + R2OST + wid * OST_W;
#pragma unroll
  for (int blk = 0; blk < 2; ++blk) {
    float l_reg = blk ? lb : la; f32x16* o = blk ? ob : oa;
    { auto rr = __builtin_amdgcn_permlane32_swap(__float_as_uint(l_reg), __float_as_uint(l_reg), false, false); l_reg = __uint_as_float(rr[0]) + __uint_as_float(rr[1]); }
    const float rl = __builtin_amdgcn_rcpf(l_reg);
    bf16_t* Ow = Ob + (long)(wid * 64 + blk * 32) * ldo;
#pragma unroll
    for (int d0 = 0; d0 < 2; ++d0)
#pragma unroll
      for (int g = 0; g < 4; ++g) { uint2 w; w.x = cvtpk(o[d0][4 * g] * rl, o[d0][4 * g + 1] * rl); w.y = cvtpk(o[d0][4 * g + 2] * rl, o[d0][4 * g + 3] * rl);
        *(uint2*)(stg + r32 * 144 + (32 * d0 + 8 * g + 4 * hi) * 2) = w; }
    asm volatile("s_waitcnt lgkmcnt(0)" ::: "memory");
#pragma unroll
    for (int i = 0; i < 4; ++i) { const int row = i * 8 + (lane >> 3), ch = lane & 7; const u32x4 v = *(const u32x4*)(stg + row * 144 + ch * 16); *(u32x4*)(Ow + (long)row * ldo + ch * 8) = v; }
    asm volatile("s_waitcnt lgkmcnt(0)" ::: "memory");
  }
  asm volatile("s_waitcnt lgkmcnt(0)\n\ts_barrier" ::: "memory");
#undef DMA_K
#undef DMA_V
#undef WAIT_BAR
}
#undef KSWZ
#undef SBAR
}

#define GAS __attribute__((address_space(1)))
#define LAS __attribute__((address_space(3)))
typedef unsigned short bf16;
typedef unsigned v4u __attribute__((ext_vector_type(4)));
typedef float f32x4 __attribute__((ext_vector_type(4)));
typedef short bf16x8 __attribute__((ext_vector_type(8)));
typedef GAS unsigned gu32;
typedef GAS unsigned long long gu64;
#define RLX_AGENT __ATOMIC_RELAXED, __HIP_MEMORY_SCOPE_AGENT
#define LDS_WAIT() asm volatile("s_waitcnt lgkmcnt(0)" ::: "memory")
#define VM_WAIT() asm volatile("s_waitcnt vmcnt(0)" ::: "memory")
__device__ __forceinline__ unsigned long long rt() { return __builtin_amdgcn_s_memrealtime(); }
__device__ __forceinline__ unsigned f2bf(float f) { unsigned u = __builtin_bit_cast(unsigned, f); return (u + 0x7fffu + ((u >> 16) & 1u)) >> 16; }
__device__ __forceinline__ unsigned pk2(float lo, float hi) { return f2bf(lo) | (f2bf(hi) << 16); }

#define XB_TMO      128
#define XB_XCNT(j)  (256  + 64 * (j))
#define XB_XSUB(j)  (1280 + 64 * (j))
#define XB_XGEN(j)  (2304 + 64 * (j))
#define XB_TOP      3328
#define XB_TOPGEN   3392
#define XB_LSUB(j)  (3456 + 64 * (j))
#define XB_LGEN(j)  (4480 + 64 * (j))
#define XCD_BAR_WORDS 5504
#define XB_SPIN_CAP (1u << 18)

__device__ __forceinline__ unsigned xb_ld(unsigned* p)              { return __hip_atomic_load(p, __ATOMIC_RELAXED, __HIP_MEMORY_SCOPE_AGENT); }
__device__ __forceinline__ unsigned xb_add(unsigned* p, unsigned v) { return __hip_atomic_fetch_add(p, v, __ATOMIC_RELAXED, __HIP_MEMORY_SCOPE_AGENT); }
__device__ __forceinline__ unsigned xb_xcc_id() { return (unsigned)__builtin_amdgcn_s_getreg((3 << 11) | 20) & 0xFu; }
#define XB_SPIN(cond, bar) do { unsigned _sp = 0; while (cond) { __builtin_amdgcn_s_sleep(1); \
    if ((++_sp & 255u) == 0u) { if (xb_ld(&(bar)[XB_TMO])) break; if (_sp > XB_SPIN_CAP) { atomicAdd(&(bar)[XB_TMO], 1u); break; } } } } while (0)

struct XcdBarrier {
    unsigned* bar; unsigned x;
    volatile LAS unsigned* st;
};

__device__ __forceinline__ XcdBarrier xcd_barrier_post(unsigned* bar, volatile LAS unsigned* st) {
    XcdBarrier b; b.bar = bar; b.x = xb_xcc_id(); b.st = st;
    if (threadIdx.x == 0) (void)xb_add(&bar[XB_XCNT(b.x)], 1u);
    return b;
}
__device__ __forceinline__ void xcd_barrier_complete(unsigned* bar, unsigned x, unsigned& nloc, unsigned& nx) {
    const unsigned G = gridDim.x * gridDim.y * gridDim.z;
    unsigned sum, cnt, mine, sp = 0u;
    for (;;) {
        sum = 0u; cnt = 0u; mine = 0u;
#pragma unroll
        for (unsigned j = 0; j < 16; ++j) { const unsigned c = xb_ld(&bar[XB_XCNT(j)]); sum += c; cnt += (c > 0u) ? 1u : 0u; mine = (j == x) ? c : mine; }
        if (sum == G) break;
        __builtin_amdgcn_s_sleep(1);
        if ((++sp & 255u) == 0u) { if (xb_ld(&bar[XB_TMO])) break; if (sp > XB_SPIN_CAP) { atomicAdd(&bar[XB_TMO], 1u); break; } }
    }
    nloc = mine > 0u ? mine : 1u; nx = cnt > 0u ? cnt : 1u;
}

__device__ __forceinline__ void xcd_barrier(const XcdBarrier& b) {
    asm volatile("s_waitcnt vmcnt(0)" ::: "memory");
    __syncthreads();
    if (threadIdx.x == 0) {
        unsigned* bar = b.bar;
        __builtin_amdgcn_s_waitcnt(0);
        unsigned nloc = b.st[0], nx = b.st[1];
        if (nloc == 0u) { xcd_barrier_complete(bar, b.x, nloc, nx); b.st[0] = nloc; b.st[1] = nx; }
        const unsigned old = xb_add(&bar[XB_XSUB(b.x)], 1u);
        const unsigned gen = old / nloc;
        if (old + 1u == (gen + 1u) * nloc) {
            __builtin_amdgcn_fence(__ATOMIC_RELEASE, "agent");
            asm volatile("s_waitcnt vmcnt(0)" ::: "memory");
            const unsigned og = xb_add(&bar[XB_TOP], 1u);
            const unsigned tg = og / nx;
            if (og + 1u == (tg + 1u) * nx) xb_add(&bar[XB_TOPGEN], 1u);
            else XB_SPIN(xb_ld(&bar[XB_TOPGEN]) == tg, bar);
            __builtin_amdgcn_fence(__ATOMIC_ACQUIRE, "agent");
            xb_add(&bar[XB_XGEN(b.x)], 1u);
            asm volatile("s_waitcnt vmcnt(0)" ::: "memory");
        } else {
            XB_SPIN(xb_ld(&bar[XB_XGEN(b.x)]) == gen, bar);
            __builtin_amdgcn_fence(__ATOMIC_ACQUIRE, "agent");
            asm volatile("s_waitcnt vmcnt(0)" ::: "memory");
        }
    }
    __syncthreads();
}

__device__ __forceinline__ void xcd_local_barrier(const XcdBarrier& b) {
    asm volatile("s_waitcnt vmcnt(0)" ::: "memory");
    __syncthreads();
    if (threadIdx.x == 0) {
        unsigned* bar = b.bar;
        __builtin_amdgcn_s_waitcnt(0);
        const unsigned nloc = b.st[0];
        const unsigned old = xb_add(&bar[XB_LSUB(b.x)], 1u);
        const unsigned gen = old / nloc;
        if (old + 1u == (gen + 1u) * nloc) xb_add(&bar[XB_LGEN(b.x)], 1u);
        else XB_SPIN(xb_ld(&bar[XB_LGEN(b.x)]) == gen, bar);
        __builtin_amdgcn_fence(__ATOMIC_ACQUIRE, "agent");
        asm volatile("s_waitcnt vmcnt(0)" ::: "memory");
    }
    __syncthreads();
}

constexpr int NWAVES = 8;
constexpr int BATCH = 16, SEQ = 2048, DM = 1024, M = BATCH * SEQ, DFF = 2816, NMOD = 9216, WIN = 1440, WINP = 1536, NH = 8;
constexpr float EPS = 1e-6f;
constexpr size_t MiB = 1u << 20;
constexpr size_t WS_CTL = 0, CTL_ZERO_BYTES = 64 * 1024;
constexpr size_t WS_MOD = 1 * MiB, WS_ROPE = 2 * MiB;
constexpr size_t WS_W1T = 6 * MiB, WS_WD1T = 17 * MiB, WS_W2T = 23 * MiB, WS_WD2T = 34 * MiB, WS_WINT = 40 * MiB, WS_WQT = 43 * MiB, WS_WKVT = 43 * MiB + 512 * 1024, WS_WOUTT = 44 * MiB;
constexpr size_t WS_A1 = 48 * MiB, WS_ACT = 112 * MiB, WS_V = 288 * MiB, WS_MIX = 320 * MiB, WS_HB = 384 * MiB, WS_END = 448 * MiB;
constexpr size_t WS_SLAB = 22 * MiB;
constexpr size_t WS_ZG = WS_ACT, WS_ZGD = WS_SLAB - 4 * MiB;
constexpr size_t WS_ZC = WS_ACT + 4 * MiB, WS_ZCD = WS_SLAB - (size_t)128 * 26 * 1024;
constexpr size_t WS_Q = WS_ACT + 8 * MiB, WS_QD = WS_SLAB - 6 * MiB;
constexpr size_t WS_K = WS_ACT + 14 * MiB, WS_KD = WS_SLAB - 6 * MiB;
static_assert((size_t)4096 * DFF * 2 == WS_SLAB && (size_t)4096 * 512 * 2 == 4 * MiB && (size_t)2 * 8 * 2048 * 96 * 2 == 6 * MiB && 4 * MiB + (size_t)128 * 26 * 1024 <= 8 * MiB, "class slabs");
static_assert(WS_W1T + (size_t)2 * DFF * DM * 2 <= WS_WD1T && WS_WD1T + (size_t)DM * DFF * 2 <= WS_W2T && WS_WD2T + (size_t)DM * DFF * 2 <= WS_WINT && WS_WINT + (size_t)WINP * DM * 2 <= WS_WQT, "weights map");
static_assert(WS_ACT + (size_t)M * DFF * 2 <= WS_V && WS_MIX + (size_t)M * DM * 2 <= WS_HB && WS_HB + (size_t)M * DM * 2 <= WS_END, "ws map");
constexpr size_t WS_SS1 = WS_CTL + 256 * 1024, WS_SS2 = WS_CTL + 512 * 1024, WS_SS3 = WS_CTL + 768 * 1024;
constexpr size_t WS_SS0 = WS_CTL + 128 * 1024;
constexpr size_t WS_BIAS1 = 46 * MiB + 512 * 1024;
constexpr size_t WS_BIASM = 46 * MiB, WS_BIAS2 = 46 * MiB + 128 * 1024;
constexpr int CW_TMO = 0, CW_BAR = 4096;
constexpr unsigned READY_MAGIC = 0x600DF00Du;
constexpr int LDS_BYTES = 147456, MISC_OFF = LDS_BYTES - 256;
constexpr int NPHASE = 13;
#ifndef MK_N_LAUNCHES
#define MK_N_LAUNCHES 1
#endif

__device__ __forceinline__ unsigned cvtpk(float lo, float hi) { unsigned r; asm volatile("v_cvt_pk_bf16_f32 %0, %1, %2" : "=v"(r) : "v"(lo), "v"(hi)); return r; }
__device__ __forceinline__ float bf_lo(unsigned w) { return __uint_as_float(w << 16); }
__device__ __forceinline__ float bf_hi(unsigned w) { return __uint_as_float(w & 0xffff0000u); }
__device__ __forceinline__ float sigm(float x) { return __builtin_amdgcn_rcpf(1.0f + __builtin_amdgcn_exp2f(-1.4426950408889634f * x)); }
__device__ __forceinline__ float dpp_ror_add(float t, int) { return t; }
__device__ __forceinline__ float wave_sum(float v) {
    v += __uint_as_float((unsigned)__builtin_amdgcn_update_dpp(0, (int)__float_as_uint(v), 0x128, 0xf, 0xf, false));
    v += __uint_as_float((unsigned)__builtin_amdgcn_update_dpp(0, (int)__float_as_uint(v), 0x124, 0xf, 0xf, false));
    v += __uint_as_float((unsigned)__builtin_amdgcn_update_dpp(0, (int)__float_as_uint(v), 0x122, 0xf, 0xf, false));
    v += __uint_as_float((unsigned)__builtin_amdgcn_update_dpp(0, (int)__float_as_uint(v), 0x121, 0xf, 0xf, false));
    { auto rr = __builtin_amdgcn_permlane16_swap(__float_as_uint(v), __float_as_uint(v), false, false); v = __uint_as_float(rr[0]) + __uint_as_float(rr[1]); }
    { auto rr = __builtin_amdgcn_permlane32_swap(__float_as_uint(v), __float_as_uint(v), false, false); v = __uint_as_float(rr[0]) + __uint_as_float(rr[1]); }
    return v;
}
__device__ __forceinline__ float swap_add(float v) { auto rr = __builtin_amdgcn_permlane32_swap(__float_as_uint(v), __float_as_uint(v), false, false); return __uint_as_float(rr[0]) + __uint_as_float(rr[1]); }

struct Args { const void* in[24]; float* out; unsigned char* ws; double invf[16]; int ph_lo, ph_hi, li, pad; };

struct Frame {
    char* lds;
    volatile LAS unsigned* MISC;
    int tid, lane, wave, vcu, G;
};

__device__ __forceinline__ void ph_final(Frame& F, const bf16* H, const float* ss, const float* g, float* out) {
    const int gw = F.vcu * NWAVES + F.wave, NGW = F.G * NWAVES, lane = F.lane;
    f32x4 g0[2], g1[2];
#pragma unroll
    for (int j = 0; j < 2; ++j) { g0[j] = *(const f32x4*)(g + 8 * lane + 512 * j); g1[j] = *(const f32x4*)(g + 8 * lane + 512 * j + 4); }
    for (int rb = gw; rb < M / 16; rb += NGW) {
        const int row0 = (rb - F.wave) * 16 + F.wave;
        const float sv = ss[row0 + 8 * (lane & 15)];
#pragma unroll 4
        for (int r = 0; r < 16; ++r) {
            const float rs = __builtin_amdgcn_rsqf(__uint_as_float((unsigned)__builtin_amdgcn_readlane((int)__float_as_uint(sv), r)) * (1.0f / DM) + EPS);
            const v4u* hr = (const v4u*)(H + (size_t)(row0 + 8 * r) * DM) + lane; f32x4* o4 = (f32x4*)(out + (size_t)(row0 + 8 * r) * DM) + 2 * lane;
#pragma unroll
            for (int j = 0; j < 2; ++j) { const v4u w = __builtin_nontemporal_load(hr + 64 * j);
                const f32x4 a = {bf_lo(w.x), bf_hi(w.x), bf_lo(w.y), bf_hi(w.y)}, b = {bf_lo(w.z), bf_hi(w.z), bf_lo(w.w), bf_hi(w.w)};
                __builtin_nontemporal_store(a * rs * g0[j], o4 + 128 * j); __builtin_nontemporal_store(b * rs * g1[j], o4 + 128 * j + 1); }
        }
    }
}
__device__ __forceinline__ int drow_of(int kind, int n0) {
    if (kind == 0) return n0;
    if (kind == 1) return 256 * (n0 >> 7) + (n0 & 127);
    if (kind == 2) return 256 * (n0 >> 7) + 128 + (n0 & 127);
    if (n0 < 512) return 256 * (n0 >> 7) + (n0 & 127);
    if (n0 < 1024) return 256 * ((n0 - 512) >> 7) + 128 + (n0 & 127);
    return n0;
}
template <int NC> __device__ __forceinline__ void gemv16_unit(int tid, const float* vec, float* red, const float* W, int ldw, int c0, float* out, int ostride, int kind, const float* addv) {
    constexpr int KG = 512 / NC;
    const int kg = tid / NC, col = tid % NC;
    if (kg < KG) {
        f32x4 a0 = {0.f, 0.f, 0.f, 0.f}, a1 = a0, a2 = a0, a3 = a0;
        const float* wp = W + c0 + col;
        int k = kg;
        for (; k + 15 * KG < 1024; k += 16 * KG) {
            float w[16];
#pragma unroll
            for (int i = 0; i < 16; ++i) w[i] = wp[(size_t)(k + i * KG) * ldw];
#pragma unroll
            for (int i = 0; i < 16; ++i) { const f32x4* sv = (const f32x4*)(vec + (k + i * KG) * 16); a0 += sv[0] * w[i]; a1 += sv[1] * w[i]; a2 += sv[2] * w[i]; a3 += sv[3] * w[i]; }
        }
#pragma unroll 4
        for (; k < 1024; k += KG) {
            const float w = wp[(size_t)k * ldw];
            const f32x4* sv = (const f32x4*)(vec + k * 16);
            a0 += sv[0] * w; a1 += sv[1] * w; a2 += sv[2] * w; a3 += sv[3] * w;
        }
        f32x4* rp = (f32x4*)(red + (kg * NC + col) * 16);
        rp[0] = a0; rp[1] = a1; rp[2] = a2; rp[3] = a3;
    }
    __syncthreads();
    for (int idx = tid; idx < NC * 16; idx += 512) { const int cl = idx >> 4, b = idx & 15; float sum = 0.f;
#pragma unroll 8
        for (int g = 0; g < KG; ++g) sum += red[(g * NC + cl) * 16 + b];
        out[(size_t)b * ostride + drow_of(kind, c0 + cl)] = sum + (addv ? addv[c0 + cl] : 0.f); }
    __syncthreads();
}
__device__ __forceinline__ void ph_mod(Frame& F, const float* c, const float* w_ada, const float* b_ada, float* mod) {
    constexpr int SHP = 1032;
    bf16* sch = (bf16*)F.lds; bf16* scl = sch + 16 * SHP;
    float* red = (float*)(F.lds + 69632);
    const int j = F.lane & 15, kq = F.lane >> 4, w = F.wave, jc = j < 9 ? j : 8;
    f32x4 wv[4][8];
#define MOD_LOADW(u_) do { const float* wp_ = w_ada + (size_t)(128 * w + 8 * kq) * NMOD + 36 * (u_) + 4 * jc; \
        _Pragma("unroll") for (int ks = 0; ks < 4; ++ks) _Pragma("unroll") for (int i = 0; i < 8; ++i) wv[ks][i] = __builtin_nontemporal_load((const f32x4*)(wp_ + (size_t)(32 * ks + i) * NMOD)); } while (0)
    int u = F.vcu;
    if (u < 256) MOD_LOADW(u);
    { float cv[32];
#pragma unroll
      for (int q = 0; q < 32; ++q) cv[q] = c[F.tid + 512 * q];
#pragma unroll
      for (int q = 0; q < 32; ++q) { const int idx = F.tid + 512 * q, b = idx >> 10, k = idx & 1023; const float v = cv[q]; const float a = v * sigm(v);
        const unsigned h = f2bf(a); sch[b * SHP + k] = (bf16)h; scl[b * SHP + k] = (bf16)f2bf(a - __uint_as_float(h << 16)); } }
    __syncthreads();
    while (u < 256) {
        const int n0 = 36 * u;
        f32x4 acc[4];
#pragma unroll
        for (int cc = 0; cc < 4; ++cc) acc[cc] = (f32x4){0.f, 0.f, 0.f, 0.f};
#pragma unroll
        for (int ks = 0; ks < 4; ++ks) {
            const bf16x8 ah = *(const bf16x8*)(sch + j * SHP + 128 * w + 32 * ks + 8 * kq), al = *(const bf16x8*)(scl + j * SHP + 128 * w + 32 * ks + 8 * kq);
#pragma unroll
            for (int cc = 0; cc < 4; ++cc) {
                v4u bh, bl;
#pragma unroll
                for (int p = 0; p < 4; ++p) { const float x0 = wv[ks][2 * p][cc], x1 = wv[ks][2 * p + 1][cc]; const unsigned h = cvtpk(x0, x1);
                    bh[p] = h; bl[p] = cvtpk(x0 - __uint_as_float(h << 16), x1 - __uint_as_float(h & 0xffff0000u)); }
                const bf16x8 bhv = __builtin_bit_cast(bf16x8, bh), blv = __builtin_bit_cast(bf16x8, bl);
                acc[cc] = __builtin_amdgcn_mfma_f32_16x16x32_bf16(al, bhv, acc[cc], 0, 0, 0);
                acc[cc] = __builtin_amdgcn_mfma_f32_16x16x32_bf16(ah, blv, acc[cc], 0, 0, 0);
                acc[cc] = __builtin_amdgcn_mfma_f32_16x16x32_bf16(ah, bhv, acc[cc], 0, 0, 0); }
        }
#pragma unroll
        for (int cc = 0; cc < 4; ++cc) *(f32x4*)(red + ((w * 4 + cc) * 64 + F.lane) * 4) = acc[cc];
        __syncthreads();
        for (int idx = F.tid; idx < 576; idx += 512) { const int b = idx / 36, col = idx % 36, jj = col >> 2, cc = col & 3;
            float sum = b_ada[n0 + col];
#pragma unroll
            for (int w8 = 0; w8 < 8; ++w8) sum += red[((w8 * 4 + cc) * 64 + 16 * (b >> 2) + jj) * 4 + (b & 3)];
            mod[(size_t)b * NMOD + n0 + col] = sum; }
        __syncthreads();
        u += F.G; if (u < 256) MOD_LOADW(u);
    }
#undef MOD_LOADW
}

struct NoMid { __device__ __forceinline__ void operator()() const {} };
template <int MODE, class Mid = NoMid> __device__ __forceinline__ void ph_rownorm(Frame& F, const float* src, const float* sc, const float* sh, bf16* dstb, float* dstf, const Mid& mid = Mid()) {
    bool mid_done = false;
    const int gw = F.vcu * NWAVES + F.wave, NGW = F.G * NWAVES, lane = F.lane;
    for (int rb = gw; rb < M / 16; rb += NGW) {
        const int row0 = rb * 16, b = row0 >> 11;
        f32x4 s[4], t[4];
#pragma unroll
        for (int j = 0; j < 4; ++j) {
            if (MODE == 0) { s[j] = *(const f32x4*)(sc + (size_t)b * NMOD + 4 * lane + 256 * j) + 1.0f; t[j] = *(const f32x4*)(sh + (size_t)b * NMOD + 4 * lane + 256 * j); }
            else if (MODE == 2) { s[j] = pg8::ada_scale(*(const f32x4*)(sc + (size_t)b * NMOD + 4 * lane + 256 * j)); t[j] = (f32x4){0.f, 0.f, 0.f, 0.f}; }
            else { s[j] = *(const f32x4*)(sc + 4 * lane + 256 * j); t[j] = (f32x4){0.f, 0.f, 0.f, 0.f}; }
        }
        if constexpr (MODE == 2) {
            f32x4 va[2][4], vb[2][4];
            const int wrow0 = (rb - F.wave) * 16 + F.wave;
#define RN_LOAD(V, p) do { _Pragma("unroll") for (int q = 0; q < 2; ++q) { const f32x4* xr_ = (const f32x4*)(src + (size_t)(wrow0 + 8 * (2 * (p) + q)) * DM) + lane; \
                _Pragma("unroll") for (int j = 0; j < 4; ++j) V[q][j] = __builtin_nontemporal_load(xr_ + 64 * j); } } while (0)
#define RN_PROC(V, p) do { _Pragma("unroll") for (int q = 0; q < 2; ++q) { const int r_ = wrow0 + 8 * (2 * (p) + q); float ss_ = 0.f; \
                unsigned long long* o8_ = (unsigned long long*)(dstb + (size_t)r_ * DM) + lane; \
                _Pragma("unroll") for (int j = 0; j < 4; ++j) { const f32x4 x_ = V[q][j]; ss_ += (x_.x * x_.x + x_.y * x_.y) + (x_.z * x_.z + x_.w * x_.w); const f32x4 o_ = x_ * s[j]; \
                    o8_[64 * j] = (unsigned long long)cvtpk(o_.x, o_.y) | ((unsigned long long)cvtpk(o_.z, o_.w) << 32); } \
                const float tot_ = wave_sum(ss_); if (lane == 0) dstf[r_] = tot_; } } while (0)
            RN_LOAD(va, 0);
            if (!mid_done) { mid(); mid_done = true; }
#pragma unroll 1
            for (int p = 0; p < 8; p += 2) { RN_LOAD(vb, p + 1); RN_PROC(va, p); if (p + 2 < 8) RN_LOAD(va, p + 2); RN_PROC(vb, p + 1); }
#undef RN_LOAD
#undef RN_PROC
            continue;
        }
#pragma unroll 2
        for (int r = 0; r < 16; ++r) {
            const f32x4* xr = (const f32x4*)(src + (size_t)(row0 + r) * DM) + lane;
            f32x4 v[4]; float ss = 0.f;
#pragma unroll
            for (int j = 0; j < 4; ++j) { v[j] = __builtin_nontemporal_load(xr + 64 * j); ss += (v[j].x * v[j].x + v[j].y * v[j].y) + (v[j].z * v[j].z + v[j].w * v[j].w); }
            if (MODE == 2) {
                unsigned long long* o8 = (unsigned long long*)(dstb + (size_t)(row0 + r) * DM) + lane;
#pragma unroll
                for (int j = 0; j < 4; ++j) { const f32x4 o = v[j] * s[j]; o8[64 * j] = (unsigned long long)cvtpk(o.x, o.y) | ((unsigned long long)cvtpk(o.z, o.w) << 32); }
                const float tot = wave_sum(ss); if (lane == 0) dstf[row0 + r] = tot;
                continue; }
            const float rs = __builtin_amdgcn_rsqf(wave_sum(ss) * (1.0f / DM) + EPS);
            if (MODE == 0) {
                unsigned long long* o8 = (unsigned long long*)(dstb + (size_t)(row0 + r) * DM) + lane;
#pragma unroll
                for (int j = 0; j < 4; ++j) { const f32x4 o = v[j] * rs * s[j] + t[j]; o8[64 * j] = (unsigned long long)cvtpk(o.x, o.y) | ((unsigned long long)cvtpk(o.z, o.w) << 32); }
            } else {
                f32x4* o4 = (f32x4*)(dstf + (size_t)(row0 + r) * DM) + lane;
#pragma unroll
                for (int j = 0; j < 4; ++j) o4[64 * j] = v[j] * rs * s[j];
            }
        }
    }
    if (!mid_done) mid();
}

struct TrItem { const float* src; const float* ks; bf16* dst; int N, K; };
__device__ __forceinline__ void tr_load(float (&v)[32], const TrItem& t, int lane) {
    const float* wp0 = t.src + (size_t)(lane >> 5) * t.N + (lane & 31);
#pragma unroll
    for (int i = 0; i < 32; ++i) v[i] = __builtin_nontemporal_load(wp0 + (size_t)(2 * i) * t.N);
}
__device__ __forceinline__ void tr_finish(float (&v)[32], const TrItem& t, float* scr, int lane) {
    if (t.ks) {
#pragma unroll
        for (int i = 0; i < 32; ++i) v[i] *= t.ks[2 * i + (lane >> 5)]; }
#pragma unroll
    for (int i = 0; i < 32; ++i) scr[(2 * i + (lane >> 5)) * 33 + (lane & 31)] = v[i];
    LDS_WAIT(); asm volatile("" ::: "memory");
    const int c = lane & 7;
#pragma unroll
    for (int j = 0; j < 4; ++j) { const int n = (lane >> 3) + 8 * j; const float* s = scr + (8 * c) * 33 + n;
        v4u o; o.x = cvtpk(s[0 * 33], s[1 * 33]); o.y = cvtpk(s[2 * 33], s[3 * 33]); o.z = cvtpk(s[4 * 33], s[5 * 33]); o.w = cvtpk(s[6 * 33], s[7 * 33]);
        { bf16* wp_ = t.dst + (size_t)n * t.K + 8 * c; asm volatile("global_store_dwordx4 %0, %1, off sc1\n\ts_nop 1" :: "v"(wp_), "v"(o) : "memory"); } }
    LDS_WAIT(); asm volatile("" ::: "memory");
}
__device__ __forceinline__ void ph_weights(Frame& F, const __attribute__((address_space(4))) Args* ap) {
    const __attribute__((address_space(4))) Args& a = *ap;
    const float* in[24];
#pragma unroll
    for (int i = 0; i < 24; ++i) in[i] = (const float*)a.in[i];
    unsigned char* ws = a.ws;
    const int gw = F.vcu * NWAVES + F.wave, NGW = F.G * NWAVES;
    float* scr = (float*)(F.lds + F.wave * 16384);
    constexpr int I_GU = (DM / 64) * (DFF / 32), I_D = (DFF / 64) * (DM / 32), I_IN = (DM / 64) * (WIN / 32), I_Q = (256 / 64) * (768 / 32), I_KV = (128 / 64) * (1024 / 32), I_O = (DM / 64) * (DM / 32);
    constexpr int NITEMS = 4 * I_GU + 2 * I_D + I_IN + I_Q + I_KV + I_O;
    auto decode = [&](int it) -> TrItem {
        int r = it; const float* W; int K, N, kind; bf16* WT; const float* ks = nullptr;
        if (r < I_GU) { W = in[5]; K = DM; N = DFF; kind = 1; WT = (bf16*)(ws + WS_W1T); }
        else if ((r -= I_GU) < I_GU) { W = in[6]; K = DM; N = DFF; kind = 2; WT = (bf16*)(ws + WS_W1T); }
        else if ((r -= I_GU) < I_D) { W = in[7]; K = DFF; N = DM; kind = 0; WT = (bf16*)(ws + WS_WD1T); }
        else if ((r -= I_D) < I_GU) { W = in[20]; K = DM; N = DFF; kind = 1; WT = (bf16*)(ws + WS_W2T); }
        else if ((r -= I_GU) < I_GU) { W = in[21]; K = DM; N = DFF; kind = 2; WT = (bf16*)(ws + WS_W2T); }
        else if ((r -= I_GU) < I_D) { W = in[22]; K = DFF; N = DM; kind = 0; WT = (bf16*)(ws + WS_WD2T); }
        else if ((r -= I_D) < I_IN) { W = in[8]; K = DM; N = WIN; kind = 3; WT = (bf16*)(ws + WS_WINT); }
        else if ((r -= I_IN) < I_Q) { W = in[11]; K = 256; N = 768; kind = 0; WT = (bf16*)(ws + WS_WQT); ks = in[9]; }
        else if ((r -= I_Q) < I_KV) { W = in[12]; K = 128; N = 1024; kind = 0; WT = (bf16*)(ws + WS_WKVT); ks = in[10]; }
        else { r -= I_KV; W = in[19]; K = DM; N = DM; kind = 0; WT = (bf16*)(ws + WS_WOUTT); }
        const int nblk = N / 32, kb = r / nblk, nb = r % nblk;
        TrItem t; t.src = W + (size_t)(64 * kb) * N + 32 * nb; t.ks = ks ? ks + 64 * kb : nullptr; t.dst = WT + (size_t)drow_of(kind, 32 * nb) * K + 64 * kb; t.N = N; t.K = K; return t; };
    { float va[32], vb[32]; TrItem A, B; int it = gw; bool hasA = it < NITEMS;
      if (hasA) { A = decode(it); tr_load(va, A, F.lane); }
      while (hasA) {
          const int itb = it + NGW; const bool hasB = itb < NITEMS;
          if (hasB) { B = decode(itb); tr_load(vb, B, F.lane); }
          tr_finish(va, A, scr, F.lane);
          if (!hasB) break;
          it = itb + NGW; hasA = it < NITEMS;
          if (hasA) { A = decode(it); tr_load(va, A, F.lane); }
          tr_finish(vb, B, scr, F.lane);
      } }
    { const int gt = F.vcu * 512 + F.tid, NT = F.G * 512; v4u z = {0u, 0u, 0u, 0u};
      for (int i = gt; i < 3 * (M / 4); i += NT) { const int a = i / (M / 4), j = i % (M / 4); *((v4u*)(ws + WS_SS1 + (size_t)a * 256 * 1024) + j) = z; } }
    { const int gt = F.vcu * 512 + F.tid, NT = F.G * 512; v4u z = {0u, 0u, 0u, 0u};
      for (int i = gt; i < 96 * 128; i += NT) *((v4u*)(ws + WS_WINT + (size_t)1440 * DM * 2) + i) = z; }
    { const int gt = F.vcu * 512 + F.tid, NT = F.G * 512; const int* pos = (const int*)a.in[2]; float* tab = (float*)(ws + WS_ROPE);
      const int i = gt & 15; double f = 0.0;
#pragma unroll
      for (int k = 0; k < 16; ++k) f = (i == k) ? a.invf[k] : f;
      f *= 0.15915494309189535;
      int idx = gt;
      for (; idx + 3 * NT < M * 16; idx += 4 * NT) {
          int p[4];
#pragma unroll
          for (int q = 0; q < 4; ++q) p[q] = pos[(idx + q * NT) >> 4];
#pragma unroll
          for (int q = 0; q < 4; ++q) { const int m = (idx + q * NT) >> 4; double rv = (double)p[q] * f; rv -= __builtin_rint(rv); const float fr = (float)rv;
              tab[m * 32 + i] = __builtin_amdgcn_cosf(fr); tab[m * 32 + 16 + i] = __builtin_amdgcn_sinf(fr); } }
      for (; idx < M * 16; idx += NT) { const int m = idx >> 4; double rv = (double)pos[m] * f; rv -= __builtin_rint(rv); const float fr = (float)rv;
          tab[m * 32 + i] = __builtin_amdgcn_cosf(fr); tab[m * 32 + 16 + i] = __builtin_amdgcn_sinf(fr); } }
}
__device__ __forceinline__ void ph_prep(Frame& F, const __attribute__((address_space(4))) Args* ap) {
    const __attribute__((address_space(4))) Args& a = *ap;
    const float* in[24];
#pragma unroll
    for (int i = 0; i < 24; ++i) in[i] = (const float*)a.in[i];
    unsigned char* ws = a.ws;
    const int gw = F.vcu * NWAVES + F.wave, NGW = F.G * NWAVES;
    float* scr = (float*)(F.lds + F.wave * 16384);
    const float* mod = (const float*)(ws + WS_MOD);
    auto bias_block = [&]() {
    { constexpr int SHP = 1032;
      bf16* shl = (bf16*)F.lds;
#pragma unroll 1
      for (int ty = 0; ty < 3; ++ty) { const int chunk = ty == 0 ? 0 : (ty == 1 ? 6 : 3); float mv[32];
#pragma unroll
          for (int q = 0; q < 32; ++q) { const int idx = F.tid + 512 * q, b = idx >> 10, k = idx & 1023; mv[q] = mod[(size_t)b * NMOD + chunk * DM + k]; }
#pragma unroll
          for (int q = 0; q < 32; ++q) { const int idx = F.tid + 512 * q, b = idx >> 10, k = idx & 1023; shl[(ty * 16 + b) * SHP + k] = (bf16)f2bf(mv[q]); } }
      __syncthreads();
      const int bl = F.lane & 15, kq = F.lane >> 4;
      for (int t = F.wave * F.G + F.vcu; t < 800; t += NGW) {
          int ty, r0, bs; const bf16* WT; float* bias;
          if (t < 352) { ty = 0; r0 = 16 * t; WT = (const bf16*)(ws + WS_W1T); bias = (float*)(ws + WS_BIAS1); bs = 2 * DFF; }
          else if (t < 704) { ty = 1; r0 = 16 * (t - 352); WT = (const bf16*)(ws + WS_W2T); bias = (float*)(ws + WS_BIAS2); bs = 2 * DFF; }
          else { ty = 2; r0 = 16 * (t - 704); WT = (const bf16*)(ws + WS_WINT); bias = (float*)(ws + WS_BIASM); bs = WINP; }
          const bf16* wrow = WT + (size_t)(r0 + bl) * DM + 8 * kq;
          const bf16* arow = shl + (ty * 16 + bl) * SHP + 8 * kq;
          f32x4 acc = {0.f, 0.f, 0.f, 0.f};
          bf16x8 bw[32];
#pragma unroll
          for (int ks = 0; ks < 32; ++ks) bw[ks] = *(const bf16x8*)(wrow + 32 * ks);
#pragma unroll
          for (int ks = 0; ks < 32; ++ks) {
              const bf16x8 av = *(const bf16x8*)(arow + 32 * ks);
              acc = __builtin_amdgcn_mfma_f32_16x16x32_bf16(av, bw[ks], acc, 0, 0, 0); }
#pragma unroll
          for (int e = 0; e < 4; ++e) bias[(size_t)(4 * kq + e) * bs + r0 + bl] = acc[e];
      }
      __syncthreads(); }
    };
    ph_rownorm<2>(F, in[0], mod + 1 * DM, nullptr, (bf16*)(ws + WS_A1), (float*)(ws + WS_SS0), bias_block);
}

typedef float cf32x2 __attribute__((ext_vector_type(2)));
template <int S> __device__ __forceinline__ void conv_row(cf32x2 (&a)[16], const cf32x2 (&w)[31], const char* base) {
    const unsigned v = *(const unsigned*)(base + S * 1024); const cf32x2 x = {bf_lo(v), bf_hi(v)};
#pragma unroll
    for (int t = 0; t < 16; ++t) { const int j = S - t; if (j >= 0 && j < 31) a[t] = __builtin_elementwise_fma(w[j], x, a[t]); }
}
template <int S0, int S1> __device__ __forceinline__ void conv_rows(cf32x2 (&a)[16], const cf32x2 (&w)[31], const char* base) {
    if constexpr (S0 < S1) { conv_row<S0>(a, w, base); conv_rows<S0 + 1, S1>(a, w, base); }
}
__device__ __forceinline__ void ph_conv(Frame& F, const bf16* ZG, const float* cw, const float* cb, const float* lg, const float* lb, bf16* MIX) {
    char* lds = F.lds; const int tid = F.tid, lane = F.lane, wave = F.wave;
    const int cp = tid & 255, th = tid >> 8;
    constexpr int NU = M / 32;
    const int per = (NU + F.G - 1) / F.G, u0 = F.vcu * per, u1 = (u0 + per < NU) ? u0 + per : NU;
    if (u0 >= u1) return;
    cf32x2 wv[31];
#pragma unroll
    for (int j = 0; j < 31; ++j) { const float2 w = *(const float2*)(cw + j * 512 + 2 * cp); wv[j] = (cf32x2){w.x, w.y}; }
    const float2 bias = *(const float2*)(cb + 2 * cp);
    const f32x4 g0 = *(const f32x4*)(lg + 8 * lane), g1 = *(const f32x4*)(lg + 8 * lane + 4), b0 = *(const f32x4*)(lb + 8 * lane), b1 = *(const f32x4*)(lb + 8 * lane + 4);
    v4u tv[8];
#define CONV_LOAD(uu) do { const int m0_ = (uu) * 32, t0_ = m0_ & (SEQ - 1); const bf16* ZGc = ZG + (size_t)(m0_ >> 12) * (WS_ZGD / 2); _Pragma("unroll") for (int i = 0; i < 8; ++i) { const int id = tid + 512 * i; const int row = id >> 6, c = id & 63, t = t0_ - 15 + row; \
        const int tc = t < 0 ? 0 : (t > SEQ - 1 ? SEQ - 1 : t); tv[i] = *(const v4u*)(ZGc + (size_t)(m0_ - t0_ + tc) * 512 + c * 8); } } while (0)
#define CONV_WRITE(uu) do { const int t0_ = ((uu) * 32) & (SEQ - 1); _Pragma("unroll") for (int i = 0; i < 8; ++i) { const int id = tid + 512 * i; const int row = id >> 6, c = id & 63, t = t0_ - 15 + row; const bool ok = (t >= 0 && t < SEQ); \
        v4u v = tv[i]; v.x = ok ? v.x : 0u; v.y = ok ? v.y : 0u; v.z = ok ? v.z : 0u; v.w = ok ? v.w : 0u; if (row < 62) *(v4u*)(lds + row * 1024 + c * 16) = v; } } while (0)
    CONV_LOAD(u0); CONV_WRITE(u0);
    __syncthreads();
    for (int u = u0; u < u1; ++u) {
        const int m0 = u * 32;
        if (u + 1 < u1) CONV_LOAD(u + 1);
        cf32x2 av[16];
#pragma unroll
        for (int t = 0; t < 16; ++t) av[t] = (cf32x2){bias.x, bias.y};
        conv_rows<0, 46>(av, wv, lds + th * 16 * 1024 + cp * 4);
#pragma unroll
        for (int t = 0; t < 16; ++t) *(cf32x2*)(lds + 65536 + (th * 16 + t) * 2048 + cp * 8) = av[t];
        asm volatile("s_waitcnt lgkmcnt(0)\n\ts_barrier" ::: "memory");
        if (u + 1 < u1) CONV_WRITE(u + 1);
#pragma unroll
        for (int i = 0; i < 4; ++i) { const int t = wave * 4 + i;
            const f32x4 x0 = *(const f32x4*)(lds + 65536 + t * 2048 + lane * 32), x1 = *(const f32x4*)(lds + 65536 + t * 2048 + lane * 32 + 16);
            const float mu = wave_sum((x0.x + x0.y) + (x0.z + x0.w) + (x1.x + x1.y) + (x1.z + x1.w)) * (1.0f / 512.0f);
            const f32x4 d0 = x0 - mu, d1 = x1 - mu;
            const float var = wave_sum((d0.x * d0.x + d0.y * d0.y) + (d0.z * d0.z + d0.w * d0.w) + (d1.x * d1.x + d1.y * d1.y) + (d1.z * d1.z + d1.w * d1.w)) * (1.0f / 512.0f);
            const float rs = __builtin_amdgcn_rsqf(var + 1e-5f);
            f32x4 y0 = d0 * rs * g0 + b0, y1 = d1 * rs * g1 + b1;
            y0.x *= sigm(y0.x); y0.y *= sigm(y0.y); y0.z *= sigm(y0.z); y0.w *= sigm(y0.w); y1.x *= sigm(y1.x); y1.y *= sigm(y1.y); y1.z *= sigm(y1.z); y1.w *= sigm(y1.w);
            v4u o; o.x = cvtpk(y0.x, y0.y); o.y = cvtpk(y0.z, y0.w); o.z = cvtpk(y1.x, y1.y); o.w = cvtpk(y1.z, y1.w);
            *(v4u*)(MIX + (size_t)(m0 + t) * DM + 8 * lane) = o; }
        asm volatile("s_waitcnt lgkmcnt(0)\n\ts_barrier" ::: "memory");
    }
#undef CONV_LOAD
#undef CONV_WRITE
}

namespace lat {
using f32x16 = __attribute__((ext_vector_type(16))) float;
constexpr int WQ_ROW = 528, WKV_ROW = 272;
constexpr int WQ_OFF = 0, WKV_OFF = 96 * WQ_ROW, SCR_OFF = WKV_OFF + 128 * WKV_ROW, SCR_W = 6656, G_OFF = SCR_OFF + 8 * SCR_W;
__device__ __forceinline__ int crow(int r, int hi) { return (r & 3) + 8 * (r >> 2) + 4 * hi; }
}
__device__ __forceinline__ void ph_latent(Frame& F, const bf16* ZC, const bf16* Wqt, const bf16* Wkvt, const float* gqh, const float* gkh, const float* tab, bf16* Qo, bf16* Ko, bf16* Vo) {
    using namespace lat;
    char* lds = F.lds; const int tid = F.tid, lane = F.lane, wave = F.wave, r32 = lane & 31, hi = lane >> 5;
    float* gl = (float*)(lds + G_OFF);
    if (tid < 96) gl[tid] = gqh[tid]; else if (tid < 192) gl[tid] = gkh[tid - 96];
    char* scr = lds + SCR_OFF + wave * SCR_W;
    const char* const wqb = lds + WQ_OFF + r32 * WQ_ROW + hi * 16; const char* const wkvb = lds + WKV_OFF + r32 * WKV_ROW + hi * 16;
    for (int u = F.vcu; u < 256; u += F.G) {
        const int h = u & 7, rng = u >> 3;
        const bf16* const ZCc = ZC + (size_t)(rng >> 2) * (WS_ZCD / 2); bf16* const Qc = Qo + (size_t)(rng >> 2) * (WS_QD / 2); bf16* const Kc = Ko + (size_t)(rng >> 2) * (WS_KD / 2);
        __syncthreads();
#pragma unroll
        for (int i = 0; i < 6; ++i) { const int id = tid + 512 * i, row = id >> 5, c = id & 31; const v4u v = *((const v4u*)(Wqt + (size_t)h * 96 * 256) + id);
            *(v4u*)(lds + WQ_OFF + row * WQ_ROW + c * 16) = v; }
#pragma unroll
        for (int i = 0; i < 4; ++i) { const int id = tid + 512 * i, row = id >> 4, c = id & 15; const v4u v = *((const v4u*)(Wkvt + (size_t)h * 128 * 128) + id);
            *(v4u*)(lds + WKV_OFF + row * WKV_ROW + c * 16) = v; }
        __syncthreads();
        bf16x8 ql[16];
        { const char* zt0 = (const char*)ZCc + (size_t)((rng * 1024 + wave * 32) >> 5) * 26 * 1024 + hi * 512 + r32 * 16;
#pragma unroll
          for (int ks = 0; ks < 8; ++ks) ql[ks] = *(const bf16x8*)(zt0 + ks * 1024); }
        for (int it = 0; it < 4; ++it) {
            const int mw = rng * 1024 + it * 256 + wave * 32;
            const int m = mw + r32, b = mw >> 11, s0 = mw & (SEQ - 1);
            const char* zt = (const char*)ZCc + (size_t)(mw >> 5) * 26 * 1024 + hi * 512 + r32 * 16;
#pragma unroll
            for (int ks = 8; ks < 16; ++ks) ql[ks] = *(const bf16x8*)(zt + ks * 1024);
            float cs[8], sn[8];
#pragma unroll
            for (int g = 0; g < 2; ++g) { const f32x4 c4 = *(const f32x4*)(tab + (size_t)m * 32 + 8 * g + 4 * hi), s4 = *(const f32x4*)(tab + (size_t)m * 32 + 16 + 8 * g + 4 * hi);
#pragma unroll
                for (int e = 0; e < 4; ++e) { cs[4 * g + e] = c4[e]; sn[4 * g + e] = s4[e]; } }
            {
                float sq = 0.f;
                f32x16 q0 = {}, q1 = {}, q2 = {};
#pragma unroll
                for (int ks = 0; ks < 16; ++ks) { const char* wp = wqb + ks * 32;
                    const bf16x8 a0 = *(const bf16x8*)(wp), a1 = *(const bf16x8*)(wp + 32 * WQ_ROW), a2 = *(const bf16x8*)(wp + 64 * WQ_ROW);
                    q0 = __builtin_amdgcn_mfma_f32_32x32x16_bf16(a0, ql[ks], q0, 0, 0, 0);
                    q1 = __builtin_amdgcn_mfma_f32_32x32x16_bf16(a1, ql[ks], q1, 0, 0, 0);
                    q2 = __builtin_amdgcn_mfma_f32_32x32x16_bf16(a2, ql[ks], q2, 0, 0, 0);
#pragma unroll
                    for (int e = 0; e < 8; ++e) { const float v = __uint_as_float(((unsigned)(unsigned short)ql[ks][e]) << 16); sq = fmaf(v, v, sq); }
                    __builtin_amdgcn_sched_barrier(0); }
                const float rq = __builtin_amdgcn_rsqf(swap_add(sq) * (1.0f / 256.0f) + EPS);
                float ss = 0.f;
#pragma unroll
                for (int r = 0; r < 16; ++r) ss += q0[r] * q0[r] + q1[r] * q1[r] + q2[r] * q2[r];
                ss = swap_add(ss);
                const float f = att::QSCALE * rq * __builtin_amdgcn_rsqf(rq * rq * ss * (1.0f / 96.0f) + EPS);
#pragma unroll
                for (int g = 0; g < 4; ++g) { const f32x4 ga = *(const f32x4*)(gl + 8 * g + 4 * hi), gb = *(const f32x4*)(gl + 32 + 8 * g + 4 * hi), gc = *(const f32x4*)(gl + 64 + 8 * g + 4 * hi);
#pragma unroll
                    for (int e = 0; e < 4; ++e) { q0[4 * g + e] *= f * ga[e]; q1[4 * g + e] *= f * gb[e]; q2[4 * g + e] *= f * gc[e]; } }
#pragma unroll
                for (int r = 0; r < 8; ++r) { const float x1 = q2[r], x2 = q2[r + 8]; q2[r] = x1 * cs[r] - x2 * sn[r]; q2[r + 8] = x2 * cs[r] + x1 * sn[r]; }
#pragma unroll
                for (int g = 0; g < 4; ++g) {
                    *(uint2*)(scr + r32 * 208 + (8 * g + 4 * hi) * 2) = make_uint2(cvtpk(q0[4 * g], q0[4 * g + 1]), cvtpk(q0[4 * g + 2], q0[4 * g + 3]));
                    *(uint2*)(scr + r32 * 208 + (32 + 8 * g + 4 * hi) * 2) = make_uint2(cvtpk(q1[4 * g], q1[4 * g + 1]), cvtpk(q1[4 * g + 2], q1[4 * g + 3]));
                    *(uint2*)(scr + r32 * 208 + (64 + 8 * g + 4 * hi) * 2) = make_uint2(cvtpk(q2[4 * g], q2[4 * g + 1]), cvtpk(q2[4 * g + 2], q2[4 * g + 3])); }
                LDS_WAIT();
                bf16* dst = Qc + ((size_t)(b * NH + h) * SEQ + s0) * 96;
#pragma unroll
                for (int i = 0; i < 6; ++i) { const int id = lane + 64 * i, row = id / 12, c = id % 12; *((v4u*)dst + id) = *(const v4u*)(scr + row * 208 + c * 16); }
                LDS_WAIT();
            }
            {
                asm volatile("" ::: "memory");
                bf16x8 kl[8];
#pragma unroll
                for (int ks = 0; ks < 8; ++ks) kl[ks] = *(const bf16x8*)(zt + (16 + ks) * 1024);
                uint2 krw[4];
#pragma unroll
                for (int g = 0; g < 4; ++g) krw[g] = *(const uint2*)((const char*)ZCc + (size_t)(mw >> 5) * 26 * 1024 + (24 + (g >> 1)) * 1024 + (g & 1) * 512 + r32 * 16 + hi * 8);
                float skv = 0.f;
#pragma unroll
                for (int ks = 0; ks < 8; ++ks)
#pragma unroll
                    for (int e = 0; e < 8; ++e) { const float v = __uint_as_float(((unsigned)(unsigned short)kl[ks][e]) << 16); skv = fmaf(v, v, skv); }
                const float rkv = __builtin_amdgcn_rsqf(swap_add(skv) * (1.0f / 128.0f) + EPS);
                float kr[16];
#pragma unroll
                for (int g = 0; g < 4; ++g) { kr[4 * g] = bf_lo(krw[g].x); kr[4 * g + 1] = bf_hi(krw[g].x); kr[4 * g + 2] = bf_lo(krw[g].y); kr[4 * g + 3] = bf_hi(krw[g].y); }
                float skr = 0.f;
#pragma unroll
                for (int r = 0; r < 16; ++r) skr = fmaf(kr[r], kr[r], skr);
                skr = swap_add(skr);
                f32x16 k0 = {}, k1 = {}, v0 = {}, v1 = {};
#pragma unroll
                for (int ks = 0; ks < 8; ++ks) { const char* wp = wkvb + ks * 32;
                    const bf16x8 a0 = *(const bf16x8*)(wp), a1 = *(const bf16x8*)(wp + 32 * WKV_ROW), a2 = *(const bf16x8*)(wp + 64 * WKV_ROW), a3 = *(const bf16x8*)(wp + 96 * WKV_ROW);
                    k0 = __builtin_amdgcn_mfma_f32_32x32x16_bf16(a0, kl[ks], k0, 0, 0, 0);
                    k1 = __builtin_amdgcn_mfma_f32_32x32x16_bf16(a1, kl[ks], k1, 0, 0, 0);
                    v0 = __builtin_amdgcn_mfma_f32_32x32x16_bf16(a2, kl[ks], v0, 0, 0, 0);
                    v1 = __builtin_amdgcn_mfma_f32_32x32x16_bf16(a3, kl[ks], v1, 0, 0, 0); }
#pragma unroll
                for (int g = 0; g < 4; ++g) {
                    *(uint2*)(scr + r32 * 144 + (8 * g + 4 * hi) * 2) = make_uint2(cvtpk(v0[4 * g] * rkv, v0[4 * g + 1] * rkv), cvtpk(v0[4 * g + 2] * rkv, v0[4 * g + 3] * rkv));
                    *(uint2*)(scr + r32 * 144 + (32 + 8 * g + 4 * hi) * 2) = make_uint2(cvtpk(v1[4 * g] * rkv, v1[4 * g + 1] * rkv), cvtpk(v1[4 * g + 2] * rkv, v1[4 * g + 3] * rkv)); }
                LDS_WAIT();
                bf16* dv = Vo + ((size_t)(b * NH + h) * SEQ + s0) * 64;
#pragma unroll
                for (int i = 0; i < 4; ++i) { const int id = lane + 64 * i, row = id >> 3, c = id & 7; *((v4u*)dv + id) = *(const v4u*)(scr + row * 144 + c * 16); }
                LDS_WAIT();
                asm volatile("" ::: "memory");
                if (it < 3) {
#pragma unroll
                    for (int ks = 0; ks < 8; ++ks) ql[ks] = *(const bf16x8*)(zt + 8 * 26 * 1024 + ks * 1024); }
                asm volatile("" ::: "memory");
                float ss = 0.f;
#pragma unroll
                for (int r = 0; r < 16; ++r) ss += k0[r] * k0[r] + k1[r] * k1[r];
                ss = swap_add(ss);
                const float rn = __builtin_amdgcn_rsqf((rkv * rkv * ss + skr) * (1.0f / 96.0f) + EPS), f = rkv * rn;
                float kq[16];
#pragma unroll
                for (int g = 0; g < 4; ++g) { const f32x4 ga = *(const f32x4*)(gl + 96 + 8 * g + 4 * hi), gb = *(const f32x4*)(gl + 96 + 32 + 8 * g + 4 * hi), gc = *(const f32x4*)(gl + 96 + 64 + 8 * g + 4 * hi);
#pragma unroll
                    for (int e = 0; e < 4; ++e) { k0[4 * g + e] *= f * ga[e]; k1[4 * g + e] *= f * gb[e]; kq[4 * g + e] = kr[4 * g + e] * rn * gc[e]; } }
#pragma unroll
                for (int r = 0; r < 8; ++r) { const float x1 = kq[r], x2 = kq[r + 8]; kq[r] = x1 * cs[r] - x2 * sn[r]; kq[r + 8] = x2 * cs[r] + x1 * sn[r]; }
#pragma unroll
                for (int g = 0; g < 4; ++g) {
                    *(uint2*)(scr + r32 * 208 + (8 * g + 4 * hi) * 2) = make_uint2(cvtpk(k0[4 * g], k0[4 * g + 1]), cvtpk(k0[4 * g + 2], k0[4 * g + 3]));
                    *(uint2*)(scr + r32 * 208 + (32 + 8 * g + 4 * hi) * 2) = make_uint2(cvtpk(k1[4 * g], k1[4 * g + 1]), cvtpk(k1[4 * g + 2], k1[4 * g + 3]));
                    *(uint2*)(scr + r32 * 208 + (64 + 8 * g + 4 * hi) * 2) = make_uint2(cvtpk(kq[4 * g], kq[4 * g + 1]), cvtpk(kq[4 * g + 2], kq[4 * g + 3])); }
                LDS_WAIT();
                bf16* dk = Kc + ((size_t)(b * NH + h) * SEQ + s0) * 96;
#pragma unroll
                for (int i = 0; i < 6; ++i) { const int id = lane + 64 * i, row = id / 12, c = id % 12; *((v4u*)dk + id) = *(const v4u*)(scr + row * 208 + c * 16); }
                LDS_WAIT();
            }
        }
    }
    __syncthreads();
}

__device__ __forceinline__ void ph_attn(Frame& F, const bf16* Q, const bf16* K, const bf16* V, bf16* MIX, bf16* DUMMY, const float* gqh, const float* gkh) {
    float gq = 0.f, gk = 0.f;
    for (int i = F.lane; i < 96; i += 64) { gq = fmaxf(gq, fabsf(gqh[i])); gk = fmaxf(gk, fabsf(gkh[i])); }
#pragma unroll
    for (int o = 1; o < 64; o <<= 1) { gq = fmaxf(gq, __shfl_xor(gq, o)); gk = fmaxf(gk, __shfl_xor(gk, o)); }
    const bool nomax = __builtin_amdgcn_readfirstlane((gq * gk * 14.136f * 1.05f <= 64.f) ? 1 : 0) != 0;
    for (int i = 0;; ++i) {
        int bh, qb;
        if (F.G == 256) { if (i >= 2) break; bh = (2 * (F.vcu >> 5) + i) * NH + ((F.vcu & 31) >> 2); qb = F.vcu & 3; }
        else { const int L = i * F.G + F.vcu; if (L >= BATCH * NH * 4) break; bh = L >> 2; qb = L & 3; }
        const int b = bh >> 3, h = bh & 7;
        const bf16* const Qk = Q + (size_t)(b >> 1) * (WS_QD / 2); const bf16* const Kk = K + (size_t)(b >> 1) * (WS_KD / 2);
        if (nomax) att::attn_unit64<true>(Qk + ((size_t)bh * SEQ + qb * 512) * 96, Kk + (size_t)bh * SEQ * 96, V + (size_t)bh * SEQ * 64, MIX + ((size_t)b * SEQ + qb * 512) * DM + 512 + h * 64, DM, SEQ, F.lds);
        else att::attn_unit64<false>(Qk + ((size_t)bh * SEQ + qb * 512) * 96, Kk + (size_t)bh * SEQ * 96, V + (size_t)bh * SEQ * 64, MIX + ((size_t)b * SEQ + qb * 512) * DM + 512 + h * 64, DM, SEQ, F.lds);
    }
}

typedef const __attribute__((address_space(4))) Args* KArgs;
#define KA() ({ KArgs p_ = (KArgs)__builtin_amdgcn_kernarg_segment_ptr(); asm volatile("" : "+s"(p_)); p_; })
__global__ void __launch_bounds__(NWAVES * 64, 2) mega_fwd(Args args) {
    extern __shared__ __attribute__((aligned(16))) unsigned char lds[];
    Frame F;
    F.lds = (char*)lds;
    F.MISC = (volatile LAS unsigned*)((LAS unsigned char*)lds + MISC_OFF);
    F.tid = threadIdx.x; F.lane = F.tid & 63; F.wave = __builtin_amdgcn_readfirstlane(F.tid >> 6);
    F.G = gridDim.x; { const int bx = blockIdx.x; F.vcu = (F.G % 8 == 0) ? (bx % 8) * (F.G / 8) + bx / 8 : bx; }
    if (F.tid < 64) F.MISC[F.tid] = 0u;
    __syncthreads();
    const int lo = args.ph_lo, hi = args.ph_hi;
    XcdBarrier bar; bar.bar = (unsigned*)((gu32*)(args.ws + WS_CTL) + CW_BAR) + args.li * XCD_BAR_WORDS; bar.x = 0; bar.st = nullptr;
    const bool full = (lo == 0 && hi == NPHASE);
    gu32* const ready = (gu32*)(args.ws + WS_CTL) + 64;
    if (full) {
        bar.x = xb_xcc_id(); bar.st = F.MISC + 8;
        if (blockIdx.x == 0 && F.tid < 64) {
            unsigned* bw = bar.bar;
            if (F.tid < 16) { __hip_atomic_store(&bw[XB_XCNT(F.tid)], 0u, RLX_AGENT); __hip_atomic_store(&bw[XB_XSUB(F.tid)], 0u, RLX_AGENT); __hip_atomic_store(&bw[XB_XGEN(F.tid)], 0u, RLX_AGENT);
                              __hip_atomic_store(&bw[XB_LSUB(F.tid)], 0u, RLX_AGENT); __hip_atomic_store(&bw[XB_LGEN(F.tid)], 0u, RLX_AGENT); }
            if (F.tid == 16) { __hip_atomic_store(&bw[XB_TMO], 0u, RLX_AGENT); __hip_atomic_store(&bw[XB_TOP], 0u, RLX_AGENT); __hip_atomic_store(&bw[XB_TOPGEN], 0u, RLX_AGENT);
                               __hip_atomic_store((gu32*)(args.ws + WS_CTL) + 16, 0u, RLX_AGENT); }
            asm volatile("s_waitcnt vmcnt(0)" ::: "memory");
            if (F.tid == 0) __hip_atomic_store(ready, READY_MAGIC, __ATOMIC_RELEASE, __HIP_MEMORY_SCOPE_AGENT);
        }
    } else if (hi - lo != 1) bar = xcd_barrier_post((unsigned*)((gu32*)(args.ws + WS_CTL) + CW_BAR) + args.li * XCD_BAR_WORDS, F.MISC + 8);
    gu32* const xtab = (gu32*)(args.ws + WS_CTL) + 1024; gu32* const xflag = (gu32*)(args.ws + WS_CTL) + 16;
    if (!full && F.tid == 0) __hip_atomic_store(xtab + blockIdx.x, bar.x + 1u, RLX_AGENT);
    bool use_local = false;
#ifndef PH_MASK
#define PH_MASK 0x1fff
#endif
#define IN(k) (((PH_MASK >> (k)) & 1) && lo <= (k) && (k) < hi)
#ifndef BAR_REP
#define BAR_REP 1
#endif
#define SEAM(k) do { if (IN(k) && (k) + 1 < hi) { for (int br_ = 0; br_ < BAR_REP; ++br_) xcd_barrier(bar); } } while (0)
#define SEAML(k) do { if (IN(k) && (k) + 1 < hi) { if (use_local) xcd_local_barrier(bar); else xcd_barrier(bar); } } while (0)
#ifndef PH_REP
#define PH_REP 0
#endif
#define REPS(k) for (int rep_ = 0; rep_ < 1 + ((PH_REP >> (k)) & 1); ++rep_)
#define WSB(off) (ws + (off))
#define INF(i) ((const float*)ka->in[i])
    LAS unsigned char* ring = (LAS unsigned char*)lds;

    if (IN(0)) REPS(0) { { KArgs ka = KA(); unsigned char* ws = ka->ws; ph_mod(F, INF(1), INF(3), INF(4), (float*)WSB(WS_MOD));
#ifdef MOD_REP
        for (int mr_ = 0; mr_ < MOD_REP; ++mr_) { __syncthreads(); ph_mod(F, INF(1), INF(3), INF(4), (float*)WSB(WS_MOD)); }
#endif
        } ph_weights(F, KA());
        }
    if (full && F.tid == 0) {
        unsigned sp_ = 0u; while (__hip_atomic_load(ready, RLX_AGENT) != READY_MAGIC) { __builtin_amdgcn_s_sleep(2); if (++sp_ > (1u << 22)) break; }
        (void)xb_add(&bar.bar[XB_XCNT(bar.x)], 1u);
        __hip_atomic_store(xtab + blockIdx.x, bar.x + 1u, RLX_AGENT);
    }
    SEAM(0);
    if (full && blockIdx.x == 0 && F.tid == 0) __hip_atomic_store(ready, 0u, RLX_AGENT);
    if (lo == 0 && hi == NPHASE && F.G == 256 && F.tid == 0) { if (__hip_atomic_load(xtab + (blockIdx.x & 7), RLX_AGENT) != bar.x + 1u) __hip_atomic_store(xflag, 1u, RLX_AGENT); }
    if (IN(1)) REPS(1) { ph_prep(F, KA()); } SEAM(1);
#ifndef NO_LOCAL_SEAMS
    if (lo == 0 && hi == NPHASE && F.G == 256) use_local = __builtin_amdgcn_readfirstlane(__hip_atomic_load(xflag, RLX_AGENT) == 0u ? 1 : 0) != 0;
#endif
    if (IN(2)) REPS(2) { KArgs ka = KA(); unsigned char* ws = ka->ws;
        pg8::Gemm g{(const bf16*)WSB(WS_A1), (const bf16*)WSB(WS_W1T), M, 2 * DFF, DM}; pg8::StaticOrder S; S.init(M, 2 * DFF, F.G, (int)blockIdx.x);
        pg8::EpiSwigluN E{(bf16*)WSB(WS_ACT), DFF, (const float*)WSB(WS_SS0), (const float*)WSB(WS_BIAS1), 2 * DFF}; pg8::gemm_phase<pg8::EpiSwigluN, pg8::StaticOrder, true, true>(ring, g, S, E); } SEAML(2);
    if (IN(3)) REPS(3) { KArgs ka = KA(); unsigned char* ws = ka->ws;
        pg8::Gemm g{(const bf16*)WSB(WS_ACT), (const bf16*)WSB(WS_WD1T), M, DM, DFF}; pg8::StaticOrder S; S.init(M, DM, F.G, (int)blockIdx.x);
        pg8::EpiResidNorm<true, 2, true, false> E{WSB(WS_A1), nullptr, (const float*)WSB(WS_MOD) + 2 * DM, 2 * DM, -1 * DM, (bf16*)WSB(WS_A1), (float*)WSB(WS_SS1)};
        pg8::gemm_phase<pg8::EpiResidNorm<true, 2, true, false>, pg8::StaticOrder, true, true>(ring, g, S, E); } SEAML(3);
    if (IN(5)) REPS(5) { KArgs ka = KA(); unsigned char* ws = ka->ws;
        pg8::Gemm g{(const bf16*)WSB(WS_A1), (const bf16*)WSB(WS_WINT), M, WINP, DM}; pg8::StaticOrder S; S.init(M, WINP, F.G, (int)blockIdx.x);
        pg8::EpiG3N E{(bf16*)WSB(WS_ZG), (bf16*)WSB(WS_ZC), (const float*)WSB(WS_SS1), (const float*)WSB(WS_BIASM), WS_ZGD / 2, WS_ZCD / 2}; pg8::gemm_phase<pg8::EpiG3N, pg8::StaticOrder, true, true>(ring, g, S, E); } SEAML(5);
    if (IN(6)) {
        REPS(13) { KArgs ka = KA(); unsigned char* ws = ka->ws;
            ph_latent(F, (const bf16*)WSB(WS_ZC), (const bf16*)WSB(WS_WQT), (const bf16*)WSB(WS_WKVT), INF(13), INF(14), (const float*)WSB(WS_ROPE), (bf16*)WSB(WS_Q), (bf16*)WSB(WS_K), (bf16*)WSB(WS_V)); }
        REPS(14) { KArgs ka = KA(); unsigned char* ws = ka->ws; ph_conv(F, (const bf16*)WSB(WS_ZG), INF(15), INF(16), INF(17), INF(18), (bf16*)WSB(WS_MIX)); }
    } SEAML(6);
    if (IN(7)) REPS(7) { KArgs ka = KA(); unsigned char* ws = ka->ws; ph_attn(F, (const bf16*)WSB(WS_Q), (const bf16*)WSB(WS_K), (const bf16*)WSB(WS_V), (bf16*)WSB(WS_MIX), (bf16*)WSB(WS_A1), INF(13), INF(14)); } SEAML(7);
    if (IN(8)) REPS(8) { KArgs ka = KA(); unsigned char* ws = ka->ws;
        pg8::Gemm g{(const bf16*)WSB(WS_MIX), (const bf16*)WSB(WS_WOUTT), M, DM, DM}; pg8::StaticOrder S; S.init(M, DM, F.G, (int)blockIdx.x);
        pg8::EpiResidNorm<false, 2, true, false> E{WSB(WS_A1), nullptr, (const float*)WSB(WS_MOD) + 5 * DM, 2 * DM, -1 * DM, (bf16*)WSB(WS_A1), (float*)WSB(WS_SS2)};
        pg8::gemm_phase<pg8::EpiResidNorm<false, 2, true, false>, pg8::StaticOrder, true, true>(ring, g, S, E); } SEAML(8);
    if (IN(10)) REPS(10) { KArgs ka = KA(); unsigned char* ws = ka->ws;
        pg8::Gemm g{(const bf16*)WSB(WS_A1), (const bf16*)WSB(WS_W2T), M, 2 * DFF, DM}; pg8::StaticOrder S; S.init(M, 2 * DFF, F.G, (int)blockIdx.x);
        pg8::EpiSwigluN E{(bf16*)WSB(WS_ACT), DFF, (const float*)WSB(WS_SS2), (const float*)WSB(WS_BIAS2), 2 * DFF}; pg8::gemm_phase<pg8::EpiSwigluN, pg8::StaticOrder, true, true>(ring, g, S, E); } SEAML(10);
    if (IN(11)) REPS(11) { KArgs ka = KA(); unsigned char* ws = ka->ws;
        pg8::Gemm g{(const bf16*)WSB(WS_ACT), (const bf16*)WSB(WS_WD2T), M, DM, DFF}; pg8::StaticOrder S; S.init(M, DM, F.G, (int)blockIdx.x);
        pg8::EpiResidNorm<true, 2, false, true> E{WSB(WS_A1), (bf16*)WSB(WS_HB), (const float*)WSB(WS_MOD) + 8 * DM, 0, -1 * DM, nullptr, (float*)WSB(WS_SS3)};
        pg8::gemm_phase<pg8::EpiResidNorm<true, 2, false, true>, pg8::StaticOrder, true, true>(ring, g, S, E); } SEAML(11);
    if (IN(12)) REPS(12) { KArgs ka = KA(); unsigned char* ws = ka->ws; ph_final(F, (const bf16*)WSB(WS_HB), (const float*)WSB(WS_SS3), INF(23), ka->out); }
#undef IN
#undef SEAM
}

extern "C" void kernel_launch(void* const* d_in, const int* in_sizes, int n_in, void* d_out, int out_size, void* d_ws, size_t ws_size, hipStream_t stream) {
    static int grid = 0;
    if (grid == 0) {
        if (n_in != 24 || in_sizes[0] != M * DM || out_size != M * DM || ws_size < WS_END) { fprintf(stderr, "kernel_launch: unexpected shapes (n_in %d, in0 %d, out %d, ws %zu)\n", n_in, n_in > 0 ? in_sizes[0] : -1, out_size, ws_size); grid = -1; return; }
        int dev = 0, cus = 0, per_cu = 0;
        if (hipGetDevice(&dev) != hipSuccess || hipDeviceGetAttribute(&cus, hipDeviceAttributeMultiprocessorCount, dev) != hipSuccess) { grid = -1; return; }
        if (hipFuncSetAttribute((const void*)mega_fwd, hipFuncAttributeMaxDynamicSharedMemorySize, LDS_BYTES) != hipSuccess) { fprintf(stderr, "kernel_launch: hipFuncSetAttribute failed\n"); grid = -1; return; }
        if (hipOccupancyMaxActiveBlocksPerMultiprocessor(&per_cu, (const void*)mega_fwd, NWAVES * 64, LDS_BYTES) != hipSuccess || per_cu < 1) { fprintf(stderr, "kernel_launch: occupancy query says %d blocks per CU\n", per_cu); (void)hipGetLastError(); grid = -1; return; }
        grid = cus;
    }
    if (grid < 0) return;
    if (MK_N_LAUNCHES != 1) { if (hipMemsetAsync((char*)d_ws + WS_CTL, 0, CTL_ZERO_BYTES, stream) != hipSuccess) return; }
    Args a{};
    for (int i = 0; i < 24; ++i) a.in[i] = d_in[i];
    a.out = (float*)d_out; a.ws = (unsigned char*)d_ws;
    for (int i = 0; i < 16; ++i) a.invf[i] = 1.0 / pow(10000.0, (double)(2 * i) / 32.0);
    constexpr int NL = MK_N_LAUNCHES;
    for (int li = 0; li < NL; ++li) {
        a.ph_lo = (NL == NPHASE) ? li : (li * NPHASE) / NL; a.ph_hi = (NL == NPHASE) ? li + 1 : ((li + 1) * NPHASE) / NL; a.li = (NL == NPHASE) ? 0 : li;
        hipLaunchKernelGGL(mega_fwd, dim3(grid), dim3(NWAVES * 64), LDS_BYTES, stream, a);
        const hipError_t le = hipPeekAtLastError();
        if (le != hipSuccess) { fprintf(stderr, "kernel_launch: launch %d failed: %s\n", li, hipGetErrorName(le)); break; }
    }
}
```
